# Optimizing an MI355X kernel written in HIP

```python
import math
import jax
import jax.numpy as jnp
from jax import lax
import numpy as np

D_MODEL = 2048
BATCH = 2
SEQ = 16384
DEPTH = 4

MLSTM_HEADS = 4
MLSTM_HEAD_DIM = 256
MLSTM_WIDTH = MLSTM_HEADS * MLSTM_HEAD_DIM
MLSTM_CHUNK = 64
CONV_WIDTH = 4
ATTN_GROUPS = ((128, 1), (512, 4), (2048, 16))
ATTN_HEADS = 8
ATTN_HEAD_DIM = 128
ATTN_WIDTH = ATTN_HEADS * ATTN_HEAD_DIM
ATTN_HEADS_TOTAL = len(ATTN_GROUPS) * ATTN_HEADS
ATTN_BLOCK = 128
REL_BUCKETS = 32
REL_MAX_DISTANCE = 2048
S5_WIDTH = 1024
S5_GROUP = 16
S5_GROUPS = S5_WIDTH // S5_GROUP
S5_STATE = 64
FF_HIDDEN = 4 * D_MODEL
N_BRANCHES = 3
NORM_EPS = 1e-6

IN_SPLITS = (
    MLSTM_WIDTH, MLSTM_WIDTH, MLSTM_WIDTH, MLSTM_WIDTH,
    MLSTM_HEADS, MLSTM_HEADS,
    3 * ATTN_HEADS_TOTAL * ATTN_HEAD_DIM,
    S5_WIDTH,
    N_BRANCHES * D_MODEL,
)
N_IN = sum(IN_SPLITS)
IN_OFFSETS = tuple(int(o) for o in np.cumsum(IN_SPLITS)[:-1])

kernel_name = "hybrid_mlstm_dilated_s5_trunk"


def rms_norm(x, g):
    xf = x.astype(jnp.float32)
    y = xf * lax.rsqrt(jnp.mean(xf * xf, axis=-1, keepdims=True) + NORM_EPS)
    return (y * g.astype(jnp.float32)).astype(x.dtype)


def split_heads(t, h):
    return t.reshape(t.shape[:-1] + (h, t.shape[-1] // h))


def causal_depthwise_conv(x, w, b):
    k = w.shape[0]
    s = x.shape[1]
    xp = jnp.pad(x, ((0, 0), (k - 1, 0), (0, 0)))
    y = b
    for j in range(k):
        y = y + w[j] * xp[:, j:j + s]
    return y


def mlstm_chunkwise(q, k, v, ig, lf):
    b, s, h, e = q.shape
    L = MLSTM_CHUNK
    nc = s // L
    k = k * (e ** -0.5)

    def chunks(t):
        t = t.reshape((b, nc, L) + t.shape[2:])
        return jnp.moveaxis(t, 1, 0).swapaxes(2, 3)

    causal = jnp.tril(jnp.ones((L, L), dtype=bool))

    def step(carry, inp):
        c_state, n_state, m_state = carry
        qc, kc, vc, igc, lfc = inp
        bcum = jnp.cumsum(lfc, axis=-1)
        dlog = bcum[..., :, None] - bcum[..., None, :] + igc[..., None, :]
        dlog = jnp.where(causal, dlog, -jnp.inf)
        m_inter = bcum + m_state[..., None]
        m_t = jnp.maximum(m_inter, jnp.max(dlog, axis=-1))
        w_intra = jnp.exp(dlog - m_t[..., None])
        w_inter = jnp.exp(m_inter - m_t)
        sc = jnp.einsum('bhtd,bhsd->bhts', qc, kc) * w_intra
        num = (jnp.einsum('bhts,bhse->bhte', sc, vc)
               + w_inter[..., None] * jnp.einsum('bhtd,bhed->bhte', qc, c_state))
        den = jnp.sum(sc, axis=-1) + w_inter * jnp.einsum('bhtd,bhd->bht', qc, n_state)
        h_out = num / jnp.maximum(jnp.abs(den), jnp.exp(-m_t))[..., None]
        b_last = bcum[..., -1]
        g = b_last[..., None] - bcum + igc
        m_new = jnp.maximum(b_last + m_state, jnp.max(g, axis=-1))
        w_s = jnp.exp(g - m_new[..., None])
        decay = jnp.exp(b_last + m_state - m_new)
        c_new = decay[..., None, None] * c_state + jnp.einsum('bhs,bhse,bhsd->bhed', w_s, vc, kc)
        n_new = decay[..., None] * n_state + jnp.einsum('bhs,bhsd->bhd', w_s, kc)
        return (c_new, n_new, m_new), h_out

    init = (jnp.zeros((b, h, e, e), jnp.float32), jnp.zeros((b, h, e), jnp.float32),
            jnp.zeros((b, h), jnp.float32))
    _, hs = lax.scan(step, init, (chunks(q), chunks(k), chunks(v), chunks(ig), chunks(lf)))
    hs = jnp.moveaxis(hs.swapaxes(2, 3), 0, 1)
    return hs.reshape(b, s, h, e)


def t5_bucket(n):
    max_exact = REL_BUCKETS // 2
    nf = jnp.maximum(n, max_exact).astype(jnp.float32)
    large = max_exact + (jnp.log(nf / max_exact) / math.log(REL_MAX_DISTANCE / max_exact)
                         * (REL_BUCKETS - max_exact)).astype(jnp.int32)
    large = jnp.minimum(large, REL_BUCKETS - 1)
    return jnp.where(n < max_exact, n, large)


def band_bias(table, dilation):
    i = jnp.arange(ATTN_BLOCK)[:, None]
    j = jnp.arange(2 * ATTN_BLOCK)[None, :]
    dist = jnp.maximum(ATTN_BLOCK + i - j, 0) * dilation
    return jnp.transpose(table[t5_bucket(dist)], (2, 0, 1)).astype(jnp.float32)


def dilated_group_attention(q, k, v, bias, window, dilation):
    b, s, h, e = q.shape
    r = dilation
    span = window // dilation
    l = s // r
    nb = -(-l // ATTN_BLOCK)
    lp = nb * ATTN_BLOCK

    def to_blocks(t):
        t = t.reshape(b, l, r, h, e).swapaxes(1, 2)
        t = jnp.pad(t, ((0, 0), (0, 0), (0, lp - l), (0, 0), (0, 0)))
        return t.reshape(b, r, nb, ATTN_BLOCK, h, e)

    def with_prev(t):
        prev = jnp.pad(t, ((0, 0), (0, 0), (1, 0), (0, 0), (0, 0), (0, 0)))[:, :, :-1]
        return jnp.concatenate([prev, t], axis=3)

    qb = to_blocks(q)
    kk = with_prev(to_blocks(k))
    vv = with_prev(to_blocks(v))
    logits = jnp.einsum('bcnqhe,bcnkhe->bcnhqk', qb, kk) * (e ** -0.5) + bias
    i = jnp.arange(ATTN_BLOCK)[:, None]
    j = jnp.arange(2 * ATTN_BLOCK)[None, :]
    rel = ATTN_BLOCK + i - j
    band = (rel >= 0) & (rel <= span)
    has_prev = (jnp.arange(nb) > 0)[:, None, None] | (j >= ATTN_BLOCK)[None]
    valid = band[None] & has_prev
    logits = jnp.where(valid[None, None, :, None], logits, -jnp.inf)
    mx = jnp.max(logits, axis=-1, keepdims=True)
    p = jnp.exp(logits - mx)
    den = jnp.sum(p, axis=-1)
    out = jnp.einsum('bcnhqk,bcnkhe->bcnqhe', p, vv) / den.swapaxes(-1, -2)[..., None]
    lse = (mx[..., 0] + jnp.log(den)).swapaxes(-1, -2)
    out = out.reshape(b, r, lp, h, e)[:, :, :l].swapaxes(1, 2).reshape(b, s, h, e)
    lse = lse.reshape(b, r, lp, h)[:, :, :l].swapaxes(1, 2).reshape(b, s, h)
    return out, lse


def dilated_attention(q, k, v, rel_bias):
    outs, lses = [], []
    for g, (window, dilation) in enumerate(ATTN_GROUPS):
        hs = slice(g * ATTN_HEADS, (g + 1) * ATTN_HEADS)
        o, lse = dilated_group_attention(q[:, :, hs], k[:, :, hs], v[:, :, hs],
                                         band_bias(rel_bias[:, hs], dilation), window, dilation)
        outs.append(o)
        lses.append(lse)
    wts = jax.nn.softmax(jnp.stack(lses), axis=0)
    return jnp.sum(wts[..., None] * jnp.stack(outs), axis=0)


def s5_combine(e1, e2):
    a1r, a1i, b1r, b1i = e1
    a2r, a2i, b2r, b2i = e2
    return (a2r * a1r - a2i * a1i, a2r * a1i + a2i * a1r,
            a2r * b1r - a2i * b1i + b2r, a2r * b1i + a2i * b1r + b2i)


def s5_ssm(u, lam_re, lam_im, log_dt, b_re, b_im, c_re, c_im, d_skip):
    bsz, s, _ = u.shape
    ug = u.reshape(bsz, s, S5_GROUPS, S5_GROUP)
    dt = jnp.exp(log_dt)[:, None]
    mag = jnp.exp(lam_re * dt)
    ab_re = mag * jnp.cos(lam_im * dt)
    ab_im = mag * jnp.sin(lam_im * dt)
    nr = ab_re - 1.0
    ni = ab_im
    den = lam_re * lam_re + lam_im * lam_im
    f_re = (nr * lam_re + ni * lam_im) / den
    f_im = (ni * lam_re - nr * lam_im) / den
    bb_re = f_re[..., None] * b_re - f_im[..., None] * b_im
    bb_im = f_re[..., None] * b_im + f_im[..., None] * b_re
    bu_re = jnp.einsum('bsgi,gpi->bsgp', ug, bb_re)
    bu_im = jnp.einsum('bsgi,gpi->bsgp', ug, bb_im)
    a_re = jnp.broadcast_to(ab_re, (1, s) + ab_re.shape)
    a_im = jnp.broadcast_to(ab_im, (1, s) + ab_im.shape)
    _, _, xr, xi = lax.associative_scan(s5_combine, (a_re, a_im, bu_re, bu_im), axis=1)
    y = (jnp.einsum('bsgp,gop->bsgo', xr, c_re) - jnp.einsum('bsgp,gop->bsgo', xi, c_im)
         + d_skip * ug)
    return y.reshape(bsz, s, S5_WIDTH)


def setup_inputs(seed: int = 0) -> dict:
    key = jax.random.key(seed)
    ks = jax.random.split(key, 26)
    f32 = jnp.float32
    L, D = DEPTH, D_MODEL

    def normal(k, shape, scale):
        return jax.random.normal(k, shape, f32) * scale

    return {
        "x": normal(ks[0], (BATCH, SEQ, D), 1.0),
        "norm1_g": 1.0 + normal(ks[1], (L, D), 0.02),
        "w_in": normal(ks[2], (L, D, N_IN), D ** -0.5),
        "conv_w": normal(ks[3], (L, CONV_WIDTH, 2 * MLSTM_WIDTH), CONV_WIDTH ** -0.5),
        "conv_b": normal(ks[4], (L, 2 * MLSTM_WIDTH), 0.02),
        "b_igate": normal(ks[5], (L, MLSTM_HEADS), 0.1),
        "b_fgate": jnp.linspace(3.0, 6.0, MLSTM_HEADS, dtype=f32) + normal(ks[6], (L, MLSTM_HEADS), 0.1),
        "mh_norm_g": 1.0 + normal(ks[7], (L, MLSTM_WIDTH), 0.02),
        "rel_bias": normal(ks[8], (REL_BUCKETS, ATTN_HEADS_TOTAL), 0.5),
        "lam_re": -0.5 + normal(ks[9], (L, S5_GROUPS, S5_STATE), 0.01),
        "lam_im": math.pi * jnp.arange(S5_STATE, dtype=f32) + normal(ks[10], (L, S5_GROUPS, S5_STATE), 0.01),
        "log_dt": jax.random.uniform(ks[11], (L, S5_GROUPS), f32, math.log(1e-3), math.log(1e-1)),
        "b_re": normal(ks[12], (L, S5_GROUPS, S5_STATE, S5_GROUP), (2 * S5_GROUP) ** -0.5),
        "b_im": normal(ks[13], (L, S5_GROUPS, S5_STATE, S5_GROUP), (2 * S5_GROUP) ** -0.5),
        "c_re": normal(ks[14], (L, S5_GROUPS, S5_GROUP, S5_STATE), S5_STATE ** -0.5),
        "c_im": normal(ks[15], (L, S5_GROUPS, S5_GROUP, S5_STATE), S5_STATE ** -0.5),
        "d_skip": normal(ks[16], (L, S5_GROUPS, S5_GROUP), 1.0),
        "w_glu": normal(ks[17], (L, S5_WIDTH, 2 * S5_WIDTH), S5_WIDTH ** -0.5),
        "w_br_a": normal(ks[18], (L, MLSTM_WIDTH, D), MLSTM_WIDTH ** -0.5),
        "w_br_b": normal(ks[19], (L, ATTN_WIDTH, D), ATTN_WIDTH ** -0.5),
        "w_br_c": normal(ks[20], (L, S5_WIDTH, D), S5_WIDTH ** -0.5),
        "w_out": normal(ks[21], (L, D, D), D ** -0.5),
        "norm2_g": 1.0 + normal(ks[22], (L, D), 0.02),
        "w_ff1": normal(ks[23], (L, D, FF_HIDDEN), D ** -0.5),
        "w_ff2": normal(ks[24], (L, FF_HIDDEN, D), FF_HIDDEN ** -0.5),
        "final_g": 1.0 + normal(ks[25], (D,), 0.02),
    }


def reference(x, norm1_g, w_in, conv_w, conv_b, b_igate, b_fgate, mh_norm_g, rel_bias,
              lam_re, lam_im, log_dt, b_re, b_im, c_re, c_im, d_skip, w_glu,
              w_br_a, w_br_b, w_br_c, w_out, norm2_g, w_ff1, w_ff2, final_g):
    dt = x.dtype
    f32 = jnp.float32
    bsz, s, _ = x.shape
    for l in range(DEPTH):
        xn = rms_norm(x, norm1_g[l])
        proj = xn @ w_in[l]
        q_m, k_m, v_m, o_m, i_m, f_m, qkv_att, u_s5, gates = jnp.split(proj, IN_OFFSETS, axis=-1)

        qk = jax.nn.silu(causal_depthwise_conv(jnp.concatenate([q_m, k_m], axis=-1),
                                               conv_w[l], conv_b[l]).astype(f32))
        q_a, k_a = jnp.split(qk, 2, axis=-1)
        h_m = mlstm_chunkwise(split_heads(q_a, MLSTM_HEADS), split_heads(k_a, MLSTM_HEADS),
                              split_heads(v_m.astype(f32), MLSTM_HEADS),
                              i_m.astype(f32) + b_igate[l].astype(f32),
                              jax.nn.log_sigmoid(f_m.astype(f32) + b_fgate[l].astype(f32)))
        h_m = h_m * lax.rsqrt(jnp.mean(h_m * h_m, axis=-1, keepdims=True) + NORM_EPS)
        h_m = h_m.reshape(bsz, s, MLSTM_WIDTH) * mh_norm_g[l].astype(f32)
        y_a = (jax.nn.sigmoid(o_m.astype(f32)) * h_m).astype(dt)

        qkv = qkv_att.astype(f32).reshape(bsz, s, 3, ATTN_HEADS_TOTAL, ATTN_HEAD_DIM)
        y_b = dilated_attention(qkv[:, :, 0], qkv[:, :, 1], qkv[:, :, 2], rel_bias)
        y_b = y_b.reshape(bsz, s, ATTN_WIDTH).astype(dt)

        y_s = s5_ssm(u_s5.astype(f32), lam_re[l].astype(f32), lam_im[l].astype(f32),
                     log_dt[l].astype(f32), b_re[l].astype(f32), b_im[l].astype(f32),
                     c_re[l].astype(f32), c_im[l].astype(f32), d_skip[l].astype(f32))
        z = jax.nn.gelu(y_s.astype(dt))
        z_lin, z_gate = jnp.split(z @ w_glu[l], 2, axis=-1)
        y_c = z_lin * jax.nn.sigmoid(z_gate)

        g_a, g_b, g_c = jnp.split(jax.nn.sigmoid(gates), 3, axis=-1)
        mix = g_a * (y_a @ w_br_a[l]) + g_b * (y_b @ w_br_b[l]) + g_c * (y_c @ w_br_c[l])
        x = x + mix @ w_out[l]

        hn = rms_norm(x, norm2_g[l])
        x = x + jnp.square(jax.nn.relu(hn @ w_ff1[l])) @ w_ff2[l]
    return rms_norm(x, final_g)
```

```cpp
#include <hip/hip_runtime.h>
#include <cstdio>
#include <cstdint>
namespace pg8 {
#define PG8_LAS __attribute__((address_space(3)))
typedef unsigned short bf16_t;
typedef short bf16x8 __attribute__((ext_vector_type(8)));
typedef float f32x4 __attribute__((ext_vector_type(4)));
typedef unsigned u32x4 __attribute__((ext_vector_type(4)));
constexpr int BM = 256, BK = 64, HALF = 128, HTB = HALF * BK * 2  , STAGE_BYTES = 8 * HTB, NXCD = 8, WGM = 8;

__host__ __device__ __forceinline__ int lds_byte(int r, int c) { const int st = (r >> 4) * 2 + (c >> 5), rr = r & 15, cc = c & 31, ob = rr * 64 + cc * 2; return st * 1024 + (ob ^ (((ob >> 9) & 1) << 5)); }
__host__ __device__ __forceinline__ void stage_rc(int b, int& R, int& C) { const int st = b / 1024, sb = b % 1024, swz = sb ^ (((sb >> 9) & 1) << 5); R = (st >> 1) * 16 + swz / 64; C = (st & 1) * 32 + (swz % 64) / 2; }
__host__ __device__ __forceinline__ int perm32(int rho) { const int n = rho >> 4, i = rho & 15; return 8 * (i >> 2) + 4 * n + (i & 3); }

struct Unit { int pm, pn; };
struct Gemm { const bf16_t* A; const bf16_t* Bt; int M, N, K, lda, ldb; };

struct StaticOrder {
    int nM, nN, nwg, G, c;
    __host__ __device__ void init(int M, int N, int G_, int c_) { nM = M / BM; nN = N / BM; nwg = nM * nN; G = G_; c = c_; }
    __host__ __device__ bool next(int i, Unit& u) const {
        const long L = (long)i * G + c; if (L >= nwg) return false;
        int wgid = (int)L; { const int q = nwg / NXCD, r = nwg % NXCD, xcd = wgid % NXCD, off = wgid / NXCD; wgid = (xcd < r ? xcd * (q + 1) : r * (q + 1) + (xcd - r) * q) + off; }
        const int nig = WGM * nN, gid = wgid / nig, fm = gid * WGM, gsz = (nM - fm) < WGM ? (nM - fm) : WGM;
        u.pm = fm + ((wgid % nig) % gsz); u.pn = (wgid % nig) / gsz; return true;
    }
    __device__ __forceinline__ void a_ready(const Unit&) const {}
    __device__ __forceinline__ void done(const Unit&) const {}
};

typedef __bf16 bf16x2_t __attribute__((ext_vector_type(2)));
typedef float f32x2_t __attribute__((ext_vector_type(2)));
__device__ __forceinline__ unsigned cvt_pk_bf16(float lo, float hi) { const f32x2_t v = {lo, hi}; const bf16x2_t r = __builtin_convertvector(v, bf16x2_t); return __builtin_bit_cast(unsigned, r); }

template <class Epi, class Sched, bool ALIGN_EPI = true>
__device__ __forceinline__ void gemm_phase(PG8_LAS unsigned char* lds, const Gemm g, const Sched& S, const Epi& E) {
    int tid = threadIdx.x; asm volatile("" : "+v"(tid));
    const int wid = __builtin_amdgcn_readfirstlane(tid >> 6), lane = tid & 63, wr = wid >> 2, wc = wid & 3, fr = lane & 15, fq = lane >> 4;
    const int nt = g.K / BK;
    unsigned voffA[2], voffB[2];
#pragma unroll
    for (int i = 0; i < 2; ++i) { int R, C; stage_rc(tid * 16 + i * 8192, R, C); const int Rb = Epi::PERM ? ((R & ~31) + perm32(R & 31)) : R;
        voffA[i] = (unsigned)(R * g.lda + C) * 2u; voffB[i] = (unsigned)(Rb * g.ldb + C) * 2u; }
    const size_t kstep = (size_t)(BK * 2);
    const size_t hstepA = (size_t)HALF * g.lda * 2, hstepB = (size_t)HALF * g.ldb * 2;
    const size_t tstepA = 2 * hstepA, tstepB = 2 * hstepB;
    const unsigned ldsw = (unsigned)wid * 1024u;
    const int aoff = lds_byte(wr * 64 + fr, fq * 8), boff = lds_byte(wc * 32 + fr, fq * 8);
#define PG8_SA(b, h) (((b) * 2 + (h)) * HTB)
#define PG8_SB(b, h) ((4 + (b) * 2 + (h)) * HTB)
#define PG8_STAGE(bufoff, gbase, voff) do { _Pragma("unroll") for (int _i = 0; _i < 2; ++_i) \
        __builtin_amdgcn_global_load_lds((const unsigned*)((const char*)(gbase) + (voff)[_i]), (PG8_LAS unsigned*)(lds + (bufoff) + ldsw + _i * 8192), 16, 0, 0); } while (0)
#define PG8_LDA(dst, b, h) do { _Pragma("unroll") for (int m = 0; m < 4; ++m) _Pragma("unroll") for (int k = 0; k < 2; ++k) dst[m][k] = *(const PG8_LAS bf16x8*)(lds + PG8_SA(b, h) + aoff + m * 2048 + k * 1024); } while (0)
#define PG8_LDB(dst, b, h) do { _Pragma("unroll") for (int n = 0; n < 2; ++n) _Pragma("unroll") for (int k = 0; k < 2; ++k) dst[n][k] = *(const PG8_LAS bf16x8*)(lds + PG8_SB(b, h) + boff + n * 2048 + k * 1024); } while (0)
#define PG8_MMA(ai, bj, At, Bt) do { __builtin_amdgcn_s_setprio(1); _Pragma("unroll") for (int m = 0; m < 4; ++m) _Pragma("unroll") for (int n = 0; n < 2; ++n) _Pragma("unroll") for (int k = 0; k < 2; ++k) \
        acc[ai][bj][m][n] = __builtin_amdgcn_mfma_f32_16x16x32_bf16(Bt[n][k], At[m][k], acc[ai][bj][m][n], 0, 0, 0); __builtin_amdgcn_s_setprio(0); } while (0)
#define PG8_WAIT_V(n) asm volatile("s_waitcnt vmcnt(" #n ")" ::: "memory")
#define PG8_WAIT_L(n) asm volatile("s_waitcnt lgkmcnt(" #n ")" ::: "memory")
#define PG8_BAR __builtin_amdgcn_s_barrier()
#define PG8_SCHED __builtin_amdgcn_sched_barrier(0)
    Unit cur, nxt; int ui = 0;
    if (!S.next(0, cur)) return;
    f32x4 acc[2][2][4][2];
#pragma unroll
    for (int a = 0; a < 2; ++a)
#pragma unroll
        for (int b = 0; b < 2; ++b)
#pragma unroll
            for (int m = 0; m < 4; ++m)
#pragma unroll
                for (int n = 0; n < 2; ++n) acc[a][b][m][n] = (f32x4){0.f, 0.f, 0.f, 0.f};
    bf16x8 At[4][2], B0[2][2], B1[2][2];
    const char* cA = (const char*)g.A + (size_t)cur.pm * tstepA; const char* cB = (const char*)g.Bt + (size_t)cur.pn * tstepB;
    S.a_ready(cur);
    PG8_STAGE(PG8_SB(0, 0), cB, voffB); PG8_STAGE(PG8_SB(0, 1), cB + hstepB, voffB); PG8_STAGE(PG8_SA(0, 0), cA, voffA); PG8_STAGE(PG8_SA(0, 1), cA + hstepA, voffA);
    if (wr == 1) PG8_BAR;
    PG8_WAIT_V(2); PG8_BAR;
    PG8_STAGE(PG8_SB(1, 0), cB + kstep, voffB); PG8_STAGE(PG8_SA(1, 0), cA + kstep, voffA); PG8_STAGE(PG8_SB(1, 1), cB + hstepB + kstep, voffB);
    PG8_WAIT_V(6); PG8_BAR;
    for (;;) {
        const bool has_next = S.next(ui + 1, nxt);
        const char* nA = has_next ? (const char*)g.A + (size_t)nxt.pm * tstepA : cA; const char* nB = has_next ? (const char*)g.Bt + (size_t)nxt.pn * tstepB : cB;
        for (int t = 0; t < nt; t += 2) {
            const bool last = (t == nt - 2);
            const char* a1 = cA + (size_t)(t + 1) * kstep;
            const char* a2 = last ? nA : cA + (size_t)(t + 2) * kstep; const char* b2 = last ? nB : cB + (size_t)(t + 2) * kstep;
            const char* a3 = a2 + kstep; const char* b3 = b2 + kstep;
            if (last && has_next) S.a_ready(nxt);
            if constexpr (Epi::MIDK) { if (t == 16 || t == 32) E.mid(acc, cur, t, wr, wc, fr, fq); }
            PG8_LDB(B0, 0, 0); PG8_LDB(B1, 0, 1); PG8_SCHED; PG8_LDA(At, 0, 0); PG8_STAGE(PG8_SA(1, 1), a1 + hstepA, voffA);
            PG8_WAIT_V(8); PG8_WAIT_L(0); PG8_BAR; PG8_MMA(0, 0, At, B0); PG8_MMA(0, 1, At, B1); PG8_BAR; PG8_SCHED;
            PG8_LDA(At, 0, 1); PG8_STAGE(PG8_SB(0, 0), b2, voffB); PG8_STAGE(PG8_SB(0, 1), b2 + hstepB, voffB); PG8_STAGE(PG8_SA(0, 0), a2, voffA);
            PG8_WAIT_V(8); PG8_WAIT_L(0); PG8_BAR; PG8_MMA(1, 0, At, B0); PG8_MMA(1, 1, At, B1); PG8_BAR; PG8_SCHED;
            PG8_LDB(B0, 1, 0); PG8_LDB(B1, 1, 1); PG8_SCHED; PG8_LDA(At, 1, 0); PG8_STAGE(PG8_SA(0, 1), a2 + hstepA, voffA);
            PG8_WAIT_V(8); PG8_WAIT_L(0); PG8_BAR; PG8_MMA(0, 0, At, B0); PG8_MMA(0, 1, At, B1); PG8_BAR; PG8_SCHED;
            PG8_LDA(At, 1, 1); PG8_STAGE(PG8_SB(1, 0), b3, voffB); PG8_STAGE(PG8_SB(1, 1), b3 + hstepB, voffB); PG8_STAGE(PG8_SA(1, 0), a3, voffA);
            PG8_WAIT_V(8); PG8_WAIT_L(0); PG8_BAR; PG8_MMA(1, 0, At, B0); PG8_MMA(1, 1, At, B1); PG8_BAR; PG8_SCHED;
        }
        if constexpr (ALIGN_EPI) { if (wr == 0) PG8_BAR; }
        E(acc, cur, wr, wc, fr, fq); S.done(cur);
        if (!has_next) break;
#pragma unroll
        for (int a = 0; a < 2; ++a)
#pragma unroll
            for (int b = 0; b < 2; ++b)
#pragma unroll
                for (int m = 0; m < 4; ++m)
#pragma unroll
                    for (int n = 0; n < 2; ++n) acc[a][b][m][n] = (f32x4){0.f, 0.f, 0.f, 0.f};
        cur = nxt; cA = nA; cB = nB; ++ui;
        if constexpr (ALIGN_EPI) { if (wr == 1) PG8_BAR; }
    }
    PG8_WAIT_V(0);
    if constexpr (!ALIGN_EPI) { if (wr == 0) PG8_BAR; }
    PG8_BAR;
#undef PG8_SA
#undef PG8_SB
#undef PG8_STAGE
#undef PG8_LDA
#undef PG8_LDB
#undef PG8_MMA
#undef PG8_WAIT_V
#undef PG8_WAIT_L
#undef PG8_BAR
#undef PG8_SCHED
}
}
constexpr int BATCH = 2, SEQ = 16384, DM = 2048, DEPTH = 4, M = BATCH * SEQ, FF = 8192;
constexpr int N_IN = 20488, NPROJ = 20480;
constexpr int PQ = 0, PK = 1024, PV = 2048, PO = 3072, PAQ = 4096, PAK = 7168, PAV = 10240, PU = 13312, PG = 14336;
constexpr float NORM_EPS = 1e-6f;
constexpr int NWAVES = 8, NTHR = 512;
constexpr int NPH = 12, NPHASES = DEPTH * NPH + 1;
#ifndef ABL_SA
#define ABL_SA 1.0f
#endif
#ifndef ABL_SB
#define ABL_SB 1.0f
#endif
#ifndef ABL_SC
#define ABL_SC 1.0f
#endif
#ifndef ABL_SM
#define ABL_SM 1.0f
#endif
#ifndef ABL_SF
#define ABL_SF 1.0f
#endif
#if defined(ABL_HOOKFREE_A)
#define ABL_FINAL_GATE 0
#else
#define ABL_FINAL_GATE 2
#endif
#ifndef MK_SPLIT
#define MK_SPLIT 0
#endif

constexpr size_t MiB = 1u << 20;
constexpr size_t WS_CTL = 0, CTL_ZERO_BYTES = 1 * MiB;
constexpr size_t WS_SMALL = 2424 * MiB, SMALL_STRIDE = 8 * MiB;
constexpr size_t WS_IFG = WS_SMALL;
constexpr size_t WS_S5LOC = WS_SMALL + 1 * MiB, WS_S5CAR = WS_SMALL + 2 * MiB;
constexpr size_t WS_WIN = 8 * MiB, WS_WGLU = 88 * MiB, WS_WBR = 92 * MiB, WS_WOUT = 104 * MiB, WS_W1 = 112 * MiB, WS_W2 = 144 * MiB;
constexpr size_t WS_XN = 176 * MiB;
constexpr size_t WS_PROJ = 304 * MiB;
constexpr size_t WS_QKC = 1584 * MiB;
constexpr size_t WS_HM = 1712 * MiB;
constexpr size_t WS_Y = 1712 * MiB;
constexpr size_t WS_Z = 1904 * MiB;
constexpr size_t WS_ATT = 1968 * MiB;
constexpr size_t WS_LSE = WS_SMALL + 4 * MiB;
constexpr size_t WS_CST = 2164 * MiB;
constexpr size_t WS_CIN = 2294 * MiB;
constexpr size_t WS_MF = WS_SMALL + 3 * MiB;
constexpr size_t WS_DISC = WS_SMALL + 3 * MiB + 512 * 1024;
constexpr size_t WS_END = 2456 * MiB;
constexpr int CW_BAR = 4096;

constexpr int RING_BYTES = 131072, MISC_OFF = 148480, LDS_BYTES = 149504;

#define GAS __attribute__((address_space(1)))
#define LAS __attribute__((address_space(3)))
typedef unsigned short bf16;
typedef unsigned v4u __attribute__((ext_vector_type(4)));
typedef unsigned v2u __attribute__((ext_vector_type(2)));
typedef float f32x4 __attribute__((ext_vector_type(4)));
typedef float f32x2 __attribute__((ext_vector_type(2)));
#define LDS_WAIT() asm volatile("s_waitcnt lgkmcnt(0)" ::: "memory")
__device__ __forceinline__ unsigned f2bf(float f) { unsigned u = __builtin_bit_cast(unsigned, f); return (u + 0x7fffu + ((u >> 16) & 1u)) >> 16; }
__device__ __forceinline__ unsigned pk2(float lo, float hi) { return f2bf(lo) | (f2bf(hi) << 16); }
__device__ __forceinline__ float bflo(unsigned u) { return __builtin_bit_cast(float, u << 16); }
__device__ __forceinline__ float bfhi(unsigned u) { return __builtin_bit_cast(float, u & 0xffff0000u); }
__device__ __forceinline__ float bf1(bf16 b) { return __builtin_bit_cast(float, (unsigned)b << 16); }
__device__ __forceinline__ float sigmoid_f(float v) { return __builtin_amdgcn_rcpf(1.0f + __builtin_amdgcn_exp2f(-1.44269504f * v)); }
__device__ __forceinline__ float wave_sum(float v) {
#pragma unroll
    for (int o = 1; o < 64; o <<= 1) v += __shfl_xor(v, o);
    return v;
}

#define XB_TMO      128
#define XB_XCNT(j)  (256  + 64 * (j))
#define XB_XSUB(j)  (1280 + 64 * (j))
#define XB_XGEN(j)  (2304 + 64 * (j))
#define XB_TOP      3328
#define XB_TOPGEN   3392
#define XCD_BAR_WORDS 3456
#define XB_SPIN_CAP (1u << 18)
__device__ __forceinline__ unsigned xb_ld(unsigned* p)              { return __hip_atomic_load(p, __ATOMIC_RELAXED, __HIP_MEMORY_SCOPE_AGENT); }
__device__ __forceinline__ unsigned xb_add(unsigned* p, unsigned v) { return __hip_atomic_fetch_add(p, v, __ATOMIC_RELAXED, __HIP_MEMORY_SCOPE_AGENT); }
__device__ __forceinline__ unsigned xb_xcc_id() { return (unsigned)__builtin_amdgcn_s_getreg((3 << 11) | 20) & 0xFu; }
#define XB_SPIN(cond, bar) do { unsigned _sp = 0; while (cond) { __builtin_amdgcn_s_sleep(1); \
    if ((++_sp & 255u) == 0u) { if (xb_ld(&(bar)[XB_TMO])) break; if (_sp > XB_SPIN_CAP) { atomicAdd(&(bar)[XB_TMO], 1u); break; } } } } while (0)
struct XcdBarrier { unsigned* bar; unsigned x; volatile LAS unsigned* st; };
__device__ __forceinline__ XcdBarrier xcd_barrier_post(unsigned* bar, volatile LAS unsigned* st) {
    XcdBarrier b; b.bar = bar; b.x = xb_xcc_id(); b.st = st;
    if (threadIdx.x == 0) (void)xb_add(&bar[XB_XCNT(b.x)], 1u);
    return b;
}
__device__ __forceinline__ void xcd_barrier_complete(unsigned* bar, unsigned x, unsigned& nloc, unsigned& nx) {
    const unsigned G = gridDim.x * gridDim.y * gridDim.z;
    unsigned sum, cnt, mine, sp = 0u;
    for (;;) {
        sum = 0u; cnt = 0u; mine = 0u;
#pragma unroll
        for (unsigned j = 0; j < 16; ++j) { const unsigned c = xb_ld(&bar[XB_XCNT(j)]); sum += c; cnt += (c > 0u) ? 1u : 0u; mine = (j == x) ? c : mine; }
        if (sum == G) break;
        __builtin_amdgcn_s_sleep(1);
        if ((++sp & 255u) == 0u) { if (xb_ld(&bar[XB_TMO])) break; if (sp > XB_SPIN_CAP) { atomicAdd(&bar[XB_TMO], 1u); break; } }
    }
    nloc = mine > 0u ? mine : 1u; nx = cnt > 0u ? cnt : 1u;
}
__device__ __forceinline__ void xcd_barrier(const XcdBarrier& b) {
    asm volatile("s_waitcnt vmcnt(0)" ::: "memory");
    __syncthreads();
    if (threadIdx.x == 0) {
        unsigned* bar = b.bar;
        __builtin_amdgcn_s_waitcnt(0);
        unsigned nloc = b.st[0], nx = b.st[1];
        if (nloc == 0u) { xcd_barrier_complete(bar, b.x, nloc, nx); b.st[0] = nloc; b.st[1] = nx; }
        const unsigned old = xb_add(&bar[XB_XSUB(b.x)], 1u);
        const unsigned gen = old / nloc;
        if (old + 1u == (gen + 1u) * nloc) {
            __builtin_amdgcn_fence(__ATOMIC_RELEASE, "agent");
            asm volatile("s_waitcnt vmcnt(0)" ::: "memory");
            const unsigned og = xb_add(&bar[XB_TOP], 1u);
            const unsigned tg = og / nx;
            if (og + 1u == (tg + 1u) * nx) xb_add(&bar[XB_TOPGEN], 1u);
            else XB_SPIN(xb_ld(&bar[XB_TOPGEN]) == tg, bar);
            __builtin_amdgcn_fence(__ATOMIC_ACQUIRE, "agent");
            xb_add(&bar[XB_XGEN(b.x)], 1u);
            asm volatile("s_waitcnt vmcnt(0)" ::: "memory");
        } else {
            XB_SPIN(xb_ld(&bar[XB_XGEN(b.x)]) == gen, bar);
            __builtin_amdgcn_fence(__ATOMIC_ACQUIRE, "agent");
            asm volatile("s_waitcnt vmcnt(0)" ::: "memory");
        }
    }
    __syncthreads();
}
using pg8::Unit; using pg8::cvt_pk_bf16;
#define EPI_ROWCOL_PERM() const int row0 = u.pm * 256 + wr * 64 + fr, colt = wc * 32 + 8 * fq
struct EpiProj {
    static constexpr bool PERM = true, MIDK = false;
    bf16* O;
    __device__ __forceinline__ void operator()(const f32x4 (&acc)[2][2][4][2], const Unit& u, int wr, int wc, int fr, int fq) const {
        EPI_ROWCOL_PERM();
        const bool sg = (u.pn >= 12 && u.pn < 16) || (u.pn >= 56);
#pragma unroll
        for (int ai = 0; ai < 2; ++ai)
#pragma unroll
            for (int m = 0; m < 4; ++m) { bf16* rowp = O + (size_t)(row0 + ai * 128 + m * 16) * NPROJ + u.pn * 256 + colt;
#pragma unroll
                for (int bj = 0; bj < 2; ++bj) { f32x4 v0 = acc[ai][bj][m][0], v1 = acc[ai][bj][m][1];
                    if (sg) {
#pragma unroll
                        for (int j = 0; j < 4; ++j) { v0[j] = sigmoid_f(v0[j]); v1[j] = sigmoid_f(v1[j]); } }
                    v4u w; w.x = cvt_pk_bf16(v0[0], v0[1]); w.y = cvt_pk_bf16(v0[2], v0[3]); w.z = cvt_pk_bf16(v1[0], v1[1]); w.w = cvt_pk_bf16(v1[2], v1[3]);
                    __builtin_nontemporal_store(w, (v4u*)(rowp + bj * 128)); } }
    }
};
struct EpiGlu {
    static constexpr bool PERM = true, MIDK = false;
    bf16* O; int ldc;
    __device__ __forceinline__ void operator()(const f32x4 (&acc)[2][2][4][2], const Unit& u, int wr, int wc, int fr, int fq) const {
        EPI_ROWCOL_PERM();
#pragma unroll
        for (int ai = 0; ai < 2; ++ai)
#pragma unroll
            for (int m = 0; m < 4; ++m) { bf16* rowp = O + (size_t)(row0 + ai * 128 + m * 16) * ldc + u.pn * 128 + colt;
                f32x4 v0 = acc[ai][0][m][0], v1 = acc[ai][0][m][1]; const f32x4 g0 = acc[ai][1][m][0], g1 = acc[ai][1][m][1];
#pragma unroll
                for (int j = 0; j < 4; ++j) { v0[j] *= sigmoid_f(g0[j]); v1[j] *= sigmoid_f(g1[j]); }
                v4u w; w.x = cvt_pk_bf16(v0[0], v0[1]); w.y = cvt_pk_bf16(v0[2], v0[3]); w.z = cvt_pk_bf16(v1[0], v1[1]); w.w = cvt_pk_bf16(v1[2], v1[3]);
                *(v4u*)rowp = w; }
    }
};
struct EpiMerge {
    static constexpr bool PERM = true, MIDK = true;
    const bf16* G; bf16* O;
    __device__ __forceinline__ void mid(f32x4 (&acc)[2][2][4][2], const Unit& u, int t, int wr, int wc, int fr, int fq) const {
        unsigned voff = (unsigned)(fr * NPROJ + wc * 32 + 8 * fq) * 2u; asm volatile("" : "+v"(voff));
        int pmz = u.pm; asm volatile("" : "+s"(pmz));
#if defined(ABL_HOOKFREE_A)
        return;
#endif
        const int br = (t >> 4) - 1;
        const char* ub = (const char*)G + ((size_t)(pmz * 256 + wr * 64) * NPROJ + br * 2048 + u.pn * 256) * 2;
#pragma unroll
        for (int ai = 0; ai < 2; ++ai)
#pragma unroll
            for (int m = 0; m < 4; ++m) { const char* rb = ub + (size_t)(ai * 128 + m * 16) * NPROJ * 2;
#pragma unroll
                for (int bj = 0; bj < 2; ++bj) { const v4u sp = *(const v4u*)(rb + bj * 256 + voff), sn = *(const v4u*)(rb + 4096 + bj * 256 + voff);
                    f32x4 r0, r1;
                    r0[0] = bflo(sp.x) * __builtin_amdgcn_rcpf(fmaxf(bflo(sn.x), 1e-30f)); r0[1] = bfhi(sp.x) * __builtin_amdgcn_rcpf(fmaxf(bfhi(sn.x), 1e-30f));
                    r0[2] = bflo(sp.y) * __builtin_amdgcn_rcpf(fmaxf(bflo(sn.y), 1e-30f)); r0[3] = bfhi(sp.y) * __builtin_amdgcn_rcpf(fmaxf(bfhi(sn.y), 1e-30f));
                    r1[0] = bflo(sp.z) * __builtin_amdgcn_rcpf(fmaxf(bflo(sn.z), 1e-30f)); r1[1] = bfhi(sp.z) * __builtin_amdgcn_rcpf(fmaxf(bfhi(sn.z), 1e-30f));
                    r1[2] = bflo(sp.w) * __builtin_amdgcn_rcpf(fmaxf(bflo(sn.w), 1e-30f)); r1[3] = bfhi(sp.w) * __builtin_amdgcn_rcpf(fmaxf(bfhi(sn.w), 1e-30f));
                    acc[ai][bj][m][0] *= r0; acc[ai][bj][m][1] *= r1; }
                if (m & 1) asm volatile("" ::: "memory"); }
    }
    __device__ __forceinline__ void operator()(const f32x4 (&acc)[2][2][4][2], const Unit& u, int wr, int wc, int fr, int fq) const {
        EPI_ROWCOL_PERM();
#pragma unroll
        for (int ai = 0; ai < 2; ++ai)
#pragma unroll
            for (int m = 0; m < 4; ++m) { const size_t row = (size_t)(row0 + ai * 128 + m * 16); const bf16* gp = G + row * NPROJ + ABL_FINAL_GATE * 2048 + u.pn * 256 + colt; bf16* op = O + row * 2048 + u.pn * 256 + colt;
#pragma unroll
                for (int bj = 0; bj < 2; ++bj) { const v4u sc = *(const v4u*)(gp + bj * 128); f32x4 v0 = acc[ai][bj][m][0], v1 = acc[ai][bj][m][1];
                    v0[0] *= bflo(sc.x); v0[1] *= bfhi(sc.x); v0[2] *= bflo(sc.y); v0[3] *= bfhi(sc.y); v1[0] *= bflo(sc.z); v1[1] *= bfhi(sc.z); v1[2] *= bflo(sc.w); v1[3] *= bfhi(sc.w);
                    v4u w; w.x = cvt_pk_bf16(v0[0], v0[1]); w.y = cvt_pk_bf16(v0[2], v0[3]); w.z = cvt_pk_bf16(v1[0], v1[1]); w.w = cvt_pk_bf16(v1[2], v1[3]);
                    *(v4u*)(op + bj * 128) = w; }
                asm volatile("" ::: "memory"); }
    }
};
template <bool WB>
struct EpiResidT {
    static constexpr bool PERM = false, MIDK = false;
    const float* base; float* out; float sc;
    __device__ __forceinline__ void operator()(const f32x4 (&acc)[2][2][4][2], const Unit& u, int wr, int wc, int fr, int fq) const {
        const int row0 = u.pm * 256 + wr * 64 + fr, col0 = u.pn * 256 + wc * 32 + 4 * fq;
        bf16* xbp = nullptr; float* partp = nullptr;
        if constexpr (WB) {
            const __attribute__((address_space(4))) unsigned long long* ka = (const __attribute__((address_space(4))) unsigned long long*)__builtin_amdgcn_kernarg_segment_ptr();
            unsigned char* wsb = (unsigned char*)(GAS unsigned char*)ka[27]; xbp = (bf16*)(wsb + WS_XN); partp = (float*)(wsb + WS_Y); }
#pragma unroll
        for (int ai = 0; ai < 2; ++ai)
#pragma unroll
            for (int m = 0; m < 4; ++m) { const size_t off = (size_t)(row0 + ai * 128 + m * 16) * DM + col0; float ss = 0.f;
#pragma unroll
                for (int bj = 0; bj < 2; ++bj)
#pragma unroll
                    for (int n = 0; n < 2; ++n) { const f32x4 bs = *(const f32x4*)(base + off + bj * 128 + n * 16); const f32x4 r = WB ? (bs + acc[ai][bj][m][n]) : (bs + sc * acc[ai][bj][m][n]); *(f32x4*)(out + off + bj * 128 + n * 16) = r;
                        if constexpr (WB) { v2u w; w.x = pk2(r[0], r[1]); w.y = pk2(r[2], r[3]); *(v2u*)(xbp + off + bj * 128 + n * 16) = w; ss += (r[0] * r[0] + r[1] * r[1]) + (r[2] * r[2] + r[3] * r[3]); } }
                if constexpr (WB) { ss += __shfl_xor(ss, 16); ss += __shfl_xor(ss, 32); if (fq == 0) partp[(size_t)(row0 + ai * 128 + m * 16) * 32 + u.pn * 4 + wc] = ss; }
                asm volatile("" ::: "memory"); }
    }
};
typedef EpiResidT<false> EpiResid;
struct EpiFF1 {
    static constexpr bool PERM = true, MIDK = false;
    bf16* O; const float* rstd;
    __device__ __forceinline__ void operator()(const f32x4 (&acc)[2][2][4][2], const Unit& u, int wr, int wc, int fr, int fq) const {
        EPI_ROWCOL_PERM();
#pragma unroll
        for (int ai = 0; ai < 2; ++ai)
#pragma unroll
            for (int m = 0; m < 4; ++m) { bf16* rowp = O + (size_t)(row0 + ai * 128 + m * 16) * FF + u.pn * 256 + colt; const float rs = rstd[row0 + ai * 128 + m * 16];
#pragma unroll
                for (int bj = 0; bj < 2; ++bj) { f32x4 v0 = acc[ai][bj][m][0], v1 = acc[ai][bj][m][1];
#pragma unroll
                    for (int j = 0; j < 4; ++j) { const float a = fmaxf(v0[j], 0.f) * rs, b = fmaxf(v1[j], 0.f) * rs; v0[j] = a * a; v1[j] = b * b; }
                    v4u w; w.x = cvt_pk_bf16(v0[0], v0[1]); w.y = cvt_pk_bf16(v0[2], v0[3]); w.z = cvt_pk_bf16(v1[0], v1[1]); w.w = cvt_pk_bf16(v1[2], v1[3]);
                    __builtin_nontemporal_store(w, (v4u*)(rowp + bj * 128)); } }
    }
};
__device__ const unsigned char T5B[3][129] = {
 {0,1,2,3,4,5,6,7,8,9,10,11,12,13,14,15,16,16,16,16,16,16,17,17,17,17,17,17,17,17,18,18,18,18,18,18,18,18,18,18,19,19,19,19,19,19,19,19,19,19,19,19,19,19,20,20,20,20,20,20,20,20,20,20,20,20,20,20,20,20,20,20,20,21,21,21,21,21,21,21,21,21,21,21,21,21,21,21,21,21,21,21,21,21,21,21,21,21,21,22,22,22,22,22,22,22,22,22,22,22,22,22,22,22,22,22,22,22,22,22,22,22,22,22,22,22,22,22,22},
 {0,4,8,12,16,16,17,17,18,18,19,19,19,19,20,20,20,20,20,21,21,21,21,21,21,22,22,22,22,22,22,22,22,22,23,23,23,23,23,23,23,23,23,23,23,23,24,24,24,24,24,24,24,24,24,24,24,24,24,24,24,24,25,25,25,25,25,25,25,25,25,25,25,25,25,25,25,25,25,25,25,25,25,26,26,26,26,26,26,26,26,26,26,26,26,26,26,26,26,26,26,26,26,26,26,26,26,26,26,26,26,26,26,27,27,27,27,27,27,27,27,27,27,27,27,27,27,27,27},
 {0,16,18,19,20,21,21,22,22,23,23,23,24,24,24,24,25,25,25,25,25,26,26,26,26,26,26,26,26,27,27,27,27,27,27,27,27,27,27,28,28,28,28,28,28,28,28,28,28,28,28,28,29,29,29,29,29,29,29,29,29,29,29,29,29,29,29,29,29,29,30,30,30,30,30,30,30,30,30,30,30,30,30,30,30,30,30,30,30,30,30,30,30,30,30,31,31,31,31,31,31,31,31,31,31,31,31,31,31,31,31,31,31,31,31,31,31,31,31,31,31,31,31,31,31,31,31,31,31}};

__device__ __forceinline__ void tr_item(const float* W, int ldw, int k0, int c0, bf16* WT, int ldt, int r0, int kd0, LAS float* scr, int lane) {
#pragma unroll 8
    for (int i = 0; i < 32; ++i) { const int kk = 2 * i + (lane >> 5); scr[kk * 33 + (lane & 31)] = W[(size_t)(k0 + kk) * ldw + c0 + (lane & 31)]; }
    LDS_WAIT(); asm volatile("" ::: "memory");
    const int c = lane & 7;
#pragma unroll
    for (int j = 0; j < 4; ++j) { const int n = (lane >> 3) + 8 * j; const LAS float* s = scr + (8 * c) * 33 + n;
        v4u o; o.x = pk2(s[0 * 33], s[1 * 33]); o.y = pk2(s[2 * 33], s[3 * 33]); o.z = pk2(s[4 * 33], s[5 * 33]); o.w = pk2(s[6 * 33], s[7 * 33]);
        *(v4u*)(WT + (size_t)(r0 + n) * ldt + kd0 + k0 + 8 * c) = o; }
    LDS_WAIT(); asm volatile("" ::: "memory");
}
__device__ __forceinline__ void tr_item64(const float* W, int ldw, int k0, int c0, bf16* WT, int ldt, int r0, int kd0, int lane, const float* kg = nullptr) {
    const int kq = lane >> 4, nq = lane & 15;
    const float* src = W + (size_t)(k0 + 16 * kq) * ldw + c0 + 4 * nq;
    f32x4 v[16];
#pragma unroll
    for (int j = 0; j < 16; ++j) v[j] = *(const f32x4*)(src + (size_t)j * ldw);
    if (kg) {
#pragma unroll
        for (int j = 0; j < 16; ++j) v[j] *= kg[k0 + 16 * kq + j]; }
    bf16* dst = WT + (size_t)(r0 + 4 * nq) * ldt + kd0 + k0 + 16 * kq;
#pragma unroll
    for (int e = 0; e < 4; ++e) { v4u o0, o1;
        o0.x = pk2(v[0][e], v[1][e]); o0.y = pk2(v[2][e], v[3][e]); o0.z = pk2(v[4][e], v[5][e]); o0.w = pk2(v[6][e], v[7][e]);
        o1.x = pk2(v[8][e], v[9][e]); o1.y = pk2(v[10][e], v[11][e]); o1.z = pk2(v[12][e], v[13][e]); o1.w = pk2(v[14][e], v[15][e]);
        *(v4u*)(dst + (size_t)e * ldt) = o0; *(v4u*)(dst + (size_t)e * ldt + 8) = o1; }
}
__device__ __forceinline__ void wconv_phase(const float* w_in, const float* w_glu, const float* w_a, const float* w_b, const float* w_c, const float* w_out, const float* w_1, const float* w_2, const float* g2, unsigned char* ws, LAS unsigned char* lds, int gw, int NGW, int wave, int lane) {
    bf16* WIN = (bf16*)(ws + WS_WIN); bf16* WGLU = (bf16*)(ws + WS_WGLU); bf16* WBR = (bf16*)(ws + WS_WBR); bf16* WOUT = (bf16*)(ws + WS_WOUT); bf16* W1 = (bf16*)(ws + WS_W1); bf16* W2 = (bf16*)(ws + WS_W2);
    constexpr int I_IN = 32 * 320, I_GLU = 16 * 32, I_BR = 16 * 32, I_OUT = 32 * 32, I_1 = 32 * 128, I_2 = 128 * 32;
    constexpr int NITEMS = I_IN + I_GLU + 3 * I_BR + I_OUT + I_1 + I_2;
    for (int it = gw; it < NITEMS; it += NGW) {
        int r = it;
        if (r < I_IN) { const int kb = r / 320, nb = r % 320, n0 = 64 * nb; tr_item64(w_in, N_IN, 64 * kb, n0 < 4096 ? n0 : n0 + 8, WIN, DM, n0, 0, lane); continue; } r -= I_IN;
        if (r < I_GLU) { const int kb = r / 32, nb = r % 32, n0 = 64 * nb; const int pn = n0 >> 8, bj = (n0 >> 7) & 1, j = n0 & 127; tr_item64(w_glu, 2048, 64 * kb, bj * 1024 + pn * 128 + j, WGLU, 1024, n0, 0, lane); continue; } r -= I_GLU;
        if (r < 3 * I_BR) { const int br = r / I_BR, q = r % I_BR, kb = q / 32, nb = q % 32; if (br == 0) tr_item64(w_a, DM, 64 * kb, 64 * nb, WBR, 3072, 64 * nb, 0, lane); else if (br == 1) tr_item64(w_b, DM, 64 * kb, 64 * nb, WBR, 3072, 64 * nb, 1024, lane); else tr_item64(w_c, DM, 64 * kb, 64 * nb, WBR, 3072, 64 * nb, 2048, lane); continue; } r -= 3 * I_BR;
        if (r < I_OUT) { const int kb = r / 32, nb = r % 32; tr_item64(w_out, DM, 64 * kb, 64 * nb, WOUT, DM, 64 * nb, 0, lane); continue; } r -= I_OUT;
        if (r < I_1) { const int kb = r / 128, nb = r % 128; tr_item64(w_1, FF, 64 * kb, 64 * nb, W1, DM, 64 * nb, 0, lane, g2); continue; } r -= I_1;
        { const int kb = r / 32, nb = r % 32; tr_item64(w_2, DM, 64 * kb, 64 * nb, W2, FF, 64 * nb, 0, lane); }
    }
}

template <bool DO_IF>
__device__ __forceinline__ void norm_phase(const float* X, const float* gain, bf16* XN, const LAS float* IFW, const float* bi, const float* bfg, float* IFG, int gw, int NGW, int lane) {
    f32x4 gv[8];
#pragma unroll
    for (int j = 0; j < 8; ++j) gv[j] = *(const f32x4*)(gain + 4 * lane + 256 * j);
    for (int m4 = gw; m4 < M / 4; m4 += NGW)
    for (int r4 = 0; r4 < 4; ++r4) { const int m = 4 * m4 + r4;
        const f32x4* xr = (const f32x4*)(X + (size_t)m * DM) + lane;
        f32x4 v[8]; float ss = 0.f;
#pragma unroll
        for (int j = 0; j < 8; ++j) { v[j] = xr[64 * j]; ss += (v[j].x * v[j].x + v[j].y * v[j].y) + (v[j].z * v[j].z + v[j].w * v[j].w); }
        const float rstd = 1.0f / sqrtf(wave_sum(ss) * (1.0f / DM) + NORM_EPS);
        v2u* o8 = (v2u*)(XN + (size_t)m * DM) + lane;
#pragma unroll
        for (int j = 0; j < 8; ++j) { v[j] = (v[j] * rstd) * gv[j]; v2u w; w.x = pk2(v[j].x, v[j].y); w.y = pk2(v[j].z, v[j].w); o8[64 * j] = w; }
        if constexpr (DO_IF) {
            float p[8];
#pragma unroll
            for (int c = 0; c < 8; ++c) p[c] = 0.f;
#pragma unroll
            for (int j = 0; j < 8; ++j)
#pragma unroll
                for (int e = 0; e < 4; ++e) { const int d = 4 * lane + 256 * j + e; const f32x4 w0 = *(const LAS f32x4*)(IFW + d * 8), w1 = *(const LAS f32x4*)(IFW + d * 8 + 4); const float xv = v[j][e];
                    p[0] += xv * w0.x; p[1] += xv * w0.y; p[2] += xv * w0.z; p[3] += xv * w0.w; p[4] += xv * w1.x; p[5] += xv * w1.y; p[6] += xv * w1.z; p[7] += xv * w1.w;
                    if (e == 3) asm volatile("" ::: "memory"); }
#pragma unroll
            for (int c = 0; c < 8; ++c) p[c] = wave_sum(p[c]);
            if (lane < 8) {
                float val = p[0];
#pragma unroll
                for (int c = 1; c < 8; ++c) val = (lane == c) ? p[c] : val;
                if (lane < 4) val += bi[lane];
                else { const float xg = val + bfg[lane - 4]; val = fminf(xg, 0.f) - log1pf(expf(-fabsf(xg))); }
                IFG[(size_t)m * 8 + lane] = val;
            }
        }
    }
}

__device__ __forceinline__ void mconv_phase(const bf16* PROJ, const float* cw, const float* cb, bf16* QKC, int gtid, int NGT) {
    for (int job = gtid; job < 256 * (M / 64); job += NGT) {
        const int cg = job & 255, run = job >> 8, c0 = cg * 8, m0 = run * 64;
        float w[4][8], bb[8];
#pragma unroll
        for (int j = 0; j < 4; ++j) { const f32x4 a = *(const f32x4*)(cw + j * 2048 + c0), b = *(const f32x4*)(cw + j * 2048 + c0 + 4); w[j][0] = a.x; w[j][1] = a.y; w[j][2] = a.z; w[j][3] = a.w; w[j][4] = b.x; w[j][5] = b.y; w[j][6] = b.z; w[j][7] = b.w; }
        { const f32x4 a = *(const f32x4*)(cb + c0), b = *(const f32x4*)(cb + c0 + 4); bb[0] = a.x; bb[1] = a.y; bb[2] = a.z; bb[3] = a.w; bb[4] = b.x; bb[5] = b.y; bb[6] = b.z; bb[7] = b.w; }
        const float osc = (c0 >= 1024) ? 0.0625f : 1.0f;
        float h0[8], h1[8], h2[8];
        const bool first = (m0 % SEQ) == 0;
#pragma unroll
        for (int e = 0; e < 8; ++e) { h0[e] = 0.f; h1[e] = 0.f; h2[e] = 0.f; }
        if (!first) {
            const v4u a = *(const v4u*)(PROJ + (size_t)(m0 - 3) * NPROJ + c0), b = *(const v4u*)(PROJ + (size_t)(m0 - 2) * NPROJ + c0), c = *(const v4u*)(PROJ + (size_t)(m0 - 1) * NPROJ + c0);
            h0[0] = bflo(a.x); h0[1] = bfhi(a.x); h0[2] = bflo(a.y); h0[3] = bfhi(a.y); h0[4] = bflo(a.z); h0[5] = bfhi(a.z); h0[6] = bflo(a.w); h0[7] = bfhi(a.w);
            h1[0] = bflo(b.x); h1[1] = bfhi(b.x); h1[2] = bflo(b.y); h1[3] = bfhi(b.y); h1[4] = bflo(b.z); h1[5] = bfhi(b.z); h1[6] = bflo(b.w); h1[7] = bfhi(b.w);
            h2[0] = bflo(c.x); h2[1] = bfhi(c.x); h2[2] = bflo(c.y); h2[3] = bfhi(c.y); h2[4] = bflo(c.z); h2[5] = bfhi(c.z); h2[6] = bflo(c.w); h2[7] = bfhi(c.w);
        }
#pragma unroll 4
        for (int r = 0; r < 64; ++r) {
            const v4u a = *(const v4u*)(PROJ + (size_t)(m0 + r) * NPROJ + c0);
            float x[8]; x[0] = bflo(a.x); x[1] = bfhi(a.x); x[2] = bflo(a.y); x[3] = bfhi(a.y); x[4] = bflo(a.z); x[5] = bfhi(a.z); x[6] = bflo(a.w); x[7] = bfhi(a.w);
            float y[8];
#pragma unroll
            for (int e = 0; e < 8; ++e) { const float s = bb[e] + w[0][e] * h0[e] + w[1][e] * h1[e] + w[2][e] * h2[e] + w[3][e] * x[e]; y[e] = s * sigmoid_f(s) * osc; h0[e] = h1[e]; h1[e] = h2[e]; h2[e] = x[e]; }
            v4u o; o.x = pk2(y[0], y[1]); o.y = pk2(y[2], y[3]); o.z = pk2(y[4], y[5]); o.w = pk2(y[6], y[7]);
            *(v4u*)(QKC + (size_t)(m0 + r) * 2048 + c0) = o;
        }
    }
}

__device__ __forceinline__ void mlstm_rec_phase(const bf16* QKC, const bf16* PROJ, const float* IFG, float* HM, int unit0, int ustride, int wave, int lane) {
    for (int unit = unit0; unit < 256; unit += ustride) {
        const int b = unit >> 7, h = (unit >> 5) & 3, e = (unit & 31) * 8 + wave;
        float C[4] = {0.f, 0.f, 0.f, 0.f}, nn[4] = {0.f, 0.f, 0.f, 0.f};
        const size_t mb = (size_t)b * SEQ;
        const bf16* qp = QKC + mb * 2048 + h * 256 + 4 * lane;
        const bf16* kp = qp + 1024;
        const bf16* vp = PROJ + mb * NPROJ + PV + h * 256 + e;
        const float* gp = IFG + mb * 8 + h;
        float* hp = HM + mb * 1024 + h * 256 + e;
        v2u qv[4], kv[4]; bf16 vv[4]; float ig[4], lf[4];
#pragma unroll
        for (int j = 0; j < 4; ++j) { qv[j] = *(const v2u*)(qp + (size_t)j * 2048); kv[j] = *(const v2u*)(kp + (size_t)j * 2048); vv[j] = vp[(size_t)j * NPROJ]; ig[j] = gp[j * 8]; lf[j] = gp[j * 8 + 4]; }
        for (int t0 = 0; t0 < SEQ; t0 += 4) {
            v2u qn[4], kn[4]; bf16 vn[4]; float ign[4], lfn[4];
            const int t1 = (t0 + 4 < SEQ) ? t0 + 4 : t0;
#pragma unroll
            for (int j = 0; j < 4; ++j) { qn[j] = *(const v2u*)(qp + (size_t)(t1 + j) * 2048); kn[j] = *(const v2u*)(kp + (size_t)(t1 + j) * 2048); vn[j] = vp[(size_t)(t1 + j) * NPROJ]; ign[j] = gp[(t1 + j) * 8]; lfn[j] = gp[(t1 + j) * 8 + 4]; }
            float pn[4], pd[4];
#pragma unroll
            for (int j = 0; j < 4; ++j) {
                const float fi = __expf(lf[j]), ii = __expf(ig[j]), iv = ii * bf1(vv[j]);
                const float q0 = bflo(qv[j].x), q1 = bfhi(qv[j].x), q2 = bflo(qv[j].y), q3 = bfhi(qv[j].y);
                const float k0 = bflo(kv[j].x), k1 = bfhi(kv[j].x), k2 = bflo(kv[j].y), k3 = bfhi(kv[j].y);
                C[0] = fi * C[0] + iv * k0; C[1] = fi * C[1] + iv * k1; C[2] = fi * C[2] + iv * k2; C[3] = fi * C[3] + iv * k3;
                nn[0] = fi * nn[0] + ii * k0; nn[1] = fi * nn[1] + ii * k1; nn[2] = fi * nn[2] + ii * k2; nn[3] = fi * nn[3] + ii * k3;
                pn[j] = (C[0] * q0 + C[1] * q1) + (C[2] * q2 + C[3] * q3);
                pd[j] = (nn[0] * q0 + nn[1] * q1) + (nn[2] * q2 + nn[3] * q3);
            }
#pragma unroll
            for (int j = 0; j < 4; ++j) { pn[j] = wave_sum(pn[j]); pd[j] = wave_sum(pd[j]); }
            if (lane == 0) {
#pragma unroll
                for (int j = 0; j < 4; ++j) hp[(size_t)(t0 + j) * 1024] = pn[j] / fmaxf(fabsf(pd[j]), 1.0f);
            }
#pragma unroll
            for (int j = 0; j < 4; ++j) { qv[j] = qn[j]; kv[j] = kn[j]; vv[j] = vn[j]; ig[j] = ign[j]; lf[j] = lfn[j]; }
        }
    }
}

__device__ __forceinline__ void mnorm_phase(const float* HM, const bf16* PROJ, const float* mg, bf16* Y, int gw, int NGW, int lane) {
    f32x4 gv[4];
#pragma unroll
    for (int j = 0; j < 4; ++j) gv[j] = *(const f32x4*)(mg + 16 * lane + 4 * j);
    for (int m = gw; m < M; m += NGW) {
        f32x4 v[4]; float ss = 0.f;
#pragma unroll
        for (int j = 0; j < 4; ++j) { v[j] = *(const f32x4*)(HM + (size_t)m * 1024 + 16 * lane + 4 * j); ss += (v[j].x * v[j].x + v[j].y * v[j].y) + (v[j].z * v[j].z + v[j].w * v[j].w); }
        ss += __shfl_xor(ss, 1); ss += __shfl_xor(ss, 2); ss += __shfl_xor(ss, 4); ss += __shfl_xor(ss, 8);
        const float r = 1.0f / sqrtf(ss * (1.0f / 256.0f) + NORM_EPS);
        const v4u o0 = *(const v4u*)(PROJ + (size_t)m * NPROJ + PO + 16 * lane), o1 = *(const v4u*)(PROJ + (size_t)m * NPROJ + PO + 16 * lane + 8);
        const float og[16] = {bflo(o0.x), bfhi(o0.x), bflo(o0.y), bfhi(o0.y), bflo(o0.z), bfhi(o0.z), bflo(o0.w), bfhi(o0.w), bflo(o1.x), bfhi(o1.x), bflo(o1.y), bfhi(o1.y), bflo(o1.z), bfhi(o1.z), bflo(o1.w), bfhi(o1.w)};
        float y[16];
#pragma unroll
        for (int j = 0; j < 4; ++j)
#pragma unroll
            for (int e = 0; e < 4; ++e) y[4 * j + e] = ABL_SA * og[4 * j + e] * ((v[j][e] * r) * gv[j][e]);
        v4u w0, w1; w0.x = pk2(y[0], y[1]); w0.y = pk2(y[2], y[3]); w0.z = pk2(y[4], y[5]); w0.w = pk2(y[6], y[7]); w1.x = pk2(y[8], y[9]); w1.y = pk2(y[10], y[11]); w1.z = pk2(y[12], y[13]); w1.w = pk2(y[14], y[15]);
        *(v4u*)(Y + (size_t)m * 3072 + 16 * lane) = w0; *(v4u*)(Y + (size_t)m * 3072 + 16 * lane + 8) = w1;
    }
}

__device__ __forceinline__ void attn_fill_bias(const float* rel_bias, LAS float* BT, int tid) {
    for (int i = tid; i < 3 * 129 * 8; i += NTHR) { const int hs = i & 7, n = (i >> 3) % 129, g = (i >> 3) / 129; BT[i] = rel_bias[T5B[g][n] * 24 + g * 8 + hs]; }
}
__device__ __forceinline__ void attn_simple_phase(const bf16* PROJ, const LAS float* BT, bf16* Y, int gw, int NGW, int lane) {
    const int quad = lane >> 2, sub = lane & 3;
    for (int job = gw; job < (M / 16) * 8; job += NGW) {
        const int hs = job & 7, m = (job >> 3) * 16 + quad, b = m / SEQ, t = m % SEQ;
        float mx = -1e30f, l = 0.f, acc[32];
#pragma unroll
        for (int i = 0; i < 32; ++i) acc[i] = 0.f;
        for (int g = 0; g < 3; ++g) {
            const int r = (g == 0) ? 1 : (g == 1 ? 4 : 16), hh = g * 8 + hs;
            float q[32];
            { const v4u* qr = (const v4u*)(PROJ + (size_t)m * NPROJ + PAQ + hh * 128 + sub * 32);
#pragma unroll
              for (int i = 0; i < 4; ++i) { const v4u a = qr[i]; q[8 * i + 0] = bflo(a.x); q[8 * i + 1] = bfhi(a.x); q[8 * i + 2] = bflo(a.y); q[8 * i + 3] = bfhi(a.y); q[8 * i + 4] = bflo(a.z); q[8 * i + 5] = bfhi(a.z); q[8 * i + 6] = bflo(a.w); q[8 * i + 7] = bfhi(a.w); }
#pragma unroll
              for (int i = 0; i < 32; ++i) q[i] *= 0.08838834764831845f; }
            const bf16* kb = PROJ + (size_t)b * SEQ * NPROJ + PAK + hh * 128 + sub * 32;
            const bf16* vb = PROJ + (size_t)b * SEQ * NPROJ + PAV + hh * 128 + sub * 32;
            const LAS float* bt = BT + g * 129 * 8 + hs;
            for (int n = 0; n <= 128; ++n) {
                const int tk = t - n * r;
                if (tk >= 0) {
                    const v4u* kr = (const v4u*)(kb + (size_t)tk * NPROJ);
                    float dot = 0.f;
#pragma unroll
                    for (int i = 0; i < 4; ++i) { const v4u a = kr[i];
                        dot += q[8 * i + 0] * bflo(a.x) + q[8 * i + 1] * bfhi(a.x) + q[8 * i + 2] * bflo(a.y) + q[8 * i + 3] * bfhi(a.y) + q[8 * i + 4] * bflo(a.z) + q[8 * i + 5] * bfhi(a.z) + q[8 * i + 6] * bflo(a.w) + q[8 * i + 7] * bfhi(a.w); }
                    dot += __shfl_xor(dot, 1); dot += __shfl_xor(dot, 2);
                    const float s = dot + bt[n * 8];
                    const float mn = fmaxf(mx, s), corr = __expf(mx - mn), p = __expf(s - mn);
                    l = l * corr + p; mx = mn;
                    const v4u* vr = (const v4u*)(vb + (size_t)tk * NPROJ);
#pragma unroll
                    for (int i = 0; i < 4; ++i) { const v4u a = vr[i];
                        acc[8 * i + 0] = acc[8 * i + 0] * corr + p * bflo(a.x); acc[8 * i + 1] = acc[8 * i + 1] * corr + p * bfhi(a.x); acc[8 * i + 2] = acc[8 * i + 2] * corr + p * bflo(a.y); acc[8 * i + 3] = acc[8 * i + 3] * corr + p * bfhi(a.y);
                        acc[8 * i + 4] = acc[8 * i + 4] * corr + p * bflo(a.z); acc[8 * i + 5] = acc[8 * i + 5] * corr + p * bfhi(a.z); acc[8 * i + 6] = acc[8 * i + 6] * corr + p * bflo(a.w); acc[8 * i + 7] = acc[8 * i + 7] * corr + p * bfhi(a.w); }
                }
            }
        }
        const float inv = ABL_SB / l;
        v4u* op = (v4u*)(Y + (size_t)m * 3072 + 1024 + hs * 128 + sub * 32);
#pragma unroll
        for (int i = 0; i < 4; ++i) { v4u w; w.x = pk2(acc[8 * i + 0] * inv, acc[8 * i + 1] * inv); w.y = pk2(acc[8 * i + 2] * inv, acc[8 * i + 3] * inv); w.z = pk2(acc[8 * i + 4] * inv, acc[8 * i + 5] * inv); w.w = pk2(acc[8 * i + 6] * inv, acc[8 * i + 7] * inv); op[i] = w; }
    }
}

struct S5P { const float *lam_re, *lam_im, *log_dt, *b_re, *b_im, *c_re, *c_im, *d_skip; };
#define S5P_MAKE(sp, l) S5P sp; sp.lam_re = ARG(9) + (size_t)(l) * 4096; sp.lam_im = ARG(10) + (size_t)(l) * 4096; sp.log_dt = ARG(11) + (size_t)(l) * 64; \
    sp.b_re = ARG(12) + (size_t)(l) * 65536; sp.b_im = ARG(13) + (size_t)(l) * 65536; sp.c_re = ARG(14) + (size_t)(l) * 65536; sp.c_im = ARG(15) + (size_t)(l) * 65536; sp.d_skip = ARG(16) + (size_t)(l) * 1024
__device__ __forceinline__ void s5_disc(const S5P& P, int g, int p, float& are, float& aim, float& fre, float& fim) {
    const float dt = expf(P.log_dt[g]), lr = P.lam_re[g * 64 + p], li = P.lam_im[g * 64 + p];
    const float mag = expf(lr * dt), ang = li * dt;
    are = mag * cosf(ang); aim = mag * sinf(ang);
    const float nr = are - 1.0f, ni = aim, den = lr * lr + li * li;
    fre = (nr * lr + ni * li) / den; fim = (ni * lr - nr * li) / den;
}
template <bool OUT>
__device__ __forceinline__ void s5_scan_phase(const S5P& P, const bf16* PROJ, float* LOC, const float* CAR, bf16* Z, LAS float* xs  , int gw, int NGW, int lane) {
    for (int job = gw; job < 2 * 64 * 16; job += NGW) {
        const int c = job & 15, g = (job >> 4) & 63, b = job >> 10, p = lane;
        float are, aim, fre, fim; s5_disc(P, g, p, are, aim, fre, fim);
        float Br[16], Bi[16];
#pragma unroll
        for (int i = 0; i < 16; ++i) { const float br = P.b_re[(g * 64 + p) * 16 + i], bi = P.b_im[(g * 64 + p) * 16 + i]; Br[i] = fre * br - fim * bi; Bi[i] = fre * bi + fim * br; }
        float xr = 0.f, xi = 0.f;
        const size_t sidx = ((size_t)((b * 64 + g) * 16 + c) * 64 + p) * 2;
        float Cr[16], Ci[16], dsk = 0.f; const int o = lane & 15, qd = lane >> 4;
        if (OUT) { xr = CAR[sidx]; xi = CAR[sidx + 1];
#pragma unroll
            for (int j = 0; j < 16; ++j) { Cr[j] = P.c_re[(g * 16 + o) * 64 + qd * 16 + j]; Ci[j] = P.c_im[(g * 16 + o) * 64 + qd * 16 + j]; }
            dsk = P.d_skip[g * 16 + o]; }
        const bf16* up = PROJ + ((size_t)b * SEQ + c * 1024) * NPROJ + PU + g * 16;
        for (int t = 0; t < 1024; ++t) {
            const v4u u0 = *(const v4u*)(up + (size_t)t * NPROJ), u1 = *(const v4u*)(up + (size_t)t * NPROJ + 8);
            const float u[16] = {bflo(u0.x), bfhi(u0.x), bflo(u0.y), bfhi(u0.y), bflo(u0.z), bfhi(u0.z), bflo(u0.w), bfhi(u0.w), bflo(u1.x), bfhi(u1.x), bflo(u1.y), bfhi(u1.y), bflo(u1.z), bfhi(u1.z), bflo(u1.w), bfhi(u1.w)};
            float br = 0.f, bi = 0.f;
#pragma unroll
            for (int i = 0; i < 16; ++i) { br += Br[i] * u[i]; bi += Bi[i] * u[i]; }
            const float nr = are * xr - aim * xi + br, ni = are * xi + aim * xr + bi; xr = nr; xi = ni;
            if (OUT) {
                xs[p] = xr; xs[64 + p] = xi; LDS_WAIT();
                float s = 0.f;
#pragma unroll
                for (int j = 0; j < 16; ++j) s += Cr[j] * xs[qd * 16 + j] - Ci[j] * xs[64 + qd * 16 + j];
                LDS_WAIT();
                s += __shfl_xor(s, 16); s += __shfl_xor(s, 32);
                float uo = u[0];
#pragma unroll
                for (int j = 1; j < 16; ++j) uo = (o == j) ? u[j] : uo;
                const float y = s + dsk * uo;
                const float z = ABL_SC * 0.5f * y * (1.0f + tanhf(0.7978845608028654f * (y + 0.044715f * y * y * y)));
                if (qd == 0) Z[((size_t)b * SEQ + c * 1024 + t) * 1024 + g * 16 + o] = (bf16)f2bf(z);
            }
        }
        if (!OUT) { LOC[sidx] = xr; LOC[sidx + 1] = xi; }
    }
}
__device__ __forceinline__ void s5_carry_phase(const f32x4* DISC, const float* LOC, float* CAR, int gtid, int NGT) {
    for (int i = gtid; i < 2 * 64 * 64; i += NGT) {
        const int p = i & 63, g = (i >> 6) & 63, b = i >> 12;
        const f32x4 dq = DISC[g * 64 + p];
        float pr = dq[0], pi = dq[1];
#pragma unroll 1
        for (int k = 0; k < 10; ++k) { const float nr = pr * pr - pi * pi, ni = 2.0f * pr * pi; pr = nr; pi = ni; }
        float cr = 0.f, ci = 0.f; asm volatile("" : "+v"(cr), "+v"(ci));
        for (int c = 0; c < 16; ++c) {
            const size_t sidx = ((size_t)((b * 64 + g) * 16 + c) * 64 + p) * 2;
            CAR[sidx] = cr; CAR[sidx + 1] = ci;
            const float lr = LOC[sidx], li = LOC[sidx + 1];
            const float nr = pr * cr - pi * ci + lr, ni = pr * ci + pi * cr + li; cr = nr; ci = ni;
        }
    }
}
constexpr int AT_PITCH = 288, AT_KOFF = 0, AT_VOFF = 256 * AT_PITCH, AT_BTOFF = 2 * 256 * AT_PITCH;
typedef short s16x4 __attribute__((ext_vector_type(4)));
typedef short s16x8 __attribute__((ext_vector_type(8)));
__device__ __forceinline__ s16x4 tr_read4(LAS unsigned char* p) { return __builtin_bit_cast(s16x4, __builtin_amdgcn_ds_read_tr16_b64_v4i16((LAS s16x4*)p)); }
struct AtUnit { int b, hh, grp, r, c, qb; };
__device__ __forceinline__ AtUnit at_unit(int u) { AtUnit a; const int blk = u & 127; a.hh = (u >> 7) % 24; a.b = u / (128 * 24); a.grp = a.hh >> 3; a.r = a.grp == 0 ? 1 : (a.grp == 1 ? 4 : 16);
    const int nbq = 128 / a.r; a.c = blk / nbq; a.qb = blk % nbq; return a; }
__device__ __forceinline__ void at_issue_loads(const bf16* PROJ, const AtUnit& a, int tid, v4u (&kreg)[8], v4u (&vreg)[8]) {
#pragma unroll
    for (int it = 0; it < 8; ++it) { const int chunk = it * NTHR + tid, row = chunk >> 4, c16 = chunk & 15; int jk = a.qb * 128 - 128 + row; jk = jk < 0 ? 0 : jk;
        const bf16* src = PROJ + ((size_t)a.b * SEQ + a.c + (size_t)a.r * jk) * NPROJ + PAK + a.hh * 128 + c16 * 8;
        kreg[it] = *(const v4u*)src; vreg[it] = *(const v4u*)(src + (PAV - PAK)); }
}
__device__ __forceinline__ void attn_mfma_phase(const bf16* PROJ, const float* rel_bias, bf16* ATT, float* LSE, LAS unsigned char* lds, int bx, int G, int tid) {
    const int lane = tid & 63, w = __builtin_amdgcn_readfirstlane(tid >> 6), ql = lane & 15, g4 = lane >> 4;
    constexpr int NU = 2 * 24 * 128;
    constexpr float SC = 0.08838834764831845f * 1.4426950408889634f;
    v4u kreg[8], vreg[8];
    float btv = -1e30f;
    if (bx < NU) { const AtUnit a0 = at_unit(bx); at_issue_loads(PROJ, a0, tid, kreg, vreg);
        if (tid < 159) { const int n = 143 - tid; btv = (n >= 0 && n <= 128) ? rel_bias[T5B[a0.grp][n] * 24 + a0.hh] * 1.4426950408889634f : -1e30f; } }
    for (int u = bx; u < NU; u += G) {
        const AtUnit a = at_unit(u);
#pragma unroll
        for (int it = 0; it < 8; ++it) { const int chunk = it * NTHR + tid, row = chunk >> 4, c16 = chunk & 15;
            *(LAS v4u*)(lds + AT_KOFF + row * AT_PITCH + c16 * 16) = kreg[it]; *(LAS v4u*)(lds + AT_VOFF + row * AT_PITCH + c16 * 16) = vreg[it]; }
        if (tid < 159) ((LAS float*)(lds + AT_BTOFF))[tid] = btv;
        __syncthreads();
        if (u + G < NU) { const AtUnit an = at_unit(u + G); at_issue_loads(PROJ, an, tid, kreg, vreg);
            if (tid < 159) { const int n = 143 - tid; btv = (n >= 0 && n <= 128) ? rel_bias[T5B[an.grp][n] * 24 + an.hh] * 1.4426950408889634f : -1e30f; } }
        const int jq = a.qb * 128 + 16 * w + ql; const size_t mq = (size_t)a.b * SEQ + a.c + (size_t)a.r * jq;
        s16x8 qf[4];
#pragma unroll
        for (int ks = 0; ks < 4; ++ks) qf[ks] = *(const s16x8*)(PROJ + mq * NPROJ + PAQ + a.hh * 128 + 32 * ks + 8 * g4);
        f32x4 s[9];
#pragma unroll
        for (int kt = 0; kt < 9; ++kt) { f32x4 acc = {0.f, 0.f, 0.f, 0.f};
#pragma unroll
            for (int ks = 0; ks < 4; ++ks) { const s16x8 kf = *(const LAS s16x8*)(lds + AT_KOFF + (16 * (w + kt) + ql) * AT_PITCH + (32 * ks + 8 * g4) * 2);
                acc = __builtin_amdgcn_mfma_f32_16x16x32_bf16(kf, qf[ks], acc, 0, 0, 0); }
            s[kt] = acc; }
        const LAS float* bt = (const LAS float*)(lds + AT_BTOFF) + (15 - ql + 4 * g4);
        float mx = -1e30f;
#pragma unroll
        for (int kt = 0; kt < 9; ++kt)
#pragma unroll
            for (int i = 0; i < 4; ++i) { float v = s[kt][i] * SC + bt[16 * kt + i];
                if (a.qb == 0) { if (16 * (w + kt) + 4 * g4 + i < 128) v = -1e30f; }
                s[kt][i] = v; mx = fmaxf(mx, v); }
        mx = fmaxf(mx, __shfl_xor(mx, 16)); mx = fmaxf(mx, __shfl_xor(mx, 32));
        float sum = 0.f;
#pragma unroll
        for (int kt = 0; kt < 9; ++kt)
#pragma unroll
            for (int i = 0; i < 4; ++i) { const float p = __builtin_amdgcn_exp2f(s[kt][i] - mx); s[kt][i] = p; sum += p; }
        sum += __shfl_xor(sum, 16); sum += __shfl_xor(sum, 32);
        f32x4 o[8];
#pragma unroll
        for (int dt = 0; dt < 8; ++dt) o[dt] = (f32x4){0.f, 0.f, 0.f, 0.f};
        LAS unsigned char* vb = lds + AT_VOFF + (16 * w + 4 * g4 + (ql >> 2)) * AT_PITCH + (ql & 3) * 8;
#pragma unroll
        for (int p = 0; p < 5; ++p) {
            v4u pk; pk.x = cvt_pk_bf16(s[2 * p][0], s[2 * p][1]); pk.y = cvt_pk_bf16(s[2 * p][2], s[2 * p][3]);
            if (p < 4) { pk.z = cvt_pk_bf16(s[2 * p + 1][0], s[2 * p + 1][1]); pk.w = cvt_pk_bf16(s[2 * p + 1][2], s[2 * p + 1][3]); } else { pk.z = 0u; pk.w = 0u; }
            const s16x8 pf = __builtin_bit_cast(s16x8, pk);
#pragma unroll
            for (int dt = 0; dt < 8; ++dt) {
                const s16x4 lo = tr_read4(vb + p * 32 * AT_PITCH + dt * 32);
                s16x4 hi = {0, 0, 0, 0}; if (p < 4) hi = tr_read4(vb + p * 32 * AT_PITCH + 16 * AT_PITCH + dt * 32);
                const s16x8 vf = {lo[0], lo[1], lo[2], lo[3], hi[0], hi[1], hi[2], hi[3]};
                o[dt] = __builtin_amdgcn_mfma_f32_16x16x32_bf16(vf, pf, o[dt], 0, 0, 0); }
        }
        const float inv = 1.0f / sum;
        bf16* op = ATT + ((size_t)a.grp * M + mq) * 1024 + (a.hh & 7) * 128 + 4 * g4;
#pragma unroll
        for (int dt = 0; dt < 8; ++dt) { v2u wv; wv.x = cvt_pk_bf16(o[dt][0] * inv, o[dt][1] * inv); wv.y = cvt_pk_bf16(o[dt][2] * inv, o[dt][3] * inv); *(v2u*)(op + dt * 16) = wv; }
        if (g4 == 0) LSE[(size_t)a.grp * (2 * 8 * SEQ) + ((size_t)(a.b * 8 + (a.hh & 7)) * a.r + a.c) * (SEQ / a.r) + jq] = mx + __builtin_amdgcn_logf(sum);
        __syncthreads();
    }
}
__device__ __forceinline__ void attn_merge_phase(const bf16* ATT, const float* LSE, bf16* Yb  , int gw, int NGW, int lane) {
    for (int m = gw; m < M; m += NGW) {
        const int hs = lane >> 3, b = m / SEQ, t = m % SEQ;
        const float* lb = LSE + (size_t)(b * 8 + hs) * SEQ;
        const float l0 = lb[t], l1 = lb[(size_t)(2 * 8 * SEQ) + (t & 3) * (SEQ / 4) + (t >> 2)], l2 = lb[(size_t)2 * (2 * 8 * SEQ) + (t & 15) * (SEQ / 16) + (t >> 4)];
        const float mx = fmaxf(l0, fmaxf(l1, l2));
        float w0 = __builtin_amdgcn_exp2f(l0 - mx), w1 = __builtin_amdgcn_exp2f(l1 - mx), w2 = __builtin_amdgcn_exp2f(l2 - mx);
        const float inv = 1.0f / (w0 + w1 + w2); w0 *= inv; w1 *= inv; w2 *= inv;
        float y[16];
#pragma unroll
        for (int hlf = 0; hlf < 2; ++hlf) {
            const v4u a = *(const v4u*)(ATT + (size_t)m * 1024 + 16 * lane + 8 * hlf), b = *(const v4u*)(ATT + ((size_t)M + m) * 1024 + 16 * lane + 8 * hlf), c = *(const v4u*)(ATT + ((size_t)2 * M + m) * 1024 + 16 * lane + 8 * hlf);
            y[8 * hlf + 0] = w0 * bflo(a.x) + w1 * bflo(b.x) + w2 * bflo(c.x); y[8 * hlf + 1] = w0 * bfhi(a.x) + w1 * bfhi(b.x) + w2 * bfhi(c.x);
            y[8 * hlf + 2] = w0 * bflo(a.y) + w1 * bflo(b.y) + w2 * bflo(c.y); y[8 * hlf + 3] = w0 * bfhi(a.y) + w1 * bfhi(b.y) + w2 * bfhi(c.y);
            y[8 * hlf + 4] = w0 * bflo(a.z) + w1 * bflo(b.z) + w2 * bflo(c.z); y[8 * hlf + 5] = w0 * bfhi(a.z) + w1 * bfhi(b.z) + w2 * bfhi(c.z);
            y[8 * hlf + 6] = w0 * bflo(a.w) + w1 * bflo(b.w) + w2 * bflo(c.w); y[8 * hlf + 7] = w0 * bfhi(a.w) + w1 * bfhi(b.w) + w2 * bfhi(c.w);
        }
        v4u o0, o1; o0.x = pk2(y[0], y[1]); o0.y = pk2(y[2], y[3]); o0.z = pk2(y[4], y[5]); o0.w = pk2(y[6], y[7]); o1.x = pk2(y[8], y[9]); o1.y = pk2(y[10], y[11]); o1.z = pk2(y[12], y[13]); o1.w = pk2(y[14], y[15]);
        *(v4u*)(Yb + (size_t)m * 3072 + 16 * lane) = o0; *(v4u*)(Yb + (size_t)m * 3072 + 16 * lane + 8) = o1;
    }
}
constexpr int ML_PITCH = 544, ML_KOFF = 0, ML_VOFF = 128 * ML_PITCH, ML_GOFF = 2 * 128 * ML_PITCH;
constexpr int ML_ROWS = 257, ML_USZ = ML_ROWS * 256;
__device__ __forceinline__ void ml_gates(const float* IFG, size_t m0, int h, LAS float* gv, int tid) {
    if (tid < 64) {
        const int l = tid; const float x0 = IFG[(m0 + 2 * l) * 8 + 4 + h], x1 = IFG[(m0 + 2 * l + 1) * 8 + 4 + h], i0 = IFG[(m0 + 2 * l) * 8 + h], i1 = IFG[(m0 + 2 * l + 1) * 8 + h];
        float inc = x0 + x1;
#pragma unroll
        for (int d = 1; d < 64; d <<= 1) { const float t = __shfl_up(inc, d); if (l >= d) inc += t; }
        const float b1 = inc, b0 = inc - x1, bL = __shfl(inc, 63);
        gv[2 * l] = b0; gv[2 * l + 1] = b1; gv[128 + 2 * l] = i0 - b0; gv[128 + 2 * l + 1] = i1 - b1;
        gv[256 + 2 * l] = __expf(bL - b0 + i0); gv[256 + 2 * l + 1] = __expf(bL - b1 + i1);
    }
}
template <bool SCALE>
__device__ __forceinline__ void ml_stage(const bf16* QKC, const bf16* PROJ, size_t m0, int h, LAS unsigned char* lds, int tid) {
    const LAS float* Wv = (const LAS float*)(lds + ML_GOFF) + 256;
#pragma unroll
    for (int it = 0; it < 8; ++it) { const int chunk = it * NTHR + tid, row = chunk >> 5, c16 = chunk & 31;
        const v4u kv = *(const v4u*)(QKC + (m0 + row) * 2048 + 1024 + h * 256 + c16 * 8); v4u vv = *(const v4u*)(PROJ + (m0 + row) * NPROJ + PV + h * 256 + c16 * 8);
        if (SCALE) { const float w = Wv[row]; vv.x = pk2(bflo(vv.x) * w, bfhi(vv.x) * w); vv.y = pk2(bflo(vv.y) * w, bfhi(vv.y) * w); vv.z = pk2(bflo(vv.z) * w, bfhi(vv.z) * w); vv.w = pk2(bflo(vv.w) * w, bfhi(vv.w) * w); }
        *(LAS v4u*)(lds + ML_KOFF + row * ML_PITCH + c16 * 16) = kv; *(LAS v4u*)(lds + ML_VOFF + row * ML_PITCH + c16 * 16) = vv; }
    if (tid < 256) { const int row = tid >> 1, hf = tid & 1; v4u z = {0u, 0u, 0u, 0u}; if (hf == 0) z.x = SCALE ? f2bf(Wv[row]) : 0x3f80u; *(LAS v4u*)(lds + ML_VOFF + row * ML_PITCH + 512 + hf * 16) = z; }
}
__device__ __forceinline__ void mlstm_a1_phase(const bf16* QKC, const bf16* PROJ, const float* IFG, bf16* CST, float* MF, LAS unsigned char* lds, int bx, int G, int tid) {
    const int lane = tid & 63, w = __builtin_amdgcn_readfirstlane(tid >> 6), li = lane & 15, g4 = lane >> 4;
    for (int u = bx; u < 1024; u += G) {
        const int c = u & 127, h = (u >> 7) & 3, b = u >> 9; const size_t m0 = (size_t)b * SEQ + c * 128;
        LAS float* gv = (LAS float*)(lds + ML_GOFF);
        ml_gates(IFG, m0, h, gv, tid);
        __syncthreads();
        if (tid == 0) MF[u * 32] = __expf(gv[127]);
        ml_stage<true>(QKC, PROJ, m0, h, lds, tid);
        __syncthreads();
        s16x8 kf[2][4];
        LAS unsigned char* kb = lds + ML_KOFF + (8 * g4 + (li >> 2)) * ML_PITCH + (li & 3) * 8;
        LAS unsigned char* vb = lds + ML_VOFF + (8 * g4 + (li >> 2)) * ML_PITCH + (li & 3) * 8;
#pragma unroll
        for (int dt = 0; dt < 2; ++dt)
#pragma unroll
            for (int ks = 0; ks < 4; ++ks) { const s16x4 lo = tr_read4(kb + ks * 32 * ML_PITCH + (2 * w + dt) * 32), hi = tr_read4(kb + ks * 32 * ML_PITCH + 4 * ML_PITCH + (2 * w + dt) * 32);
                kf[dt][ks] = (s16x8){lo[0], lo[1], lo[2], lo[3], hi[0], hi[1], hi[2], hi[3]}; }
        bf16* cu = CST + (size_t)u * ML_USZ;
#pragma unroll 1
        for (int et = 0; et < 17; ++et) {
            f32x4 a0 = {0.f, 0.f, 0.f, 0.f}, a1 = {0.f, 0.f, 0.f, 0.f};
#pragma unroll
            for (int ks = 0; ks < 4; ++ks) { const s16x4 lo = tr_read4(vb + ks * 32 * ML_PITCH + et * 32), hi = tr_read4(vb + ks * 32 * ML_PITCH + 4 * ML_PITCH + et * 32);
                const s16x8 vf = {lo[0], lo[1], lo[2], lo[3], hi[0], hi[1], hi[2], hi[3]};
                a0 = __builtin_amdgcn_mfma_f32_16x16x32_bf16(kf[0][ks], vf, a0, 0, 0, 0); a1 = __builtin_amdgcn_mfma_f32_16x16x32_bf16(kf[1][ks], vf, a1, 0, 0, 0); }
            const int e = et * 16 + li;
            if (e < ML_ROWS) { v2u o0, o1; o0.x = cvt_pk_bf16(a0[0], a0[1]); o0.y = cvt_pk_bf16(a0[2], a0[3]); o1.x = cvt_pk_bf16(a1[0], a1[1]); o1.y = cvt_pk_bf16(a1[2], a1[3]);
                *(v2u*)(cu + (size_t)e * 256 + 32 * w + 4 * g4) = o0; *(v2u*)(cu + (size_t)e * 256 + 32 * w + 16 + 4 * g4) = o1; }
        }
        __syncthreads();
    }
}
__device__ __forceinline__ void mlstm_a2_phase(const bf16* DC, bf16* CIN, const float* MF, int gtid, int NGT) {
    constexpr int NQ = ML_USZ / 8;
    for (int job = gtid; job < 8 * NQ; job += NGT) {
        const int bh = job / NQ, q = job % NQ;
        float cr[8];
#pragma unroll
        for (int j = 0; j < 8; ++j) cr[j] = 0.f;
        const bf16* p = DC + (size_t)bh * 128 * ML_USZ + (size_t)q * 8; bf16* po = CIN + (size_t)bh * 128 * ML_USZ + (size_t)q * 8;
        for (int c0 = 0; c0 < 128; c0 += 8) {
            v4u d[8]; float f[8];
#pragma unroll
            for (int k = 0; k < 8; ++k) { d[k] = *(const v4u*)(p + (size_t)(c0 + k) * ML_USZ); f[k] = MF[(bh * 128 + c0 + k) * 32]; }
#pragma unroll
            for (int k = 0; k < 8; ++k) {
                v4u o; o.x = pk2(cr[0], cr[1]); o.y = pk2(cr[2], cr[3]); o.z = pk2(cr[4], cr[5]); o.w = pk2(cr[6], cr[7]);
                *(v4u*)(po + (size_t)(c0 + k) * ML_USZ) = o;
                cr[0] = f[k] * cr[0] + bflo(d[k].x); cr[1] = f[k] * cr[1] + bfhi(d[k].x); cr[2] = f[k] * cr[2] + bflo(d[k].y); cr[3] = f[k] * cr[3] + bfhi(d[k].y);
                cr[4] = f[k] * cr[4] + bflo(d[k].z); cr[5] = f[k] * cr[5] + bfhi(d[k].z); cr[6] = f[k] * cr[6] + bflo(d[k].w); cr[7] = f[k] * cr[7] + bfhi(d[k].w);
            }
        }
    }
}
constexpr int ML3_GOFF = 139840;
__device__ __forceinline__ void mlstm_a3_phase(const bf16* QKC, const bf16* PROJ, const float* IFG, const bf16* CST, const float* mg, bf16* Yo, LAS unsigned char* lds, int bx, int G, int tid) {
    const int lane = tid & 63, w = __builtin_amdgcn_readfirstlane(tid >> 6), li = lane & 15, g4 = lane >> 4;
    for (int u = bx; u < 1024; u += G) {
        const int c = u & 127, h = (u >> 7) & 3, b = u >> 9; const size_t m0 = (size_t)b * SEQ + c * 128;
        LAS float* gv = (LAS float*)(lds + ML3_GOFF);
        ml_gates(IFG, m0, h, gv, tid);
        const bf16* cu = CST + (size_t)u * ML_USZ;
#pragma unroll 1
        for (int hf = 0; hf < 2; ++hf) { v4u r[8];
#pragma unroll
            for (int it = 0; it < 8; ++it) { const int chunk = (hf * 8 + it) * NTHR + tid; r[it] = *(const v4u*)(cu + (size_t)(chunk >> 5) * 256 + (chunk & 31) * 8); }
#pragma unroll
            for (int it = 0; it < 8; ++it) { const int chunk = (hf * 8 + it) * NTHR + tid; *(LAS v4u*)(lds + (chunk >> 5) * ML_PITCH + (chunk & 31) * 16) = r[it]; } }
        if (tid < 32) *(LAS v4u*)(lds + 256 * ML_PITCH + tid * 16) = *(const v4u*)(cu + (size_t)256 * 256 + tid * 8);
        const size_t mq = m0 + 16 * w + li;
        __syncthreads();
        s16x8 qf[8];
#pragma unroll
        for (int ks = 0; ks < 8; ++ks) qf[ks] = *(const s16x8*)(QKC + mq * 2048 + h * 256 + 32 * ks + 8 * g4);
        f32x4 o[17];
#pragma unroll
        for (int et = 0; et < 17; ++et) { f32x4 acc = {0.f, 0.f, 0.f, 0.f}; const int row = (et * 16 + li) < ML_ROWS ? (et * 16 + li) : (ML_ROWS - 1);
#pragma unroll
            for (int ks = 0; ks < 8; ++ks) { const s16x8 cf = *(const LAS s16x8*)(lds + row * ML_PITCH + (32 * ks + 8 * g4) * 2); acc = __builtin_amdgcn_mfma_f32_16x16x32_bf16(cf, qf[ks], acc, 0, 0, 0); }
            o[et] = acc; if (et & 1) __builtin_amdgcn_sched_barrier(0); }
        const float bt = gv[16 * w + li], ebt = __expf(bt);
#pragma unroll
        for (int et = 0; et < 17; ++et) o[et] *= ebt;
        v4u kr[8], vr[8];
#pragma unroll
        for (int it = 0; it < 8; ++it) { const int chunk = it * NTHR + tid, row = chunk >> 5, c16 = chunk & 31;
            kr[it] = *(const v4u*)(QKC + (m0 + row) * 2048 + 1024 + h * 256 + c16 * 8); vr[it] = *(const v4u*)(PROJ + (m0 + row) * NPROJ + PV + h * 256 + c16 * 8); }
        __syncthreads();
#pragma unroll
        for (int it = 0; it < 8; ++it) { const int chunk = it * NTHR + tid, row = chunk >> 5, c16 = chunk & 31;
            *(LAS v4u*)(lds + ML_KOFF + row * ML_PITCH + c16 * 16) = kr[it]; *(LAS v4u*)(lds + ML_VOFF + row * ML_PITCH + c16 * 16) = vr[it]; }
        if (tid < 256) { const int row = tid >> 1, hf = tid & 1; v4u z = {0u, 0u, 0u, 0u}; if (hf == 0) z.x = 0x3f80u; *(LAS v4u*)(lds + ML_VOFF + row * ML_PITCH + 512 + hf * 16) = z; }
        __syncthreads();
        v4u pk[4];
#pragma unroll
        for (int p = 0; p < 4; ++p) pk[p] = (v4u){0u, 0u, 0u, 0u};
#pragma unroll
        for (int kt = 0; kt < 8; ++kt) {
            if (kt <= w) {
                f32x4 acc = {0.f, 0.f, 0.f, 0.f};
#pragma unroll
                for (int ks = 0; ks < 8; ++ks) { const s16x8 kf = *(const LAS s16x8*)(lds + ML_KOFF + (16 * kt + li) * ML_PITCH + (32 * ks + 8 * g4) * 2); acc = __builtin_amdgcn_mfma_f32_16x16x32_bf16(kf, qf[ks], acc, 0, 0, 0); }
                const f32x4 av = *(const LAS f32x4*)(gv + 128 + 16 * kt + 4 * g4);
                float pv[4];
#pragma unroll
                for (int i = 0; i < 4; ++i) { const bool ok = (16 * kt + 4 * g4 + i) <= (16 * w + li); pv[i] = ok ? acc[i] * __expf(bt + av[i]) : 0.f; }
                if (kt & 1) { pk[kt >> 1].z = cvt_pk_bf16(pv[0], pv[1]); pk[kt >> 1].w = cvt_pk_bf16(pv[2], pv[3]); } else { pk[kt >> 1].x = cvt_pk_bf16(pv[0], pv[1]); pk[kt >> 1].y = cvt_pk_bf16(pv[2], pv[3]); }
            }
        }
        LAS unsigned char* vb = lds + ML_VOFF + (4 * g4 + (li >> 2)) * ML_PITCH + (li & 3) * 8;
#pragma unroll
        for (int p = 0; p < 4; ++p) {
            if (2 * p <= w) {
                const s16x8 pf = __builtin_bit_cast(s16x8, pk[p]);
#pragma unroll
                for (int et = 0; et < 17; ++et) { const s16x4 lo = tr_read4(vb + p * 32 * ML_PITCH + et * 32), hi = tr_read4(vb + p * 32 * ML_PITCH + 16 * ML_PITCH + et * 32);
                    const s16x8 vf = {lo[0], lo[1], lo[2], lo[3], hi[0], hi[1], hi[2], hi[3]};
                    o[et] = __builtin_amdgcn_mfma_f32_16x16x32_bf16(vf, pf, o[et], 0, 0, 0); }
            }
        }
        const float den = __shfl(o[16][0], li), rden = 1.0f / fmaxf(fabsf(den), 1.0f);
        float ss = 0.f;
#pragma unroll
        for (int et = 0; et < 16; ++et) { o[et] *= rden; ss += (o[et][0] * o[et][0] + o[et][1] * o[et][1]) + (o[et][2] * o[et][2] + o[et][3] * o[et][3]); }
        ss += __shfl_xor(ss, 16); ss += __shfl_xor(ss, 32);
        const float rn = 1.0f / sqrtf(ss * (1.0f / 256.0f) + NORM_EPS);
#pragma unroll
        for (int et = 0; et < 16; ++et) { const int ch = h * 256 + 16 * et + 4 * g4;
            const v2u og = *(const v2u*)(PROJ + mq * NPROJ + PO + ch); const f32x4 gn = *(const f32x4*)(mg + ch);
            v2u wv; wv.x = cvt_pk_bf16(bflo(og.x) * (o[et][0] * rn) * gn[0], bfhi(og.x) * (o[et][1] * rn) * gn[1]); wv.y = cvt_pk_bf16(bflo(og.y) * (o[et][2] * rn) * gn[2], bfhi(og.y) * (o[et][3] * rn) * gn[3]);
            *(v2u*)(Yo + mq * 3072 + ch) = wv; }
        __syncthreads();
    }
}
__device__ __forceinline__ float dpp_row_shr1(float v) { return __builtin_bit_cast(float, __builtin_amdgcn_update_dpp(0, __builtin_bit_cast(int, v), 0x111, 0xF, 0xF, true)); }
__device__ __forceinline__ float dpp_row_shr2(float v) { return __builtin_bit_cast(float, __builtin_amdgcn_update_dpp(0, __builtin_bit_cast(int, v), 0x112, 0xF, 0xF, true)); }
__device__ __forceinline__ float dpp_row_shr4(float v) { return __builtin_bit_cast(float, __builtin_amdgcn_update_dpp(0, __builtin_bit_cast(int, v), 0x114, 0xF, 0xF, true)); }
__device__ __forceinline__ float dpp_row_shr8(float v) { return __builtin_bit_cast(float, __builtin_amdgcn_update_dpp(0, __builtin_bit_cast(int, v), 0x118, 0xF, 0xF, true)); }
__device__ __forceinline__ float dpp_row_ror1(float v) { return __builtin_bit_cast(float, __builtin_amdgcn_update_dpp(0, __builtin_bit_cast(int, v), 0x121, 0xF, 0xF, true)); }
__device__ __forceinline__ float gelu_tanh_f(float y) { const float x = 0.7978845608028654f * (y + 0.044715f * y * y * y); const float th = 1.0f - 2.0f * __builtin_amdgcn_rcpf(1.0f + __builtin_amdgcn_exp2f(2.8853900817779268f * x)); return 0.5f * y * (1.0f + th); }
__device__ __forceinline__ void s5_disc_phase(const S5P& P, f32x4* DISC, int gtid) { if (gtid < 4096) { float a_r, a_i, f_r, f_i; s5_disc(P, gtid >> 6, gtid & 63, a_r, a_i, f_r, f_i); DISC[gtid] = (f32x4){a_r, a_i, f_r, f_i};
    const float t2 = a_r * a_i, a2r = a_r * a_r - a_i * a_i, a2i = t2 + t2, t4 = a2r * a2i, a4r = a2r * a2r - a2i * a2i, a4i = t4 + t4, t8 = a4r * a4i, a8r = a4r * a4r - a4i * a4i, a8i = t8 + t8;
    const float t16 = a8r * a8i, a12r = a8r * a4r - a8i * a4i, a12i = a8r * a4i + a8i * a4r, a16r = a8r * a8r - a8i * a8i, a16i = t16 + t16;
    float one = 1.f, zero = 0.f; asm volatile("" : "+v"(one), "+v"(zero));
    f32x4* E = DISC + 4096 + (size_t)gtid * 4; E[0] = (f32x4){one, zero, a4r, a4i}; E[1] = (f32x4){a8r, a8i, a12r, a12i}; E[2] = (f32x4){a16r, a16i, a_r, a_i}; E[3] = (f32x4){f_r, f_i, zero, zero}; } }
constexpr int S5_WLDS = 16384, S5_BOFF = 0, S5_COFF = 8192, S5_AOFF = 12288, S5_XOFF = 12800;
template <bool OUT>
__device__ __forceinline__ void s5_mfma_phase(const S5P& P, const f32x4* DISC, const bf16* PROJ, float* LOC, const float* CAR, bf16* Zb, LAS unsigned char* wl, int gw, int NGW, int lane) {
    const int li = lane & 15, g4 = lane >> 4;
    LAS v4u* bl = (LAS v4u*)(wl + S5_BOFF); LAS v4u* cl = (LAS v4u*)(wl + S5_COFF);
    LAS f32x4* at = (LAS f32x4*)(wl + S5_AOFF) + g4 * 8;
    LAS f32x4* xt = (LAS f32x4*)(wl + S5_XOFF) + g4 * 8;
    for (int wj = gw >> 3; wj < 256; wj += NGW >> 3) {
        const int wv = gw & 7, c = (wj & 7) * 2 + (wv >> 2), grp = ((wj >> 3) & 15) * 4 + (wv & 3), b = wj >> 7;
#pragma unroll
        for (int T = 0; T < 4; ++T) { const int p = 16 * T + li; const f32x4 dq = DISC[grp * 64 + p]; const float f_r = dq[2], f_i = dq[3];
            v4u re = {0u, 0u, 0u, 0u}, im = {0u, 0u, 0u, 0u};
            if (g4 < 2) { const float* br = P.b_re + (grp * 64 + p) * 16 + 8 * g4; const float* bi = P.b_im + (grp * 64 + p) * 16 + 8 * g4; float vr[8], vi[8];
#pragma unroll
                for (int j = 0; j < 8; ++j) { vr[j] = f_r * br[j] - f_i * bi[j]; vi[j] = f_r * bi[j] + f_i * br[j]; }
                re.x = pk2(vr[0], vr[1]); re.y = pk2(vr[2], vr[3]); re.z = pk2(vr[4], vr[5]); re.w = pk2(vr[6], vr[7]); im.x = pk2(vi[0], vi[1]); im.y = pk2(vi[2], vi[3]); im.z = pk2(vi[4], vi[5]); im.w = pk2(vi[6], vi[7]); }
            bl[T * 64 + lane] = re; bl[(4 + T) * 64 + lane] = im; }
        if (OUT) {
#pragma unroll
            for (int ks = 0; ks < 4; ++ks) { float cv[8];
#pragma unroll
                for (int j = 0; j < 8; ++j) { const int pp = 16 * (2 * ks + (j >> 2)) + 4 * g4 + (j & 3);
                    cv[j] = (pp < 64) ? P.c_re[(grp * 16 + li) * 64 + pp] : -P.c_im[(grp * 16 + li) * 64 + pp - 64]; }
                v4u w; w.x = pk2(cv[0], cv[1]); w.y = pk2(cv[2], cv[3]); w.z = pk2(cv[4], cv[5]); w.w = pk2(cv[6], cv[7]); cl[ks * 64 + lane] = w; }
        }
        if (li < 8) {
            const int q0 = 2 * li, p0 = 16 * (q0 >> 2) + 4 * g4 + (q0 & 3), p1 = p0 + 1; const f32x4 d0 = DISC[grp * 64 + p0], d1 = DISC[grp * 64 + p1];
            at[li] = (f32x4){d0[0], d0[1], d1[0], d1[1]};
            float zf = 0.f; asm volatile("" : "+v"(zf));
            f32x4 c0 = {zf, zf, zf, zf};
            if (OUT) { const size_t s0 = ((size_t)((b * 64 + grp) * 16 + c) * 64 + p0) * 2; c0 = (f32x4){CAR[s0], CAR[s0 + 1], CAR[s0 + 2], CAR[s0 + 3]}; }
            xt[li] = c0; }
        float dsk[4] = {0.f, 0.f, 0.f, 0.f};
        if (OUT) {
#pragma unroll
            for (int i = 0; i < 4; ++i) dsk[i] = P.d_skip[grp * 16 + 4 * g4 + i]; }
        LDS_WAIT();
        const bf16* ub = PROJ + ((size_t)b * SEQ + c * 1024 + li) * NPROJ + PU + grp * 16;
        v4u un0 = {0u, 0u, 0u, 0u}, un1 = {0u, 0u, 0u, 0u};
        if (g4 < 2) { un0 = *(const v4u*)(ub + 8 * g4); un1 = *(const v4u*)(ub + (size_t)16 * NPROJ + 8 * g4); }
        v2u us0 = {0u, 0u}, us1 = {0u, 0u};
        if (OUT) { us0 = *(const v2u*)(ub + 4 * g4); us1 = *(const v2u*)(ub + (size_t)16 * NPROJ + 4 * g4); }
#pragma unroll 1
        for (int tt = 0; tt < 64; ++tt) {
            const v4u uv = un0; const v2u us = us0; un0 = un1; us0 = us1;
            { const int t2 = tt + 2 < 64 ? tt + 2 : 63; const bf16* u2 = ub + (size_t)t2 * 16 * NPROJ;
              if (g4 < 2) un1 = *(const v4u*)(u2 + 8 * g4);
              if (OUT) us1 = *(const v2u*)(u2 + 4 * g4); }
            const s16x8 uf = __builtin_bit_cast(s16x8, uv);
            f32x4 y = {0.f, 0.f, 0.f, 0.f};
#pragma unroll 1
            for (int h2 = 0; h2 < 2; ++h2) {
                float xr[8], xi[8], ar[8], ai[8];
#pragma unroll
                for (int Tl = 0; Tl < 2; ++Tl) { const int T = 2 * h2 + Tl; const f32x4 z4 = {0.f, 0.f, 0.f, 0.f};
                    const s16x8 bre = __builtin_bit_cast(s16x8, bl[T * 64 + lane]), bim = __builtin_bit_cast(s16x8, bl[(4 + T) * 64 + lane]);
                    const f32x4 dre = __builtin_amdgcn_mfma_f32_16x16x32_bf16(bre, uf, z4, 0, 0, 0), dim = __builtin_amdgcn_mfma_f32_16x16x32_bf16(bim, uf, z4, 0, 0, 0);
#pragma unroll
                    for (int i = 0; i < 4; ++i) { xr[4 * Tl + i] = dre[i]; xi[4 * Tl + i] = dim[i]; } }
#pragma unroll
                for (int k = 0; k < 4; ++k) { const f32x4 av = at[4 * h2 + k], cv = xt[4 * h2 + k];
                    ar[2 * k] = av[0]; ai[2 * k] = av[1]; ar[2 * k + 1] = av[2]; ai[2 * k + 1] = av[3];
                    if (li == 0) { xr[2 * k] += av[0] * cv[0] - av[1] * cv[1]; xi[2 * k] += av[0] * cv[1] + av[1] * cv[0]; xr[2 * k + 1] += av[2] * cv[2] - av[3] * cv[3]; xi[2 * k + 1] += av[2] * cv[3] + av[3] * cv[2]; } }
#pragma unroll
                for (int q = 0; q < 8; ++q) {
                    float vr = xr[q], vi = xi[q], wr = ar[q], wi = ai[q];
                    { const float tr = dpp_row_shr1(vr), ti = dpp_row_shr1(vi); vr += wr * tr - wi * ti; vi += wr * ti + wi * tr; }
                    { const float nr = wr * wr - wi * wi, ni = 2.f * wr * wi; wr = nr; wi = ni; }
                    { const float tr = dpp_row_shr2(vr), ti = dpp_row_shr2(vi); vr += wr * tr - wi * ti; vi += wr * ti + wi * tr; }
                    { const float nr = wr * wr - wi * wi, ni = 2.f * wr * wi; wr = nr; wi = ni; }
                    { const float tr = dpp_row_shr4(vr), ti = dpp_row_shr4(vi); vr += wr * tr - wi * ti; vi += wr * ti + wi * tr; }
                    { const float nr = wr * wr - wi * wi, ni = 2.f * wr * wi; wr = nr; wi = ni; }
                    { const float tr = dpp_row_shr8(vr), ti = dpp_row_shr8(vi); vr += wr * tr - wi * ti; vi += wr * ti + wi * tr; }
                    xr[q] = vr; xi[q] = vi; }
                if (li == 15) {
#pragma unroll
                    for (int k = 0; k < 4; ++k) xt[4 * h2 + k] = (f32x4){xr[2 * k], xi[2 * k], xr[2 * k + 1], xi[2 * k + 1]}; }
                if (OUT) { v4u wre, wim;
                    wre.x = cvt_pk_bf16(xr[0], xr[1]); wre.y = cvt_pk_bf16(xr[2], xr[3]); wre.z = cvt_pk_bf16(xr[4], xr[5]); wre.w = cvt_pk_bf16(xr[6], xr[7]);
                    wim.x = cvt_pk_bf16(xi[0], xi[1]); wim.y = cvt_pk_bf16(xi[2], xi[3]); wim.z = cvt_pk_bf16(xi[4], xi[5]); wim.w = cvt_pk_bf16(xi[6], xi[7]);
                    y = __builtin_amdgcn_mfma_f32_16x16x32_bf16(__builtin_bit_cast(s16x8, cl[h2 * 64 + lane]), __builtin_bit_cast(s16x8, wre), y, 0, 0, 0);
                    y = __builtin_amdgcn_mfma_f32_16x16x32_bf16(__builtin_bit_cast(s16x8, cl[(2 + h2) * 64 + lane]), __builtin_bit_cast(s16x8, wim), y, 0, 0, 0); }
            }
            if (OUT) {
                const float u4[4] = {bflo(us.x), bfhi(us.x), bflo(us.y), bfhi(us.y)};
                float z[4];
#pragma unroll
                for (int i = 0; i < 4; ++i) z[i] = gelu_tanh_f(y[i] + dsk[i] * u4[i]);
                v2u zo; zo.x = cvt_pk_bf16(z[0], z[1]); zo.y = cvt_pk_bf16(z[2], z[3]);
                *(v2u*)(Zb + ((size_t)b * SEQ + c * 1024 + tt * 16 + li) * 1024 + grp * 16 + 4 * g4) = zo;
            }
        }
        if (!OUT) { if (li < 8) { const f32x4 fv = xt[li];
#pragma unroll
            for (int e = 0; e < 2; ++e) { const int q = 2 * li + e, p = 16 * (q >> 2) + 4 * g4 + (q & 3); const size_t sidx = ((size_t)((b * 64 + grp) * 16 + c) * 64 + p) * 2; LOC[sidx] = fv[2 * e]; LOC[sidx + 1] = fv[2 * e + 1]; } } }
        LDS_WAIT();
    }
}
__device__ __forceinline__ void s5a_reduce_phase(const S5P& P, const f32x4* DISC, const bf16* PROJ, float* LOC, LAS unsigned char* wl, int gw, int NGW, int lane) {
    const int li = lane & 15, g4 = lane >> 4;
    LAS v4u* bl = (LAS v4u*)(wl + S5_BOFF);
    for (int wj = gw >> 3; wj < 256; wj += NGW >> 3) {
        const int wv = gw & 7, c = (wj & 7) * 2 + (wv >> 2), grp = ((wj >> 3) & 15) * 4 + (wv & 3), b = wj >> 7;
#pragma unroll
        for (int T = 0; T < 4; ++T) { const int p = 16 * T + li; const f32x4 dq = DISC[grp * 64 + p]; const float f_r = dq[2], f_i = dq[3];
            v4u re = {0u, 0u, 0u, 0u}, im = {0u, 0u, 0u, 0u};
            if (g4 < 2) { const float* br = P.b_re + (grp * 64 + p) * 16 + 8 * g4; const float* bi = P.b_im + (grp * 64 + p) * 16 + 8 * g4; float vr[8], vi[8];
#pragma unroll
                for (int j = 0; j < 8; ++j) { vr[j] = f_r * br[j] - f_i * bi[j]; vi[j] = f_r * bi[j] + f_i * br[j]; }
                re.x = pk2(vr[0], vr[1]); re.y = pk2(vr[2], vr[3]); re.z = pk2(vr[4], vr[5]); re.w = pk2(vr[6], vr[7]); im.x = pk2(vi[0], vi[1]); im.y = pk2(vi[2], vi[3]); im.z = pk2(vi[4], vi[5]); im.w = pk2(vi[6], vi[7]); }
            bl[T * 64 + lane] = re; bl[(4 + T) * 64 + lane] = im; }
        float wr[16], wi[16], sr[16], si[16], cr[16], ci[16];
        const int ex = 15 - li;
#pragma unroll
        for (int q = 0; q < 16; ++q) { const f32x4 da = DISC[grp * 64 + 16 * (q >> 2) + 4 * g4 + (q & 3)];
            float pr = da[0], pi = da[1], ar_ = 1.f, ai_ = 0.f;
#pragma unroll
            for (int bit = 0; bit < 4; ++bit) { if ((ex >> bit) & 1) { const float nr = ar_ * pr - ai_ * pi, ni = ar_ * pi + ai_ * pr; ar_ = nr; ai_ = ni; }
                const float qr = pr * pr - pi * pi, qi = 2.f * pr * pi; pr = qr; pi = qi; }
            wr[q] = ar_; wi[q] = ai_; sr[q] = pr; si[q] = pi; cr[q] = 0.f; ci[q] = 0.f; }
        LDS_WAIT();
        const bf16* ub = PROJ + ((size_t)b * SEQ + c * 1024 + li) * NPROJ + PU + grp * 16;
        v4u un0 = {0u, 0u, 0u, 0u}, un1 = {0u, 0u, 0u, 0u};
        if (g4 < 2) { un0 = *(const v4u*)(ub + 8 * g4); un1 = *(const v4u*)(ub + (size_t)16 * NPROJ + 8 * g4); }
#pragma unroll 1
        for (int tt = 0; tt < 64; ++tt) {
            const v4u uv = un0; un0 = un1;
            { const int t2 = tt + 2 < 64 ? tt + 2 : 63; if (g4 < 2) un1 = *(const v4u*)(ub + (size_t)t2 * 16 * NPROJ + 8 * g4); }
            const s16x8 uf = __builtin_bit_cast(s16x8, uv);
#pragma unroll
            for (int T = 0; T < 4; ++T) { const f32x4 z4 = {0.f, 0.f, 0.f, 0.f};
                const s16x8 bre = __builtin_bit_cast(s16x8, bl[T * 64 + lane]), bim = __builtin_bit_cast(s16x8, bl[(4 + T) * 64 + lane]);
                const f32x4 dre = __builtin_amdgcn_mfma_f32_16x16x32_bf16(bre, uf, z4, 0, 0, 0), dim = __builtin_amdgcn_mfma_f32_16x16x32_bf16(bim, uf, z4, 0, 0, 0);
#pragma unroll
                for (int i = 0; i < 4; ++i) { const int q = 4 * T + i;
                    float vr = dre[i] * wr[q] - dim[i] * wi[q], vi = dre[i] * wi[q] + dim[i] * wr[q];
                    vr += dpp_row_shr1(vr); vi += dpp_row_shr1(vi); vr += dpp_row_shr2(vr); vi += dpp_row_shr2(vi);
                    vr += dpp_row_shr4(vr); vi += dpp_row_shr4(vi); vr += dpp_row_shr8(vr); vi += dpp_row_shr8(vi);
                    const float nr = sr[q] * cr[q] - si[q] * ci[q] + vr, ni = sr[q] * ci[q] + si[q] * cr[q] + vi; cr[q] = nr; ci[q] = ni; }
                __builtin_amdgcn_sched_barrier(0); }
        }
        if (li == 15) {
#pragma unroll
            for (int q = 0; q < 16; ++q) { const int p = 16 * (q >> 2) + 4 * g4 + (q & 3); const size_t sidx = ((size_t)((b * 64 + grp) * 16 + c) * 64 + p) * 2; LOC[sidx] = cr[q]; LOC[sidx + 1] = ci[q]; } }
        LDS_WAIT();
    }
}
__device__ __forceinline__ float bperm_f(int addr, float v) { return __builtin_bit_cast(float, __builtin_amdgcn_ds_bpermute(addr, __builtin_bit_cast(int, v))); }
struct S5Pw { float ar, ai, a4r, a4i, a8r, a8i, a16r, a16i; };
__device__ __forceinline__ S5Pw s5_powers(const f32x4 dq) { S5Pw w; w.ar = dq[0]; w.ai = dq[1];
    const float a2r = w.ar * w.ar - w.ai * w.ai, a2i = 2.f * w.ar * w.ai; w.a4r = a2r * a2r - a2i * a2i; w.a4i = 2.f * a2r * a2i;
    w.a8r = w.a4r * w.a4r - w.a4i * w.a4i; w.a8i = 2.f * w.a4r * w.a4i; w.a16r = w.a8r * w.a8r - w.a8i * w.a8i; w.a16i = 2.f * w.a8r * w.a8i; return w; }
__device__ __forceinline__ void s5_fill_bfrags(const S5P& P, const f32x4* DISC, int grp, LAS v4u* bl, int lane) {
    const int li = lane & 15, g4 = lane >> 4;
#pragma unroll
    for (int T = 0; T < 4; ++T) { const int p = 16 * T + li; const f32x4 dq = DISC[grp * 64 + p]; const float f_r = dq[2], f_i = dq[3];
        v4u re = {0u, 0u, 0u, 0u}, im = {0u, 0u, 0u, 0u};
        if (g4 < 2) { const float* br = P.b_re + (grp * 64 + p) * 16 + 8 * g4; const float* bi = P.b_im + (grp * 64 + p) * 16 + 8 * g4; float vr[8], vi[8];
#pragma unroll
            for (int j = 0; j < 8; ++j) { vr[j] = f_r * br[j] - f_i * bi[j]; vi[j] = f_r * bi[j] + f_i * br[j]; }
            re.x = pk2(vr[0], vr[1]); re.y = pk2(vr[2], vr[3]); re.z = pk2(vr[4], vr[5]); re.w = pk2(vr[6], vr[7]); im.x = pk2(vi[0], vi[1]); im.y = pk2(vi[2], vi[3]); im.z = pk2(vi[4], vi[5]); im.w = pk2(vi[6], vi[7]); }
        bl[T * 64 + lane] = re; bl[(4 + T) * 64 + lane] = im; }
}
__device__ __forceinline__ float afma(float a, float b, float c) { float d; asm("v_fma_f32 %0, %1, %2, %3" : "=v"(d) : "v"(a), "v"(b), "v"(c)); return d; }
__device__ __forceinline__ float anfma(float a, float b, float c) { float d; asm("v_fma_f32 %0, -%1, %2, %3" : "=v"(d) : "v"(a), "v"(b), "v"(c)); return d; }
__device__ __forceinline__ float aadd(float a, float b) { float d; asm("v_add_f32 %0, %1, %2" : "=v"(d) : "v"(a), "v"(b)); return d; }
#define CFMA(rr, ri, ar, ai, xr_, xi_, cr_, ci_) do { const float t0_ = anfma(ai, xi_, cr_), t1_ = afma(ai, xr_, ci_); rr = afma(ar, xr_, t0_); ri = afma(ar, xi_, t1_); } while (0)
__device__ __forceinline__ void s5a_ls_phase(const S5P& P, const f32x4* DISC, const bf16* PROJ, float* LOC, LAS unsigned char* wl, int gw, int NGW, int lane) {
    float zf = 0.f; asm volatile("" : "+v"(zf));
    const int li = lane & 15, g4 = lane >> 4;
    LAS v4u* bl = (LAS v4u*)(wl + S5_BOFF);
    const int ax16 = (lane ^ 16) << 2, ax32 = (lane ^ 32) << 2;
    for (int wj = gw >> 3; wj < 256; wj += NGW >> 3) {
        const int wv = gw & 7, c = (wj & 7) * 2 + (wv >> 2), grp = ((wj >> 3) & 15) * 4 + (wv & 3), b = wj >> 7;
        s5_fill_bfrags(P, DISC, grp, bl, lane);
        S5Pw pw[4]; float qr[4], qi[4], cr[4], ci[4];
        const f32x2* E = (const f32x2*)(DISC + 4096);
#pragma unroll
        for (int T = 0; T < 4; ++T) { const f32x2* e = E + (size_t)(grp * 64 + 16 * T + li) * 8; const f32x2 a = e[5], q = e[3 - g4], s16 = e[4];
            pw[T].ar = a[0]; pw[T].ai = a[1]; pw[T].a16r = s16[0]; pw[T].a16i = s16[1]; qr[T] = q[0]; qi[T] = q[1]; cr[T] = 0.f; ci[T] = 0.f; }
        LDS_WAIT();
        const bf16* ub = PROJ + ((size_t)b * SEQ + c * 1024 + li) * NPROJ + PU + grp * 16;
        v4u un0 = {0u, 0u, 0u, 0u}, un1 = {0u, 0u, 0u, 0u};
        if (g4 < 2) { un0 = *(const v4u*)(ub + 8 * g4); un1 = *(const v4u*)(ub + (size_t)16 * NPROJ + 8 * g4); }
#pragma unroll 1
        for (int tt = 0; tt < 64; ++tt) {
            const v4u uv = un0; un0 = un1;
            { const int t2 = tt + 2 < 64 ? tt + 2 : 63; if (g4 < 2) un1 = *(const v4u*)(ub + (size_t)t2 * 16 * NPROJ + 8 * g4); }
            const s16x8 uf = __builtin_bit_cast(s16x8, uv);
            f32x4 dre4[4], dim4[4];
#pragma unroll
            for (int T = 0; T < 4; ++T) { const f32x4 z4 = {0.f, 0.f, 0.f, 0.f};
                dre4[T] = __builtin_amdgcn_mfma_f32_16x16x32_bf16(uf, __builtin_bit_cast(s16x8, bl[T * 64 + lane]), z4, 0, 0, 0); dim4[T] = __builtin_amdgcn_mfma_f32_16x16x32_bf16(uf, __builtin_bit_cast(s16x8, bl[(4 + T) * 64 + lane]), z4, 0, 0, 0); }
            asm volatile("s_nop 7\n\ts_nop 3" : "+v"(dre4[0]), "+v"(dim4[0]), "+v"(dre4[1]), "+v"(dim4[1]), "+v"(dre4[2]), "+v"(dim4[2]), "+v"(dre4[3]), "+v"(dim4[3]));
#pragma unroll
            for (int T = 0; T < 4; ++T) { const f32x4 dre = dre4[T], dim = dim4[T];
                const float a_r = pw[T].ar, a_i = pw[T].ai;
                float hr = dre[0], hi = dim[0];
#pragma unroll
                for (int i = 1; i < 4; ++i) { float nr, ni; CFMA(nr, ni, a_r, a_i, hr, hi, dre[i], dim[i]); hr = nr; hi = ni; }
                float wr, wi; CFMA(wr, wi, qr[T], qi[T], hr, hi, zf, zf);
                wr = aadd(wr, bperm_f(ax16, wr)); wi = aadd(wi, bperm_f(ax16, wi)); wr = aadd(wr, bperm_f(ax32, wr)); wi = aadd(wi, bperm_f(ax32, wi));
                { float nr, ni; CFMA(nr, ni, pw[T].a16r, pw[T].a16i, cr[T], ci[T], wr, wi); cr[T] = nr; ci[T] = ni; } }
        }
        if (g4 == 0) {
#pragma unroll
            for (int T = 0; T < 4; ++T) { const int p = 16 * T + li; const size_t sidx = ((size_t)((b * 64 + grp) * 16 + c) * 64 + p) * 2; LOC[sidx] = cr[T]; LOC[sidx + 1] = ci[T]; } }
        LDS_WAIT();
    }
}
constexpr int S5_XTOFF = 12288;
__device__ __forceinline__ void s5c_ls_phase(const S5P& P, const f32x4* DISC, const bf16* PROJ, const float* CAR, bf16* Zb, LAS unsigned char* wl, int gw, int NGW, int lane) {
    float zf = 0.f; asm volatile("" : "+v"(zf));
    const int li = lane & 15, g4 = lane >> 4;
    LAS v4u* bl = (LAS v4u*)(wl + S5_BOFF); LAS v4u* cl = (LAS v4u*)(wl + S5_COFF); LAS unsigned char* xt = wl + S5_XTOFF;
    const int au16 = ((lane - 16) & 63) << 2, au32 = ((lane - 32) & 63) << 2, ab3 = (48 + li) << 2;
    for (int wj = gw >> 3; wj < 256; wj += NGW >> 3) {
        const int wv = gw & 7, c = (wj & 7) * 2 + (wv >> 2), grp = ((wj >> 3) & 15) * 4 + (wv & 3), b = wj >> 7;
        s5_fill_bfrags(P, DISC, grp, bl, lane);
#pragma unroll
        for (int ks = 0; ks < 4; ++ks) { float cv[8];
#pragma unroll
            for (int j = 0; j < 8; ++j) { const int pp = 32 * ks + 8 * g4 + j; cv[j] = (pp < 64) ? P.c_re[(grp * 16 + li) * 64 + pp] : -P.c_im[(grp * 16 + li) * 64 + pp - 64]; }
            v4u w; w.x = pk2(cv[0], cv[1]); w.y = pk2(cv[2], cv[3]); w.z = pk2(cv[4], cv[5]); w.w = pk2(cv[6], cv[7]); cl[ks * 64 + lane] = w; }
        S5Pw pw[4]; float gr[4], gi[4], cr[4], ci[4];
        const f32x2* E = (const f32x2*)(DISC + 4096);
#pragma unroll
        for (int T = 0; T < 4; ++T) { const int p = 16 * T + li; const f32x2* e = E + (size_t)(grp * 64 + p) * 8; const f32x2 a = e[5], p4 = e[1], p8 = e[2], gq = e[g4];
            pw[T].ar = a[0]; pw[T].ai = a[1]; pw[T].a4r = p4[0]; pw[T].a4i = p4[1]; pw[T].a8r = p8[0]; pw[T].a8i = p8[1]; gr[T] = gq[0]; gi[T] = gq[1];
            const size_t sidx = ((size_t)((b * 64 + grp) * 16 + c) * 64 + p) * 2; cr[T] = CAR[sidx]; ci[T] = CAR[sidx + 1]; }
        float dsk[4];
#pragma unroll
        for (int i = 0; i < 4; ++i) dsk[i] = P.d_skip[grp * 16 + 4 * g4 + i];
        LDS_WAIT();
        const bf16* ub = PROJ + ((size_t)b * SEQ + c * 1024 + li) * NPROJ + PU + grp * 16;
        v4u un0 = {0u, 0u, 0u, 0u}, un1 = {0u, 0u, 0u, 0u};
        if (g4 < 2) { un0 = *(const v4u*)(ub + 8 * g4); un1 = *(const v4u*)(ub + (size_t)16 * NPROJ + 8 * g4); }
        v2u us0 = *(const v2u*)(ub + 4 * g4), us1 = *(const v2u*)(ub + (size_t)16 * NPROJ + 4 * g4);
#pragma unroll 1
        for (int tt = 0; tt < 64; ++tt) {
            const v4u uv = un0; const v2u us = us0; un0 = un1; us0 = us1;
            { const int t2 = tt + 2 < 64 ? tt + 2 : 63; const bf16* u2 = ub + (size_t)t2 * 16 * NPROJ; if (g4 < 2) un1 = *(const v4u*)(u2 + 8 * g4); us1 = *(const v2u*)(u2 + 4 * g4); }
            const s16x8 uf = __builtin_bit_cast(s16x8, uv);
            f32x4 dre4[4], dim4[4];
#pragma unroll
            for (int T = 0; T < 4; ++T) { const f32x4 z4 = {0.f, 0.f, 0.f, 0.f};
                dre4[T] = __builtin_amdgcn_mfma_f32_16x16x32_bf16(uf, __builtin_bit_cast(s16x8, bl[T * 64 + lane]), z4, 0, 0, 0); dim4[T] = __builtin_amdgcn_mfma_f32_16x16x32_bf16(uf, __builtin_bit_cast(s16x8, bl[(4 + T) * 64 + lane]), z4, 0, 0, 0); }
            asm volatile("s_nop 7\n\ts_nop 3" : "+v"(dre4[0]), "+v"(dim4[0]), "+v"(dre4[1]), "+v"(dim4[1]), "+v"(dre4[2]), "+v"(dim4[2]), "+v"(dre4[3]), "+v"(dim4[3]));
#pragma unroll
            for (int T = 0; T < 4; ++T) { const f32x4 dre = dre4[T], dim = dim4[T];
                const float a_r = pw[T].ar, a_i = pw[T].ai;
                float xr[4], xi[4]; xr[0] = dre[0]; xi[0] = dim[0];
#pragma unroll
                for (int i = 1; i < 4; ++i) { CFMA(xr[i], xi[i], a_r, a_i, xr[i - 1], xi[i - 1], dre[i], dim[i]); }
                float er = xr[3], ei = xi[3];
                { float sr = bperm_f(au16, er), si = bperm_f(au16, ei); if (g4 < 1) { sr = 0.f; si = 0.f; } float nr, ni; CFMA(nr, ni, pw[T].a4r, pw[T].a4i, sr, si, er, ei); er = nr; ei = ni; }
                { float sr = bperm_f(au32, er), si = bperm_f(au32, ei); if (g4 < 2) { sr = 0.f; si = 0.f; } float nr, ni; CFMA(nr, ni, pw[T].a8r, pw[T].a8i, sr, si, er, ei); er = nr; ei = ni; }
                float mr = bperm_f(au16, er), mi = bperm_f(au16, ei); if (g4 < 1) { mr = 0.f; mi = 0.f; }
                float tr, ti; CFMA(tr, ti, gr[T], gi[T], cr[T], ci[T], mr, mi);
#pragma unroll
                for (int i = 0; i < 4; ++i) { float nr, ni; CFMA(nr, ni, a_r, a_i, tr, ti, zf, zf); tr = nr; ti = ni; xr[i] = aadd(xr[i], tr); xi[i] = aadd(xi[i], ti); }
                cr[T] = bperm_f(ab3, xr[3]); ci[T] = bperm_f(ab3, xi[3]);
                v2u wre, wim; wre.x = cvt_pk_bf16(xr[0], xr[1]); wre.y = cvt_pk_bf16(xr[2], xr[3]); wim.x = cvt_pk_bf16(xi[0], xi[1]); wim.y = cvt_pk_bf16(xi[2], xi[3]);
                *(LAS v2u*)(xt + (16 * T + li) * 32 + g4 * 8) = wre; *(LAS v2u*)(xt + (64 + 16 * T + li) * 32 + g4 * 8) = wim; }
            f32x4 y = {0.f, 0.f, 0.f, 0.f};
#pragma unroll
            for (int ks = 0; ks < 4; ++ks) { const s16x4 lo = tr_read4(xt + (32 * ks + 8 * g4 + (li >> 2)) * 32 + (li & 3) * 8), hi = tr_read4(xt + (32 * ks + 8 * g4 + 4 + (li >> 2)) * 32 + (li & 3) * 8);
                const s16x8 xf = {lo[0], lo[1], lo[2], lo[3], hi[0], hi[1], hi[2], hi[3]};
                y = __builtin_amdgcn_mfma_f32_16x16x32_bf16(__builtin_bit_cast(s16x8, cl[ks * 64 + lane]), xf, y, 0, 0, 0); }
            const float u4[4] = {bflo(us.x), bfhi(us.x), bflo(us.y), bfhi(us.y)};
            float z[4];
#pragma unroll
            for (int i = 0; i < 4; ++i) z[i] = gelu_tanh_f(y[i] + dsk[i] * u4[i]);
            v2u zo; zo.x = cvt_pk_bf16(z[0], z[1]); zo.y = cvt_pk_bf16(z[2], z[3]);
            *(v2u*)(Zb + ((size_t)b * SEQ + c * 1024 + tt * 16 + li) * 1024 + grp * 16 + 4 * g4) = zo;
        }
        LDS_WAIT();
    }
}
#ifndef PH_MASK
#define PH_MASK 0x1FFF
#endif
#define PHEN(k) (((PH_MASK) >> (k)) & 1)
#ifndef DUP_MASK
#define DUP_MASK 0
#endif
#define NREP(k) ((((DUP_MASK) >> (k)) & 1) ? 2 : 1)
#ifndef SUB_MASK
#define SUB_MASK 0
#endif
#define SUBREP(k) for (int srep = 0; srep < ((((SUB_MASK) >> (k)) & 1) ? 2 : 1); ++srep)
__device__ unsigned g_ctl[2 * (XCD_BAR_WORDS + 64) + 64];
struct Args { const float* in[26]; float* out; unsigned char* ws; int ph_lo, ph_hi; };
__global__ void __launch_bounds__(NTHR, 2) fwd_kernel(Args args) {
    extern __shared__ __attribute__((aligned(16))) unsigned char lds_raw[];
    LAS unsigned char* lds = (LAS unsigned char*)lds_raw;
    volatile LAS unsigned* MISC = (volatile LAS unsigned*)(lds + MISC_OFF);
#define PHASE_IDS() PHASE_PTRS(); int tid = threadIdx.x; asm volatile("" : "+v"(tid)); const int lane = tid & 63, wave = __builtin_amdgcn_readfirstlane(tid >> 6); \
    const int gw = bx * NWAVES + wave, NGW = G * NWAVES, gtid = bx * NTHR + tid, NGT = G * NTHR; (void)lane; (void)gw; (void)NGW; (void)gtid; (void)NGT
#define PHASE_PTRS() int zq = 0, G = gridDim.x, bx = blockIdx.x; asm volatile("" : "+s"(zq), "+s"(G), "+s"(bx)); const __attribute__((address_space(4))) unsigned long long* kargs = (const __attribute__((address_space(4))) unsigned long long*)__builtin_amdgcn_kernarg_segment_ptr(); \
    unsigned char* ws = (unsigned char*)(GAS unsigned char*)kargs[27 + zq]; float* X = (float*)(GAS float*)kargs[26 + zq]; (void)ws; (void)X
#define ARG(k) ((const float*)(const GAS float*)kargs[(k) + zq])
    for (int u = threadIdx.x; u < LDS_BYTES / 16; u += NTHR) ((LAS v4u*)lds)[u] = (v4u){0u, 0u, 0u, 0u};
    __syncthreads();
    { unsigned* gctl = (unsigned*)(GAS unsigned*)g_ctl;
      if (threadIdx.x == 0) MISC[16] = (xb_add(gctl + 2 * (XCD_BAR_WORDS + 64), 1u) / gridDim.x) & 1u;
      __syncthreads();
      const unsigned bsel = (unsigned)__builtin_amdgcn_readfirstlane((int)MISC[16]);
      (void)xcd_barrier_post(gctl + bsel * (XCD_BAR_WORDS + 64), MISC + 8); }
#define GRID_BARRIER() do { XcdBarrier b_; unsigned* gp_ = (unsigned*)(GAS unsigned*)g_ctl; asm volatile("" : "+s"(gp_)); b_.bar = gp_ + (unsigned)__builtin_amdgcn_readfirstlane((int)MISC[16]) * (XCD_BAR_WORDS + 64); b_.x = xb_xcc_id(); b_.st = MISC + 8; xcd_barrier(b_); } while (0)
    const int lo = args.ph_lo, hi = args.ph_hi;
#ifndef START_HOLD
#define START_HOLD 0
#endif
    if (hi - lo > 1) { for (int dl = 0; dl < START_HOLD; ++dl) __builtin_amdgcn_s_sleep(127); }
#define IN(k) (lo <= (k) && (k) < hi)
#define SEAM(k) do { if (IN(k) && IN((k) + 1)) GRID_BARRIER(); } while (0)

#define XN ((bf16*)(ws + WS_XN))
#define PROJ ((bf16*)(ws + WS_PROJ))
#define HID ((bf16*)(ws + WS_PROJ))
#define QKC ((bf16*)(ws + WS_QKC))
#define MIX ((bf16*)(ws + WS_QKC))
#define HM ((float*)(ws + WS_HM))
#define Y ((bf16*)(ws + WS_Y))
#define Z ((bf16*)(ws + WS_Z))
#define LOFF ((size_t)l * SMALL_STRIDE)
#define IFG ((float*)(ws + WS_IFG + LOFF))
#define S5LOC ((float*)(ws + WS_S5LOC + LOFF))
#define S5CAR ((float*)(ws + WS_S5CAR + LOFF))

    for (int l = 0; l < DEPTH; ++l) {
        const int pb = l * NPH;

        if (PHEN(0) && IN(pb + 0)) for (int rep = 0; rep < NREP(0); ++rep) {
            PHASE_IDS();
            { S5P_MAKE(sp, l); s5_disc_phase(sp, (f32x4*)(ws + WS_DISC + LOFF), gtid); }
            wconv_phase(ARG(2) + (size_t)l * DM * N_IN, ARG(17) + (size_t)l * 1024 * 2048, ARG(18) + (size_t)l * 1024 * DM, ARG(19) + (size_t)l * 1024 * DM,
                        ARG(20) + (size_t)l * 1024 * DM, ARG(21) + (size_t)l * DM * DM, ARG(23) + (size_t)l * DM * FF, ARG(24) + (size_t)l * FF * DM, ARG(22) + (size_t)l * DM, ws, lds, gw, NGW, wave, lane);
            __syncthreads();
            { LAS float* IFW = (LAS float*)lds; const float* src = ARG(2) + (size_t)l * DM * N_IN + 4096;
              for (int i = tid; i < DM * 2; i += NTHR) { const int row = i >> 1, hf = i & 1; *(LAS f32x4*)(IFW + row * 8 + hf * 4) = *(const f32x4*)(src + (size_t)row * N_IN + hf * 4); }
              __syncthreads();
              norm_phase<true>((l == 0) ? ARG(0) : (const float*)X, ARG(1) + (size_t)l * DM, XN, IFW, ARG(5) + l * 4, ARG(6) + l * 4, IFG, gw, NGW, lane);
              __syncthreads(); }
        }
        SEAM(pb + 0);
        if (l == 0 && IN(0) && IN(1) && blockIdx.x == 0) { const unsigned bsel = (unsigned)__builtin_amdgcn_readfirstlane((int)MISC[16]); unsigned* gp_ = (unsigned*)(GAS unsigned*)g_ctl; asm volatile("" : "+s"(gp_)); unsigned* other = gp_ + (bsel ^ 1u) * (XCD_BAR_WORDS + 64);
            int tz = threadIdx.x; asm volatile("" : "+v"(tz));
            for (int u = tz; u < XCD_BAR_WORDS + 64; u += NTHR) __hip_atomic_store(other + u, 0u, __ATOMIC_RELAXED, __HIP_MEMORY_SCOPE_AGENT); }
        if (PHEN(1) && IN(pb + 1)) for (int rep = 0; rep < NREP(1); ++rep) {
            PHASE_PTRS();
            pg8::Gemm g{XN, (const bf16*)(ws + WS_WIN), M, NPROJ, DM, DM, DM}; pg8::StaticOrder S; S.init(M, NPROJ, G, bx);
            EpiProj E{PROJ};
            pg8::gemm_phase<EpiProj, pg8::StaticOrder>(lds, g, S, E);
        }
        SEAM(pb + 1);
        if (PHEN(2) && IN(pb + 2)) for (int rep = 0; rep < NREP(2); ++rep) {
            PHASE_IDS();
            S5P_MAKE(sp, l);
            SUBREP(0) mconv_phase(PROJ, ARG(3) + (size_t)l * 4 * 2048, ARG(4) + (size_t)l * 2048, QKC, gtid, NGT);
            SUBREP(1) s5a_ls_phase(sp, (const f32x4*)(ws + WS_DISC + LOFF), PROJ, S5LOC, lds + wave * S5_WLDS, gw, NGW, lane);
        }
        SEAM(pb + 2);
        if (PHEN(3) && IN(pb + 3)) for (int rep = 0; rep < NREP(3); ++rep) {
            PHASE_IDS();
            S5P_MAKE(sp, l);
            SUBREP(2) mlstm_a1_phase(QKC, PROJ, IFG, (bf16*)(ws + WS_CST), (float*)(ws + WS_MF + LOFF), lds, bx, G, tid);
            SUBREP(3) s5_carry_phase((const f32x4*)(ws + WS_DISC + LOFF), S5LOC, S5CAR, gtid, NGT);
        }
        SEAM(pb + 3);
        if (PHEN(4) && IN(pb + 4)) for (int rep = 0; rep < NREP(4); ++rep) { PHASE_IDS(); mlstm_a2_phase((const bf16*)(ws + WS_CST), (bf16*)(ws + WS_CIN), (const float*)(ws + WS_MF + LOFF), gtid, NGT); }
        SEAM(pb + 4);
        if (PHEN(5) && IN(pb + 5)) for (int rep = 0; rep < NREP(5); ++rep) {
            PHASE_IDS();
            S5P_MAKE(sp, l);
            SUBREP(4) { mlstm_a3_phase(QKC, PROJ, IFG, (const bf16*)(ws + WS_CIN), ARG(7) + (size_t)l * 1024, Y, lds, bx, G, tid);
            __syncthreads(); }
            SUBREP(5) { attn_mfma_phase(PROJ, ARG(8), (bf16*)(ws + WS_ATT), (float*)(ws + WS_LSE + LOFF), lds, bx, G, tid);
            __syncthreads(); }
            SUBREP(6) { s5c_ls_phase(sp, (const f32x4*)(ws + WS_DISC + LOFF), PROJ, S5CAR, Z, lds + wave * S5_WLDS, gw, NGW, lane);
            __syncthreads(); }
        }
        SEAM(pb + 5);
        if (PHEN(6) && IN(pb + 6)) for (int rep = 0; rep < NREP(6); ++rep) {
            SUBREP(7) { PHASE_IDS(); attn_merge_phase((const bf16*)(ws + WS_ATT), (const float*)(ws + WS_LSE + LOFF), Y + 1024, gw, NGW, lane); }
            PHASE_PTRS();
            pg8::Gemm g{Z, (const bf16*)(ws + WS_WGLU), M, 2048, 1024, 1024, 1024}; pg8::StaticOrder S; S.init(M, 2048, G, bx);
            EpiGlu E{Y + 2048, 3072};
            pg8::gemm_phase<EpiGlu, pg8::StaticOrder>(lds, g, S, E);
        }
        SEAM(pb + 6);
        if (PHEN(7) && IN(pb + 7)) for (int rep = 0; rep < NREP(7); ++rep) {
            PHASE_PTRS();
            pg8::Gemm g{Y, (const bf16*)(ws + WS_WBR), M, DM, 3072, 3072, 3072}; pg8::StaticOrder S; S.init(M, DM, G, bx);
            EpiMerge E{PROJ + PG, MIX};
            pg8::gemm_phase<EpiMerge, pg8::StaticOrder>(lds, g, S, E);
        }
        SEAM(pb + 7);
        if (PHEN(8) && IN(pb + 8)) {
            PHASE_PTRS();
            pg8::Gemm g{MIX, (const bf16*)(ws + WS_WOUT), M, DM, DM, DM, DM}; pg8::StaticOrder S; S.init(M, DM, G, bx);
            EpiResidT<true> E{(l == 0) ? ARG(0) : (const float*)X, X, 1.0f};
            pg8::gemm_phase<EpiResidT<true>, pg8::StaticOrder>(lds, g, S, E);
        }
        SEAM(pb + 8);
        if (PHEN(9) && IN(pb + 9)) { PHASE_IDS();
            const f32x4* pp = (const f32x4*)(GAS const f32x4*)(ws + WS_Y); float* rsd = (float*)(GAS float*)(ws + WS_Y + 8 * MiB);
            for (int m = gtid; m < M; m += NGT) { f32x4 a = pp[(size_t)m * 8];
#pragma unroll
                for (int j = 1; j < 8; ++j) a += pp[(size_t)m * 8 + j];
                rsd[m] = 1.0f / sqrtf(((a[0] + a[1]) + (a[2] + a[3])) * (1.0f / DM) + NORM_EPS); } }
        SEAM(pb + 9);
        if (PHEN(10) && IN(pb + 10)) for (int rep = 0; rep < NREP(10); ++rep) {
            PHASE_PTRS();
            pg8::Gemm g{XN, (const bf16*)(ws + WS_W1), M, FF, DM, DM, DM}; pg8::StaticOrder S; S.init(M, FF, G, bx);
            EpiFF1 E{HID, (const float*)(GAS const float*)(ws + WS_Y + 8 * MiB)};
            pg8::gemm_phase<EpiFF1, pg8::StaticOrder>(lds, g, S, E);
        }
        SEAM(pb + 10);
        if (PHEN(11) && IN(pb + 11)) {
            PHASE_PTRS();
            pg8::Gemm g{HID, (const bf16*)(ws + WS_W2), M, DM, FF, FF, FF}; pg8::StaticOrder S; S.init(M, DM, G, bx);
            EpiResid E{X, X, ABL_SF};
            pg8::gemm_phase<EpiResid, pg8::StaticOrder>(lds, g, S, E);
        }
        SEAM(pb + 11);
    }
    if (PHEN(12) && IN(DEPTH * NPH)) {
        PHASE_IDS();
        const float* gain = ARG(25);
        f32x4 gv[8];
#pragma unroll
        for (int j = 0; j < 8; ++j) gv[j] = *(const f32x4*)(gain + 4 * lane + 256 * j);
        for (int m = gw; m < M; m += NGW) {
            f32x4* xr = (f32x4*)(X + (size_t)m * DM) + lane;
            f32x4 v[8]; float ss = 0.f;
#pragma unroll
            for (int j = 0; j < 8; ++j) { v[j] = xr[64 * j]; ss += (v[j].x * v[j].x + v[j].y * v[j].y) + (v[j].z * v[j].z + v[j].w * v[j].w); }
            const float rstd = 1.0f / sqrtf(wave_sum(ss) * (1.0f / DM) + NORM_EPS);
#pragma unroll
            for (int j = 0; j < 8; ++j) xr[64 * j] = (v[j] * rstd) * gv[j];
        }
    }
#undef IN
#undef SEAM
}

extern "C" void kernel_launch(void* const* d_in, const int* in_sizes, int n_in, void* d_out, int out_size, void* d_ws, size_t ws_size, hipStream_t stream) {
    static int grid = 0;
    if (grid == 0) {
        if (n_in != 26 || in_sizes[0] != M * DM || out_size != M * DM || ws_size < WS_END) { fprintf(stderr, "kernel_launch: unexpected shapes (n_in %d, in0 %d, out %d, ws %zu); nothing launched\n", n_in, n_in > 0 ? in_sizes[0] : -1, out_size, ws_size); grid = -1; return; }
        int dev = 0, cus = 0, per_cu = 0;
        if (hipGetDevice(&dev) != hipSuccess || hipDeviceGetAttribute(&cus, hipDeviceAttributeMultiprocessorCount, dev) != hipSuccess) { grid = -1; return; }
        if (hipFuncSetAttribute((const void*)fwd_kernel, hipFuncAttributeMaxDynamicSharedMemorySize, LDS_BYTES) != hipSuccess) { fprintf(stderr, "kernel_launch: hipFuncSetAttribute failed\n"); grid = -1; return; }
        if (hipOccupancyMaxActiveBlocksPerMultiprocessor(&per_cu, (const void*)fwd_kernel, NTHR, LDS_BYTES) != hipSuccess || per_cu < 1) fprintf(stderr, "kernel_launch: occupancy query reports %d\n", per_cu);
        (void)hipGetLastError();
        grid = cus;
    }
    if (grid < 0) return;
    Args a{};
    for (int i = 0; i < 26; ++i) a.in[i] = (const float*)d_in[i];
    a.out = (float*)d_out; a.ws = (unsigned char*)d_ws;
#if MK_SPLIT
    for (int p = 0; p < NPHASES; ++p) { a.ph_lo = p; a.ph_hi = p + 1; hipLaunchKernelGGL(fwd_kernel, dim3(grid), dim3(NTHR), LDS_BYTES, stream, a); }
#else
    a.ph_lo = 0; a.ph_hi = NPHASES;
    hipLaunchKernelGGL(fwd_kernel, dim3(grid), dim3(NTHR), LDS_BYTES, stream, a);
#endif
    const hipError_t le = hipPeekAtLastError();
    if (le != hipSuccess) fprintf(stderr, "kernel_launch: launch failed: %s\n", hipGetErrorName(le));
}
```

```cpp
#include <hip/hip_runtime.h>
#include <cstdio>
#include <cstdint>
namespace pg8 {
#define PG8_LAS __attribute__((address_space(3)))
typedef unsigned short bf16_t;
typedef short bf16x8 __attribute__((ext_vector_type(8)));
typedef float f32x4 __attribute__((ext_vector_type(4)));
typedef unsigned u32x4 __attribute__((ext_vector_type(4)));
constexpr int BM = 256, BK = 64, HALF = 128, HTB = HALF * BK * 2  , STAGE_BYTES = 8 * HTB, NXCD = 8, WGM = 8;

__host__ __device__ __forceinline__ int lds_byte(int r, int c) { const int st = (r >> 4) * 2 + (c >> 5), rr = r & 15, cc = c & 31, ob = rr * 64 + cc * 2; return st * 1024 + (ob ^ (((ob >> 9) & 1) << 5)); }
__host__ __device__ __forceinline__ void stage_rc(int b, int& R, int& C) { const int st = b / 1024, sb = b % 1024, swz = sb ^ (((sb >> 9) & 1) << 5); R = (st >> 1) * 16 + swz / 64; C = (st & 1) * 32 + (swz % 64) / 2; }
__host__ __device__ __forceinline__ int perm32(int rho) { const int n = rho >> 4, i = rho & 15; return 8 * (i >> 2) + 4 * n + (i & 3); }

struct Unit { int pm, pn; };
struct Gemm { const bf16_t* A; const bf16_t* Bt; int M, N, K, lda, ldb; };

struct StaticOrder {
    int nM, nN, nwg, G, c;
    __host__ __device__ void init(int M, int N, int G_, int c_) { nM = M / BM; nN = N / BM; nwg = nM * nN; G = G_; c = c_; }
    __host__ __device__ bool next(int i, Unit& u) const {
        const long L = (long)i * G + c; if (L >= nwg) return false;
        int wgid = (int)L; { const int q = nwg / NXCD, r = nwg % NXCD, xcd = wgid % NXCD, off = wgid / NXCD; wgid = (xcd < r ? xcd * (q + 1) : r * (q + 1) + (xcd - r) * q) + off; }
        const int nig = WGM * nN, gid = wgid / nig, fm = gid * WGM, gsz = (nM - fm) < WGM ? (nM - fm) : WGM;
        u.pm = fm + ((wgid % nig) % gsz); u.pn = (wgid % nig) / gsz; return true;
    }
    __device__ __forceinline__ void a_ready(const Unit&) const {}
    __device__ __forceinline__ void done(const Unit&) const {}
};

typedef __bf16 bf16x2_t __attribute__((ext_vector_type(2)));
typedef float f32x2_t __attribute__((ext_vector_type(2)));
__device__ __forceinline__ unsigned cvt_pk_bf16(float lo, float hi) { const f32x2_t v = {lo, hi}; const bf16x2_t r = __builtin_convertvector(v, bf16x2_t); return __builtin_bit_cast(unsigned, r); }

template <class Epi, class Sched, bool ALIGN_EPI = true>
__device__ __forceinline__ void gemm_phase(PG8_LAS unsigned char* lds, const Gemm g, const Sched& S, const Epi& E) {
    int tid = threadIdx.x; asm volatile("" : "+v"(tid));
    const int wid = __builtin_amdgcn_readfirstlane(tid >> 6), lane = tid & 63, wr = wid >> 2, wc = wid & 3, fr = lane & 15, fq = lane >> 4;
    const int nt = g.K / BK;
    unsigned voffA[2], voffB[2];
#pragma unroll
    for (int i = 0; i < 2; ++i) { int R, C; stage_rc(tid * 16 + i * 8192, R, C); const int Rb = Epi::PERM ? ((R & ~31) + perm32(R & 31)) : R;
        voffA[i] = (unsigned)(R * g.lda + C) * 2u; voffB[i] = (unsigned)(Rb * g.ldb + C) * 2u; }
    const size_t kstep = (size_t)(BK * 2);
    const size_t hstepA = (size_t)HALF * g.lda * 2, hstepB = (size_t)HALF * g.ldb * 2;
    const size_t tstepA = 2 * hstepA, tstepB = 2 * hstepB;
    const unsigned ldsw = (unsigned)wid * 1024u;
    const int aoff = lds_byte(wr * 64 + fr, fq * 8), boff = lds_byte(wc * 32 + fr, fq * 8);
#define PG8_SA(b, h) (((b) * 2 + (h)) * HTB)
#define PG8_SB(b, h) ((4 + (b) * 2 + (h)) * HTB)
#define PG8_STAGE(bufoff, gbase, voff) do { _Pragma("unroll") for (int _i = 0; _i < 2; ++_i) \
        __builtin_amdgcn_global_load_lds((const unsigned*)((const char*)(gbase) + (voff)[_i]), (PG8_LAS unsigned*)(lds + (bufoff) + ldsw + _i * 8192), 16, 0, 0); } while (0)
#define PG8_LDA(dst, b, h) do { _Pragma("unroll") for (int m = 0; m < 4; ++m) _Pragma("unroll") for (int k = 0; k < 2; ++k) dst[m][k] = *(const PG8_LAS bf16x8*)(lds + PG8_SA(b, h) + aoff + m * 2048 + k * 1024); } while (0)
#define PG8_LDB(dst, b, h) do { _Pragma("unroll") for (int n = 0; n < 2; ++n) _Pragma("unroll") for (int k = 0; k < 2; ++k) dst[n][k] = *(const PG8_LAS bf16x8*)(lds + PG8_SB(b, h) + boff + n * 2048 + k * 1024); } while (0)
#define PG8_MMA(ai, bj, At, Bt) do { __builtin_amdgcn_s_setprio(1); _Pragma("unroll") for (int m = 0; m < 4; ++m) _Pragma("unroll") for (int n = 0; n < 2; ++n) _Pragma("unroll") for (int k = 0; k < 2; ++k) \
        acc[ai][bj][m][n] = __builtin_amdgcn_mfma_f32_16x16x32_bf16(Bt[n][k], At[m][k], acc[ai][bj][m][n], 0, 0, 0); __builtin_amdgcn_s_setprio(0); } while (0)
#define PG8_WAIT_V(n) asm volatile("s_waitcnt vmcnt(" #n ")" ::: "memory")
#define PG8_WAIT_L(n) asm volatile("s_waitcnt lgkmcnt(" #n ")" ::: "memory")
#define PG8_BAR __builtin_amdgcn_s_barrier()
#define PG8_SCHED __builtin_amdgcn_sched_barrier(0)
    Unit cur, nxt; int ui = 0;
    if (!S.next(0, cur)) return;
    f32x4 acc[2][2][4][2];
#pragma unroll
    for (int a = 0; a < 2; ++a)
#pragma unroll
        for (int b = 0; b < 2; ++b)
#pragma unroll
            for (int m = 0; m < 4; ++m)
#pragma unroll
                for (int n = 0; n < 2; ++n) acc[a][b][m][n] = (f32x4){0.f, 0.f, 0.f, 0.f};
    bf16x8 At[4][2], B0[2][2], B1[2][2];
    const char* cA = (const char*)g.A + (size_t)cur.pm * tstepA; const char* cB = (const char*)g.Bt + (size_t)cur.pn * tstepB;
    S.a_ready(cur);
    PG8_STAGE(PG8_SB(0, 0), cB, voffB); PG8_STAGE(PG8_SB(0, 1), cB + hstepB, voffB); PG8_STAGE(PG8_SA(0, 0), cA, voffA); PG8_STAGE(PG8_SA(0, 1), cA + hstepA, voffA);
    if (wr == 1) PG8_BAR;
    PG8_WAIT_V(2); PG8_BAR;
    PG8_STAGE(PG8_SB(1, 0), cB + kstep, voffB); PG8_STAGE(PG8_SA(1, 0), cA + kstep, voffA); PG8_STAGE(PG8_SB(1, 1), cB + hstepB + kstep, voffB);
    PG8_WAIT_V(6); PG8_BAR;
    for (;;) {
        const bool has_next = S.next(ui + 1, nxt);
        const char* nA = has_next ? (const char*)g.A + (size_t)nxt.pm * tstepA : cA; const char* nB = has_next ? (const char*)g.Bt + (size_t)nxt.pn * tstepB : cB;
        for (int t = 0; t < nt; t += 2) {
            const bool last = (t == nt - 2);
            const char* a1 = cA + (size_t)(t + 1) * kstep;
            const char* a2 = last ? nA : cA + (size_t)(t + 2) * kstep; const char* b2 = last ? nB : cB + (size_t)(t + 2) * kstep;
            const char* a3 = a2 + kstep; const char* b3 = b2 + kstep;
            if (last && has_next) S.a_ready(nxt);
            if constexpr (Epi::MIDK) { if (t == 16 || t == 32) E.mid(acc, cur, t, wr, wc, fr, fq); }
            PG8_LDB(B0, 0, 0); PG8_LDB(B1, 0, 1); PG8_SCHED; PG8_LDA(At, 0, 0); PG8_STAGE(PG8_SA(1, 1), a1 + hstepA, voffA);
            PG8_WAIT_V(8); PG8_WAIT_L(0); PG8_BAR; PG8_MMA(0, 0, At, B0); PG8_MMA(0, 1, At, B1); PG8_BAR; PG8_SCHED;
            PG8_LDA(At, 0, 1); PG8_STAGE(PG8_SB(0, 0), b2, voffB); PG8_STAGE(PG8_SB(0, 1), b2 + hstepB, voffB); PG8_STAGE(PG8_SA(0, 0), a2, voffA);
            PG8_WAIT_V(8); PG8_WAIT_L(0); PG8_BAR; PG8_MMA(1, 0, At, B0); PG8_MMA(1, 1, At, B1); PG8_BAR; PG8_SCHED;
            PG8_LDB(B0, 1, 0); PG8_LDB(B1, 1, 1); PG8_SCHED; PG8_LDA(At, 1, 0); PG8_STAGE(PG8_SA(0, 1), a2 + hstepA, voffA);
            PG8_WAIT_V(8); PG8_WAIT_L(0); PG8_BAR; PG8_MMA(0, 0, At, B0); PG8_MMA(0, 1, At, B1); PG8_BAR; PG8_SCHED;
            PG8_LDA(At, 1, 1); PG8_STAGE(PG8_SB(1, 0), b3, voffB); PG8_STAGE(PG8_SB(1, 1), b3 + hstepB, voffB); PG8_STAGE(PG8_SA(1, 0), a3, voffA);
            PG8_WAIT_V(8); PG8_WAIT_L(0); PG8_BAR; PG8_MMA(1, 0, At, B0); PG8_MMA(1, 1, At, B1); PG8_BAR; PG8_SCHED;
        }
        if constexpr (ALIGN_EPI) { if (wr == 0) PG8_BAR; }
        E(acc, cur, wr, wc, fr, fq); S.done(cur);
        if (!has_next) break;
#pragma unroll
        for (int a = 0; a < 2; ++a)
#pragma unroll
            for (int b = 0; b < 2; ++b)
#pragma unroll
                for (int m = 0; m < 4; ++m)
#pragma unroll
                    for (int n = 0; n < 2; ++n) acc[a][b][m][n] = (f32x4){0.f, 0.f, 0.f, 0.f};
        cur = nxt; cA = nA; cB = nB; ++ui;
        if constexpr (ALIGN_EPI) { if (wr == 1) PG8_BAR; }
    }
    PG8_WAIT_V(0);
    if constexpr (!ALIGN_EPI) { if (wr == 0) PG8_BAR; }
    PG8_BAR;
#undef PG8_SA
#undef PG8_SB
#undef PG8_STAGE
#undef PG8_LDA
#undef PG8_LDB
#undef PG8_MMA
#undef PG8_WAIT_V
#undef PG8_WAIT_L
#undef PG8_BAR
#undef PG8_SCHED
}
}
constexpr int BATCH = 2, SEQ = 16384, DM = 2048, DEPTH = 4, M = BATCH * SEQ, FF = 8192;
constexpr int N_IN = 20488, NPROJ = 20480;
constexpr int PQ = 0, PK = 1024, PV = 2048, PO = 3072, PAQ = 4096, PAK = 7168, PAV = 10240, PU = 13312, PG = 14336;
constexpr float NORM_EPS = 1e-6f;
constexpr int NWAVES = 8, NTHR = 512;
constexpr int NPH = 12, NPHASES = DEPTH * NPH + 1;
#ifndef ABL_SA
#define ABL_SA 1.0f
#endif
#ifndef ABL_SB
#define ABL_SB 1.0f
#endif
#ifndef ABL_SC
#define ABL_SC 1.0f
#endif
#ifndef ABL_SM
#define ABL_SM 1.0f
#endif
#ifndef ABL_SF
#define ABL_SF 1.0f
#endif
#if defined(ABL_HOOKFREE_A)
#define ABL_FINAL_GATE 0
#else
#define ABL_FINAL_GATE 2
#endif
#ifndef MK_SPLIT
#define MK_SPLIT 0
#endif

constexpr size_t MiB = 1u << 20;
constexpr size_t WS_CTL = 0, CTL_ZERO_BYTES = 1 * MiB;
constexpr size_t WS_SMALL = 2424 * MiB, SMALL_STRIDE = 8 * MiB;
constexpr size_t WS_IFG = WS_SMALL;
constexpr size_t WS_S5LOC = WS_SMALL + 1 * MiB, WS_S5CAR = WS_SMALL + 2 * MiB;
constexpr size_t WS_WIN = 8 * MiB, WS_WGLU = 88 * MiB, WS_WBR = 92 * MiB, WS_WOUT = 104 * MiB, WS_W1 = 112 * MiB, WS_W2 = 144 * MiB;
constexpr size_t WS_XN = 176 * MiB;
constexpr size_t WS_PROJ = 304 * MiB;
constexpr size_t WS_QKC = 1584 * MiB;
constexpr size_t WS_HM = 1712 * MiB;
constexpr size_t WS_Y = 1712 * MiB;
constexpr size_t WS_Z = 1904 * MiB;
constexpr size_t WS_ATT = 1968 * MiB;
constexpr size_t WS_LSE = WS_SMALL + 4 * MiB;
constexpr size_t WS_CST = 2164 * MiB;
constexpr size_t WS_CIN = 2294 * MiB;
constexpr size_t WS_MF = WS_SMALL + 3 * MiB;
constexpr size_t WS_DISC = WS_SMALL + 3 * MiB + 512 * 1024;
constexpr size_t WS_END = 2456 * MiB;
constexpr int CW_BAR = 4096;

constexpr int RING_BYTES = 131072, MISC_OFF = 148480, LDS_BYTES = 149504;

#define GAS __attribute__((address_space(1)))
#define LAS __attribute__((address_space(3)))
typedef unsigned short bf16;
typedef unsigned v4u __attribute__((ext_vector_type(4)));
typedef unsigned v2u __attribute__((ext_vector_type(2)));
typedef float f32x4 __attribute__((ext_vector_type(4)));
typedef float f32x2 __attribute__((ext_vector_type(2)));
#define LDS_WAIT() asm volatile("s_waitcnt lgkmcnt(0)" ::: "memory")
__device__ __forceinline__ unsigned f2bf(float f) { unsigned u = __builtin_bit_cast(unsigned, f); return (u + 0x7fffu + ((u >> 16) & 1u)) >> 16; }
__device__ __forceinline__ unsigned pk2(float lo, float hi) { return f2bf(lo) | (f2bf(hi) << 16); }
__device__ __forceinline__ float bflo(unsigned u) { return __builtin_bit_cast(float, u << 16); }
__device__ __forceinline__ float bfhi(unsigned u) { return __builtin_bit_cast(float, u & 0xffff0000u); }
__device__ __forceinline__ float bf1(bf16 b) { return __builtin_bit_cast(float, (unsigned)b << 16); }
__device__ __forceinline__ float sigmoid_f(float v) { return __builtin_amdgcn_rcpf(1.0f + __builtin_amdgcn_exp2f(-1.44269504f * v)); }
__device__ __forceinline__ float wave_sum(float v) {
#pragma unroll
    for (int o = 1; o < 64; o <<= 1) v += __shfl_xor(v, o);
    return v;
}

#define XB_TMO      128
#define XB_XCNT(j)  (256  + 64 * (j))
#define XB_XSUB(j)  (1280 + 64 * (j))
#define XB_XGEN(j)  (2304 + 64 * (j))
#define XB_TOP      3328
#define XB_TOPGEN   3392
#define XCD_BAR_WORDS 3456
#define XB_SPIN_CAP (1u << 18)
__device__ __forceinline__ unsigned xb_ld(unsigned* p)              { return __hip_atomic_load(p, __ATOMIC_RELAXED, __HIP_MEMORY_SCOPE_AGENT); }
__device__ __forceinline__ unsigned xb_add(unsigned* p, unsigned v) { return __hip_atomic_fetch_add(p, v, __ATOMIC_RELAXED, __HIP_MEMORY_SCOPE_AGENT); }
__device__ __forceinline__ unsigned xb_xcc_id() { return (unsigned)__builtin_amdgcn_s_getreg((3 << 11) | 20) & 0xFu; }
#define XB_SPIN(cond, bar) do { unsigned _sp = 0; while (cond) { __builtin_amdgcn_s_sleep(1); \
    if ((++_sp & 255u) == 0u) { if (xb_ld(&(bar)[XB_TMO])) break; if (_sp > XB_SPIN_CAP) { atomicAdd(&(bar)[XB_TMO], 1u); break; } } } } while (0)
struct XcdBarrier { unsigned* bar; unsigned x; volatile LAS unsigned* st; };
__device__ __forceinline__ XcdBarrier xcd_barrier_post(unsigned* bar, volatile LAS unsigned* st) {
    XcdBarrier b; b.bar = bar; b.x = xb_xcc_id(); b.st = st;
    if (threadIdx.x == 0) (void)xb_add(&bar[XB_XCNT(b.x)], 1u);
    return b;
}
__device__ __forceinline__ void xcd_barrier_complete(unsigned* bar, unsigned x, unsigned& nloc, unsigned& nx) {
    const unsigned G = gridDim.x * gridDim.y * gridDim.z;
    unsigned sum, cnt, mine, sp = 0u;
    for (;;) {
        sum = 0u; cnt = 0u; mine = 0u;
#pragma unroll
        for (unsigned j = 0; j < 16; ++j) { const unsigned c = xb_ld(&bar[XB_XCNT(j)]); sum += c; cnt += (c > 0u) ? 1u : 0u; mine = (j == x) ? c : mine; }
        if (sum == G) break;
        __builtin_amdgcn_s_sleep(1);
        if ((++sp & 255u) == 0u) { if (xb_ld(&bar[XB_TMO])) break; if (sp > XB_SPIN_CAP) { atomicAdd(&bar[XB_TMO], 1u); break; } }
    }
    nloc = mine > 0u ? mine : 1u; nx = cnt > 0u ? cnt : 1u;
}
__device__ __forceinline__ void xcd_barrier(const XcdBarrier& b) {
    asm volatile("s_waitcnt vmcnt(0)" ::: "memory");
    __syncthreads();
    if (threadIdx.x == 0) {
        unsigned* bar = b.bar;
        __builtin_amdgcn_s_waitcnt(0);
        unsigned nloc = b.st[0], nx = b.st[1];
        if (nloc == 0u) { xcd_barrier_complete(bar, b.x, nloc, nx); b.st[0] = nloc; b.st[1] = nx; }
        const unsigned old = xb_add(&bar[XB_XSUB(b.x)], 1u);
        const unsigned gen = old / nloc;
        if (old + 1u == (gen + 1u) * nloc) {
            __builtin_amdgcn_fence(__ATOMIC_RELEASE, "agent");
            asm volatile("s_waitcnt vmcnt(0)" ::: "memory");
            const unsigned og = xb_add(&bar[XB_TOP], 1u);
            const unsigned tg = og / nx;
            if (og + 1u == (tg + 1u) * nx) xb_add(&bar[XB_TOPGEN], 1u);
            else XB_SPIN(xb_ld(&bar[XB_TOPGEN]) == tg, bar);
            __builtin_amdgcn_fence(__ATOMIC_ACQUIRE, "agent");
            xb_add(&bar[XB_XGEN(b.x)], 1u);
            asm volatile("s_waitcnt vmcnt(0)" ::: "memory");
        } else {
            XB_SPIN(xb_ld(&bar[XB_XGEN(b.x)]) == gen, bar);
            __builtin_amdgcn_fence(__ATOMIC_ACQUIRE, "agent");
            asm volatile("s_waitcnt vmcnt(0)" ::: "memory");
        }
    }
    __syncthreads();
}
using pg8::Unit; using pg8::cvt_pk_bf16;
#define EPI_ROWCOL_PERM() const int row0 = u.pm * 256 + wr * 64 + fr, colt = wc * 32 + 8 * fq
struct EpiProj {
    static constexpr bool PERM = true, MIDK = false;
    bf16* O;
    __device__ __forceinline__ void operator()(const f32x4 (&acc)[2][2][4][2], const Unit& u, int wr, int wc, int fr, int fq) const {
        EPI_ROWCOL_PERM();
        const bool sg = (u.pn >= 12 && u.pn < 16) || (u.pn >= 56);
#pragma unroll
        for (int ai = 0; ai < 2; ++ai)
#pragma unroll
            for (int m = 0; m < 4; ++m) { bf16* rowp = O + (size_t)(row0 + ai * 128 + m * 16) * NPROJ + u.pn * 256 + colt;
#pragma unroll
                for (int bj = 0; bj < 2; ++bj) { f32x4 v0 = acc[ai][bj][m][0], v1 = acc[ai][bj][m][1];
                    if (sg) {
#pragma unroll
                        for (int j = 0; j < 4; ++j) { v0[j] = sigmoid_f(v0[j]); v1[j] = sigmoid_f(v1[j]); } }
                    v4u w; w.x = cvt_pk_bf16(v0[0], v0[1]); w.y = cvt_pk_bf16(v0[2], v0[3]); w.z = cvt_pk_bf16(v1[0], v1[1]); w.w = cvt_pk_bf16(v1[2], v1[3]);
                    __builtin_nontemporal_store(w, (v4u*)(rowp + bj * 128)); } }
    }
};
struct EpiGlu {
    static constexpr bool PERM = true, MIDK = false;
    bf16* O; int ldc;
    __device__ __forceinline__ void operator()(const f32x4 (&acc)[2][2][4][2], const Unit& u, int wr, int wc, int fr, int fq) const {
        EPI_ROWCOL_PERM();
#pragma unroll
        for (int ai = 0; ai < 2; ++ai)
#pragma unroll
            for (int m = 0; m < 4; ++m) { bf16* rowp = O + (size_t)(row0 + ai * 128 + m * 16) * ldc + u.pn * 128 + colt;
                f32x4 v0 = acc[ai][0][m][0], v1 = acc[ai][0][m][1]; const f32x4 g0 = acc[ai][1][m][0], g1 = acc[ai][1][m][1];
#pragma unroll
                for (int j = 0; j < 4; ++j) { v0[j] *= sigmoid_f(g0[j]); v1[j] *= sigmoid_f(g1[j]); }
                v4u w; w.x = cvt_pk_bf16(v0[0], v0[1]); w.y = cvt_pk_bf16(v0[2], v0[3]); w.z = cvt_pk_bf16(v1[0], v1[1]); w.w = cvt_pk_bf16(v1[2], v1[3]);
                *(v4u*)rowp = w; }
    }
};
struct EpiMerge {
    static constexpr bool PERM = true, MIDK = true;
    const bf16* G; bf16* O;
    __device__ __forceinline__ void mid(f32x4 (&acc)[2][2][4][2], const Unit& u, int t, int wr, int wc, int fr, int fq) const {
        unsigned voff = (unsigned)(fr * NPROJ + wc * 32 + 8 * fq) * 2u; asm volatile("" : "+v"(voff));
        int pmz = u.pm; asm volatile("" : "+s"(pmz));
#if defined(ABL_HOOKFREE_A)
        return;
#endif
        const int br = (t >> 4) - 1;
        const char* ub = (const char*)G + ((size_t)(pmz * 256 + wr * 64) * NPROJ + br * 2048 + u.pn * 256) * 2;
#pragma unroll
        for (int ai = 0; ai < 2; ++ai)
#pragma unroll
            for (int m = 0; m < 4; ++m) { const char* rb = ub + (size_t)(ai * 128 + m * 16) * NPROJ * 2;
#pragma unroll
                for (int bj = 0; bj < 2; ++bj) { const v4u sp = *(const v4u*)(rb + bj * 256 + voff), sn = *(const v4u*)(rb + 4096 + bj * 256 + voff);
                    f32x4 r0, r1;
                    r0[0] = bflo(sp.x) * __builtin_amdgcn_rcpf(fmaxf(bflo(sn.x), 1e-30f)); r0[1] = bfhi(sp.x) * __builtin_amdgcn_rcpf(fmaxf(bfhi(sn.x), 1e-30f));
                    r0[2] = bflo(sp.y) * __builtin_amdgcn_rcpf(fmaxf(bflo(sn.y), 1e-30f)); r0[3] = bfhi(sp.y) * __builtin_amdgcn_rcpf(fmaxf(bfhi(sn.y), 1e-30f));
                    r1[0] = bflo(sp.z) * __builtin_amdgcn_rcpf(fmaxf(bflo(sn.z), 1e-30f)); r1[1] = bfhi(sp.z) * __builtin_amdgcn_rcpf(fmaxf(bfhi(sn.z), 1e-30f));
                    r1[2] = bflo(sp.w) * __builtin_amdgcn_rcpf(fmaxf(bflo(sn.w), 1e-30f)); r1[3] = bfhi(sp.w) * __builtin_amdgcn_rcpf(fmaxf(bfhi(sn.w), 1e-30f));
                    acc[ai][bj][m][0] *= r0; acc[ai][bj][m][1] *= r1; }
                if (m & 1) asm volatile("" ::: "memory"); }
    }
    __device__ __forceinline__ void operator()(const f32x4 (&acc)[2][2][4][2], const Unit& u, int wr, int wc, int fr, int fq) const {
        EPI_ROWCOL_PERM();
#pragma unroll
        for (int ai = 0; ai < 2; ++ai)
#pragma unroll
            for (int m = 0; m < 4; ++m) { const size_t row = (size_t)(row0 + ai * 128 + m * 16); const bf16* gp = G + row * NPROJ + ABL_FINAL_GATE * 2048 + u.pn * 256 + colt; bf16* op = O + row * 2048 + u.pn * 256 + colt;
#pragma unroll
                for (int bj = 0; bj < 2; ++bj) { const v4u sc = *(const v4u*)(gp + bj * 128); f32x4 v0 = acc[ai][bj][m][0], v1 = acc[ai][bj][m][1];
                    v0[0] *= bflo(sc.x); v0[1] *= bfhi(sc.x); v0[2] *= bflo(sc.y); v0[3] *= bfhi(sc.y); v1[0] *= bflo(sc.z); v1[1] *= bfhi(sc.z); v1[2] *= bflo(sc.w); v1[3] *= bfhi(sc.w);
                    v4u w; w.x = cvt_pk_bf16(v0[0], v0[1]); w.y = cvt_pk_bf16(v0[2], v0[3]); w.z = cvt_pk_bf16(v1[0], v1[1]); w.w = cvt_pk_bf16(v1[2], v1[3]);
                    *(v4u*)(op + bj * 128) = w; }
                asm volatile("" ::: "memory"); }
    }
};
template <bool WB>
struct EpiResidT {
    static constexpr bool PERM = false, MIDK = false;
    const float* base; float* out; float sc;
    __device__ __forceinline__ void operator()(const f32x4 (&acc)[2][2][4][2], const Unit& u, int wr, int wc, int fr, int fq) const {
        const int row0 = u.pm * 256 + wr * 64 + fr, col0 = u.pn * 256 + wc * 32 + 4 * fq;
        bf16* xbp = nullptr; float* partp = nullptr;
        if constexpr (WB) {
            const __attribute__((address_space(4))) unsigned long long* ka = (const __attribute__((address_space(4))) unsigned long long*)__builtin_amdgcn_kernarg_segment_ptr();
            unsigned char* wsb = (unsigned char*)(GAS unsigned char*)ka[27]; xbp = (bf16*)(wsb + WS_XN); partp = (float*)(wsb + WS_Y); }
#pragma unroll
        for (int ai = 0; ai < 2; ++ai)
#pragma unroll
            for (int m = 0; m < 4; ++m) { const size_t off = (size_t)(row0 + ai * 128 + m * 16) * DM + col0; float ss = 0.f;
#pragma unroll
                for (int bj = 0; bj < 2; ++bj)
#pragma unroll
                    for (int n = 0; n < 2; ++n) { const f32x4 bs = *(const f32x4*)(base + off + bj * 128 + n * 16); const f32x4 r = WB ? (bs + acc[ai][bj][m][n]) : (bs + sc * acc[ai][bj][m][n]); *(f32x4*)(out + off + bj * 128 + n * 16) = r;
                        if constexpr (WB) { v2u w; w.x = pk2(r[0], r[1]); w.y = pk2(r[2], r[3]); *(v2u*)(xbp + off + bj * 128 + n * 16) = w; ss += (r[0] * r[0] + r[1] * r[1]) + (r[2] * r[2] + r[3] * r[3]); } }
                if constexpr (WB) { ss += __shfl_xor(ss, 16); ss += __shfl_xor(ss, 32); if (fq == 0) partp[(size_t)(row0 + ai * 128 + m * 16) * 32 + u.pn * 4 + wc] = ss; }
                asm volatile("" ::: "memory"); }
    }
};
typedef EpiResidT<false> EpiResid;
struct EpiFF1 {
    static constexpr bool PERM = true, MIDK = false;
    bf16* O; const float* rstd;
    __device__ __forceinline__ void operator()(const f32x4 (&acc)[2][2][4][2], const Unit& u, int wr, int wc, int fr, int fq) const {
        EPI_ROWCOL_PERM();
#pragma unroll
        for (int ai = 0; ai < 2; ++ai)
#pragma unroll
            for (int m = 0; m < 4; ++m) { bf16* rowp = O + (size_t)(row0 + ai * 128 + m * 16) * FF + u.pn * 256 + colt; const float rs = rstd[row0 + ai * 128 + m * 16];
#pragma unroll
                for (int bj = 0; bj < 2; ++bj) { f32x4 v0 = acc[ai][bj][m][0], v1 = acc[ai][bj][m][1];
#pragma unroll
                    for (int j = 0; j < 4; ++j) { const float a = fmaxf(v0[j], 0.f) * rs, b = fmaxf(v1[j], 0.f) * rs; v0[j] = a * a; v1[j] = b * b; }
                    v4u w; w.x = cvt_pk_bf16(v0[0], v0[1]); w.y = cvt_pk_bf16(v0[2], v0[3]); w.z = cvt_pk_bf16(v1[0], v1[1]); w.w = cvt_pk_bf16(v1[2], v1[3]);
                    __builtin_nontemporal_store(w, (v4u*)(rowp + bj * 128)); } }
    }
};
__device__ const unsigned char T5B[3][129] = {
 {0,1,2,3,4,5,6,7,8,9,10,11,12,13,14,15,16,16,16,16,16,16,17,17,17,17,17,17,17,17,18,18,18,18,18,18,18,18,18,18,19,19,19,19,19,19,19,19,19,19,19,19,19,19,20,20,20,20,20,20,20,20,20,20,20,20,20,20,20,20,20,20,20,21,21,21,21,21,21,21,21,21,21,21,21,21,21,21,21,21,21,21,21,21,21,21,21,21,21,22,22,22,22,22,22,22,22,22,22,22,22,22,22,22,22,22,22,22,22,22,22,22,22,22,22,22,22,22,22},
 {0,4,8,12,16,16,17,17,18,18,19,19,19,19,20,20,20,20,20,21,21,21,21,21,21,22,22,22,22,22,22,22,22,22,23,23,23,23,23,23,23,23,23,23,23,23,24,24,24,24,24,24,24,24,24,24,24,24,24,24,24,24,25,25,25,25,25,25,25,25,25,25,25,25,25,25,25,25,25,25,25,25,25,26,26,26,26,26,26,26,26,26,26,26,26,26,26,26,26,26,26,26,26,26,26,26,26,26,26,26,26,26,26,27,27,27,27,27,27,27,27,27,27,27,27,27,27,27,27},
 {0,16,18,19,20,21,21,22,22,23,23,23,24,24,24,24,25,25,25,25,25,26,26,26,26,26,26,26,26,27,27,27,27,27,27,27,27,27,27,28,28,28,28,28,28,28,28,28,28,28,28,28,29,29,29,29,29,29,29,29,29,29,29,29,29,29,29,29,29,29,30,30,30,30,30,30,30,30,30,30,30,30,30,30,30,30,30,30,30,30,30,30,30,30,30,31,31,31,31,31,31,31,31,31,31,31,31,31,31,31,31,31,31,31,31,31,31,31,31,31,31,31,31,31,31,31,31,31,31}};

__device__ __forceinline__ void tr_item(const float* W, int ldw, int k0, int c0, bf16* WT, int ldt, int r0, int kd0, LAS float* scr, int lane) {
#pragma unroll 8
    for (int i = 0; i < 32; ++i) { const int kk = 2 * i + (lane >> 5); scr[kk * 33 + (lane & 31)] = W[(size_t)(k0 + kk) * ldw + c0 + (lane & 31)]; }
    LDS_WAIT(); asm volatile("" ::: "memory");
    const int c = lane & 7;
#pragma unroll
    for (int j = 0; j < 4; ++j) { const int n = (lane >> 3) + 8 * j; const LAS float* s = scr + (8 * c) * 33 + n;
        v4u o; o.x = pk2(s[0 * 33], s[1 * 33]); o.y = pk2(s[2 * 33], s[3 * 33]); o.z = pk2(s[4 * 33], s[5 * 33]); o.w = pk2(s[6 * 33], s[7 * 33]);
        *(v4u*)(WT + (size_t)(r0 + n) * ldt + kd0 + k0 + 8 * c) = o; }
    LDS_WAIT(); asm volatile("" ::: "memory");
}
__device__ __forceinline__ void tr_item64(const float* W, int ldw, int k0, int c0, bf16* WT, int ldt, int r0, int kd0, int lane, const float* kg = nullptr) {
    const int kq = lane >> 4, nq = lane & 15;
    const float* src = W + (size_t)(k0 + 16 * kq) * ldw + c0 + 4 * nq;
    f32x4 v[16];
#pragma unroll
    for (int j = 0; j < 16; ++j) v[j] = *(const f32x4*)(src + (size_t)j * ldw);
    if (kg) {
#pragma unroll
        for (int j = 0; j < 16; ++j) v[j] *= kg[k0 + 16 * kq + j]; }
    bf16* dst = WT + (size_t)(r0 + 4 * nq) * ldt + kd0 + k0 + 16 * kq;
#pragma unroll
    for (int e = 0; e < 4; ++e) { v4u o0, o1;
        o0.x = pk2(v[0][e], v[1][e]); o0.y = pk2(v[2][e], v[3][e]); o0.z = pk2(v[4][e], v[5][e]); o0.w = pk2(v[6][e], v[7][e]);
        o1.x = pk2(v[8][e], v[9][e]); o1.y = pk2(v[10][e], v[11][e]); o1.z = pk2(v[12][e], v[13][e]); o1.w = pk2(v[14][e], v[15][e]);
        *(v4u*)(dst + (size_t)e * ldt) = o0; *(v4u*)(dst + (size_t)e * ldt + 8) = o1; }
}
__device__ __forceinline__ void wconv_phase(const float* w_in, const float* w_glu, const float* w_a, const float* w_b, const float* w_c, const float* w_out, const float* w_1, const float* w_2, const float* g2, unsigned char* ws, LAS unsigned char* lds, int gw, int NGW, int wave, int lane) {
    bf16* WIN = (bf16*)(ws + WS_WIN); bf16* WGLU = (bf16*)(ws + WS_WGLU); bf16* WBR = (bf16*)(ws + WS_WBR); bf16* WOUT = (bf16*)(ws + WS_WOUT); bf16* W1 = (bf16*)(ws + WS_W1); bf16* W2 = (bf16*)(ws + WS_W2);
    constexpr int I_IN = 32 * 320, I_GLU = 16 * 32, I_BR = 16 * 32, I_OUT = 32 * 32, I_1 = 32 * 128, I_2 = 128 * 32;
    constexpr int NITEMS = I_IN + I_GLU + 3 * I_BR + I_OUT + I_1 + I_2;
    for (int it = gw; it < NITEMS; it += NGW) {
        int r = it;
        if (r < I_IN) { const int kb = r / 320, nb = r % 320, n0 = 64 * nb; tr_item64(w_in, N_IN, 64 * kb, n0 < 4096 ? n0 : n0 + 8, WIN, DM, n0, 0, lane); continue; } r -= I_IN;
        if (r < I_GLU) { const int kb = r / 32, nb = r % 32, n0 = 64 * nb; const int pn = n0 >> 8, bj = (n0 >> 7) & 1, j = n0 & 127; tr_item64(w_glu, 2048, 64 * kb, bj * 1024 + pn * 128 + j, WGLU, 1024, n0, 0, lane); continue; } r -= I_GLU;
        if (r < 3 * I_BR) { const int br = r / I_BR, q = r % I_BR, kb = q / 32, nb = q % 32; if (br == 0) tr_item64(w_a, DM, 64 * kb, 64 * nb, WBR, 3072, 64 * nb, 0, lane); else if (br == 1) tr_item64(w_b, DM, 64 * kb, 64 * nb, WBR, 3072, 64 * nb, 1024, lane); else tr_item64(w_c, DM, 64 * kb, 64 * nb, WBR, 3072, 64 * nb, 2048, lane); continue; } r -= 3 * I_BR;
        if (r < I_OUT) { const int kb = r / 32, nb = r % 32; tr_item64(w_out, DM, 64 * kb, 64 * nb, WOUT, DM, 64 * nb, 0, lane); continue; } r -= I_OUT;
        if (r < I_1) { const int kb = r / 128, nb = r % 128; tr_item64(w_1, FF, 64 * kb, 64 * nb, W1, DM, 64 * nb, 0, lane, g2); continue; } r -= I_1;
        { const int kb = r / 32, nb = r % 32; tr_item64(w_2, DM, 64 * kb, 64 * nb, W2, FF, 64 * nb, 0, lane); }
    }
}

template <bool DO_IF>
__device__ __forceinline__ void norm_phase(const float* X, const float* gain, bf16* XN, const LAS float* IFW, const float* bi, const float* bfg, float* IFG, int gw, int NGW, int lane) {
    f32x4 gv[8];
#pragma unroll
    for (int j = 0; j < 8; ++j) gv[j] = *(const f32x4*)(gain + 4 * lane + 256 * j);
    for (int m4 = gw; m4 < M / 4; m4 += NGW)
    for (int r4 = 0; r4 < 4; ++r4) { const int m = 4 * m4 + r4;
        const f32x4* xr = (const f32x4*)(X + (size_t)m * DM) + lane;
        f32x4 v[8]; float ss = 0.f;
#pragma unroll
        for (int j = 0; j < 8; ++j) { v[j] = xr[64 * j]; ss += (v[j].x * v[j].x + v[j].y * v[j].y) + (v[j].z * v[j].z + v[j].w * v[j].w); }
        const float rstd = 1.0f / sqrtf(wave_sum(ss) * (1.0f / DM) + NORM_EPS);
        v2u* o8 = (v2u*)(XN + (size_t)m * DM) + lane;
#pragma unroll
        for (int j = 0; j < 8; ++j) { v[j] = (v[j] * rstd) * gv[j]; v2u w; w.x = pk2(v[j].x, v[j].y); w.y = pk2(v[j].z, v[j].w); o8[64 * j] = w; }
        if constexpr (DO_IF) {
            float p[8];
#pragma unroll
            for (int c = 0; c < 8; ++c) p[c] = 0.f;
#pragma unroll
            for (int j = 0; j < 8; ++j)
#pragma unroll
                for (int e = 0; e < 4; ++e) { const int d = 4 * lane + 256 * j + e; const f32x4 w0 = *(const LAS f32x4*)(IFW + d * 8), w1 = *(const LAS f32x4*)(IFW + d * 8 + 4); const float xv = v[j][e];
                    p[0] += xv * w0.x; p[1] += xv * w0.y; p[2] += xv * w0.z; p[3] += xv * w0.w; p[4] += xv * w1.x; p[5] += xv * w1.y; p[6] += xv * w1.z; p[7] += xv * w1.w;
                    if (e == 3) asm volatile("" ::: "memory"); }
#pragma unroll
            for (int c = 0; c < 8; ++c) p[c] = wave_sum(p[c]);
            if (lane < 8) {
                float val = p[0];
#pragma unroll
                for (int c = 1; c < 8; ++c) val = (lane == c) ? p[c] : val;
                if (lane < 4) val += bi[lane];
                else { const float xg = val + bfg[lane - 4]; val = fminf(xg, 0.f) - log1pf(expf(-fabsf(xg))); }
                IFG[(size_t)m * 8 + lane] = val;
            }
        }
    }
}

__device__ __forceinline__ void mconv_phase(const bf16* PROJ, const float* cw, const float* cb, bf16* QKC, int gtid, int NGT) {
    for (int job = gtid; job < 256 * (M / 64); job += NGT) {
        const int cg = job & 255, run = job >> 8, c0 = cg * 8, m0 = run * 64;
        float w[4][8], bb[8];
#pragma unroll
        for (int j = 0; j < 4; ++j) { const f32x4 a = *(const f32x4*)(cw + j * 2048 + c0), b = *(const f32x4*)(cw + j * 2048 + c0 + 4); w[j][0] = a.x; w[j][1] = a.y; w[j][2] = a.z; w[j][3] = a.w; w[j][4] = b.x; w[j][5] = b.y; w[j][6] = b.z; w[j][7] = b.w; }
        { const f32x4 a = *(const f32x4*)(cb + c0), b = *(const f32x4*)(cb + c0 + 4); bb[0] = a.x; bb[1] = a.y; bb[2] = a.z; bb[3] = a.w; bb[4] = b.x; bb[5] = b.y; bb[6] = b.z; bb[7] = b.w; }
        const float osc = (c0 >= 1024) ? 0.0625f : 1.0f;
        float h0[8], h1[8], h2[8];
        const bool first = (m0 % SEQ) == 0;
#pragma unroll
        for (int e = 0; e < 8; ++e) { h0[e] = 0.f; h1[e] = 0.f; h2[e] = 0.f; }
        if (!first) {
            const v4u a = *(const v4u*)(PROJ + (size_t)(m0 - 3) * NPROJ + c0), b = *(const v4u*)(PROJ + (size_t)(m0 - 2) * NPROJ + c0), c = *(const v4u*)(PROJ + (size_t)(m0 - 1) * NPROJ + c0);
            h0[0] = bflo(a.x); h0[1] = bfhi(a.x); h0[2] = bflo(a.y); h0[3] = bfhi(a.y); h0[4] = bflo(a.z); h0[5] = bfhi(a.z); h0[6] = bflo(a.w); h0[7] = bfhi(a.w);
            h1[0] = bflo(b.x); h1[1] = bfhi(b.x); h1[2] = bflo(b.y); h1[3] = bfhi(b.y); h1[4] = bflo(b.z); h1[5] = bfhi(b.z); h1[6] = bflo(b.w); h1[7] = bfhi(b.w);
            h2[0] = bflo(c.x); h2[1] = bfhi(c.x); h2[2] = bflo(c.y); h2[3] = bfhi(c.y); h2[4] = bflo(c.z); h2[5] = bfhi(c.z); h2[6] = bflo(c.w); h2[7] = bfhi(c.w);
        }
#pragma unroll 4
        for (int r = 0; r < 64; ++r) {
            const v4u a = *(const v4u*)(PROJ + (size_t)(m0 + r) * NPROJ + c0);
            float x[8]; x[0] = bflo(a.x); x[1] = bfhi(a.x); x[2] = bflo(a.y); x[3] = bfhi(a.y); x[4] = bflo(a.z); x[5] = bfhi(a.z); x[6] = bflo(a.w); x[7] = bfhi(a.w);
            float y[8];
#pragma unroll
            for (int e = 0; e < 8; ++e) { const float s = bb[e] + w[0][e] * h0[e] + w[1][e] * h1[e] + w[2][e] * h2[e] + w[3][e] * x[e]; y[e] = s * sigmoid_f(s) * osc; h0[e] = h1[e]; h1[e] = h2[e]; h2[e] = x[e]; }
            v4u o; o.x = pk2(y[0], y[1]); o.y = pk2(y[2], y[3]); o.z = pk2(y[4], y[5]); o.w = pk2(y[6], y[7]);
            *(v4u*)(QKC + (size_t)(m0 + r) * 2048 + c0) = o;
        }
    }
}

__device__ __forceinline__ void mlstm_rec_phase(const bf16* QKC, const bf16* PROJ, const float* IFG, float* HM, int unit0, int ustride, int wave, int lane) {
    for (int unit = unit0; unit < 256; unit += ustride) {
        const int b = unit >> 7, h = (unit >> 5) & 3, e = (unit & 31) * 8 + wave;
        float C[4] = {0.f, 0.f, 0.f, 0.f}, nn[4] = {0.f, 0.f, 0.f, 0.f};
        const size_t mb = (size_t)b * SEQ;
        const bf16* qp = QKC + mb * 2048 + h * 256 + 4 * lane;
        const bf16* kp = qp + 1024;
        const bf16* vp = PROJ + mb * NPROJ + PV + h * 256 + e;
        const float* gp = IFG + mb * 8 + h;
        float* hp = HM + mb * 1024 + h * 256 + e;
        v2u qv[4], kv[4]; bf16 vv[4]; float ig[4], lf[4];
#pragma unroll
        for (int j = 0; j < 4; ++j) { qv[j] = *(const v2u*)(qp + (size_t)j * 2048); kv[j] = *(const v2u*)(kp + (size_t)j * 2048); vv[j] = vp[(size_t)j * NPROJ]; ig[j] = gp[j * 8]; lf[j] = gp[j * 8 + 4]; }
        for (int t0 = 0; t0 < SEQ; t0 += 4) {
            v2u qn[4], kn[4]; bf16 vn[4]; float ign[4], lfn[4];
            const int t1 = (t0 + 4 < SEQ) ? t0 + 4 : t0;
#pragma unroll
            for (int j = 0; j < 4; ++j) { qn[j] = *(const v2u*)(qp + (size_t)(t1 + j) * 2048); kn[j] = *(const v2u*)(kp + (size_t)(t1 + j) * 2048); vn[j] = vp[(size_t)(t1 + j) * NPROJ]; ign[j] = gp[(t1 + j) * 8]; lfn[j] = gp[(t1 + j) * 8 + 4]; }
            float pn[4], pd[4];
#pragma unroll
            for (int j = 0; j < 4; ++j) {
                const float fi = __expf(lf[j]), ii = __expf(ig[j]), iv = ii * bf1(vv[j]);
                const float q0 = bflo(qv[j].x), q1 = bfhi(qv[j].x), q2 = bflo(qv[j].y), q3 = bfhi(qv[j].y);
                const float k0 = bflo(kv[j].x), k1 = bfhi(kv[j].x), k2 = bflo(kv[j].y), k3 = bfhi(kv[j].y);
                C[0] = fi * C[0] + iv * k0; C[1] = fi * C[1] + iv * k1; C[2] = fi * C[2] + iv * k2; C[3] = fi * C[3] + iv * k3;
                nn[0] = fi * nn[0] + ii * k0; nn[1] = fi * nn[1] + ii * k1; nn[2] = fi * nn[2] + ii * k2; nn[3] = fi * nn[3] + ii * k3;
                pn[j] = (C[0] * q0 + C[1] * q1) + (C[2] * q2 + C[3] * q3);
                pd[j] = (nn[0] * q0 + nn[1] * q1) + (nn[2] * q2 + nn[3] * q3);
            }
#pragma unroll
            for (int j = 0; j < 4; ++j) { pn[j] = wave_sum(pn[j]); pd[j] = wave_sum(pd[j]); }
            if (lane == 0) {
#pragma unroll
                for (int j = 0; j < 4; ++j) hp[(size_t)(t0 + j) * 1024] = pn[j] / fmaxf(fabsf(pd[j]), 1.0f);
            }
#pragma unroll
            for (int j = 0; j < 4; ++j) { qv[j] = qn[j]; kv[j] = kn[j]; vv[j] = vn[j]; ig[j] = ign[j]; lf[j] = lfn[j]; }
        }
    }
}

__device__ __forceinline__ void mnorm_phase(const float* HM, const bf16* PROJ, const float* mg, bf16* Y, int gw, int NGW, int lane) {
    f32x4 gv[4];
#pragma unroll
    for (int j = 0; j < 4; ++j) gv[j] = *(const f32x4*)(mg + 16 * lane + 4 * j);
    for (int m = gw; m < M; m += NGW) {
        f32x4 v[4]; float ss = 0.f;
#pragma unroll
        for (int j = 0; j < 4; ++j) { v[j] = *(const f32x4*)(HM + (size_t)m * 1024 + 16 * lane + 4 * j); ss += (v[j].x * v[j].x + v[j].y * v[j].y) + (v[j].z * v[j].z + v[j].w * v[j].w); }
        ss += __shfl_xor(ss, 1); ss += __shfl_xor(ss, 2); ss += __shfl_xor(ss, 4); ss += __shfl_xor(ss, 8);
        const float r = 1.0f / sqrtf(ss * (1.0f / 256.0f) + NORM_EPS);
        const v4u o0 = *(const v4u*)(PROJ + (size_t)m * NPROJ + PO + 16 * lane), o1 = *(const v4u*)(PROJ + (size_t)m * NPROJ + PO + 16 * lane + 8);
        const float og[16] = {bflo(o0.x), bfhi(o0.x), bflo(o0.y), bfhi(o0.y), bflo(o0.z), bfhi(o0.z), bflo(o0.w), bfhi(o0.w), bflo(o1.x), bfhi(o1.x), bflo(o1.y), bfhi(o1.y), bflo(o1.z), bfhi(o1.z), bflo(o1.w), bfhi(o1.w)};
        float y[16];
#pragma unroll
        for (int j = 0; j < 4; ++j)
#pragma unroll
            for (int e = 0; e < 4; ++e) y[4 * j + e] = ABL_SA * og[4 * j + e] * ((v[j][e] * r) * gv[j][e]);
        v4u w0, w1; w0.x = pk2(y[0], y[1]); w0.y = pk2(y[2], y[3]); w0.z = pk2(y[4], y[5]); w0.w = pk2(y[6], y[7]); w1.x = pk2(y[8], y[9]); w1.y = pk2(y[10], y[11]); w1.z = pk2(y[12], y[13]); w1.w = pk2(y[14], y[15]);
        *(v4u*)(Y + (size_t)m * 3072 + 16 * lane) = w0; *(v4u*)(Y + (size_t)m * 3072 + 16 * lane + 8) = w1;
    }
}

__device__ __forceinline__ void attn_fill_bias(const float* rel_bias, LAS float* BT, int tid) {
    for (int i = tid; i < 3 * 129 * 8; i += NTHR) { const int hs = i & 7, n = (i >> 3) % 129, g = (i >> 3) / 129; BT[i] = rel_bias[T5B[g][n] * 24 + g * 8 + hs]; }
}
__device__ __forceinline__ void attn_simple_phase(const bf16* PROJ, const LAS float* BT, bf16* Y, int gw, int NGW, int lane) {
    const int quad = lane >> 2, sub = lane & 3;
    for (int job = gw; job < (M / 16) * 8; job += NGW) {
        const int hs = job & 7, m = (job >> 3) * 16 + quad, b = m / SEQ, t = m % SEQ;
        float mx = -1e30f, l = 0.f, acc[32];
#pragma unroll
        for (int i = 0; i < 32; ++i) acc[i] = 0.f;
        for (int g = 0; g < 3; ++g) {
            const int r = (g == 0) ? 1 : (g == 1 ? 4 : 16), hh = g * 8 + hs;
            float q[32];
            { const v4u* qr = (const v4u*)(PROJ + (size_t)m * NPROJ + PAQ + hh * 128 + sub * 32);
#pragma unroll
              for (int i = 0; i < 4; ++i) { const v4u a = qr[i]; q[8 * i + 0] = bflo(a.x); q[8 * i + 1] = bfhi(a.x); q[8 * i + 2] = bflo(a.y); q[8 * i + 3] = bfhi(a.y); q[8 * i + 4] = bflo(a.z); q[8 * i + 5] = bfhi(a.z); q[8 * i + 6] = bflo(a.w); q[8 * i + 7] = bfhi(a.w); }
#pragma unroll
              for (int i = 0; i < 32; ++i) q[i] *= 0.08838834764831845f; }
            const bf16* kb = PROJ + (size_t)b * SEQ * NPROJ + PAK + hh * 128 + sub * 32;
            const bf16* vb = PROJ + (size_t)b * SEQ * NPROJ + PAV + hh * 128 + sub * 32;
            const LAS float* bt = BT + g * 129 * 8 + hs;
            for (int n = 0; n <= 128; ++n) {
                const int tk = t - n * r;
                if (tk >= 0) {
                    const v4u* kr = (const v4u*)(kb + (size_t)tk * NPROJ);
                    float dot = 0.f;
#pragma unroll
                    for (int i = 0; i < 4; ++i) { const v4u a = kr[i];
                        dot += q[8 * i + 0] * bflo(a.x) + q[8 * i + 1] * bfhi(a.x) + q[8 * i + 2] * bflo(a.y) + q[8 * i + 3] * bfhi(a.y) + q[8 * i + 4] * bflo(a.z) + q[8 * i + 5] * bfhi(a.z) + q[8 * i + 6] * bflo(a.w) + q[8 * i + 7] * bfhi(a.w); }
                    dot += __shfl_xor(dot, 1); dot += __shfl_xor(dot, 2);
                    const float s = dot + bt[n * 8];
                    const float mn = fmaxf(mx, s), corr = __expf(mx - mn), p = __expf(s - mn);
                    l = l * corr + p; mx = mn;
                    const v4u* vr = (const v4u*)(vb + (size_t)tk * NPROJ);
#pragma unroll
                    for (int i = 0; i < 4; ++i) { const v4u a = vr[i];
                        acc[8 * i + 0] = acc[8 * i + 0] * corr + p * bflo(a.x); acc[8 * i + 1] = acc[8 * i + 1] * corr + p * bfhi(a.x); acc[8 * i + 2] = acc[8 * i + 2] * corr + p * bflo(a.y); acc[8 * i + 3] = acc[8 * i + 3] * corr + p * bfhi(a.y);
                        acc[8 * i + 4] = acc[8 * i + 4] * corr + p * bflo(a.z); acc[8 * i + 5] = acc[8 * i + 5] * corr + p * bfhi(a.z); acc[8 * i + 6] = acc[8 * i + 6] * corr + p * bflo(a.w); acc[8 * i + 7] = acc[8 * i + 7] * corr + p * bfhi(a.w); }
                }
            }
        }
        const float inv = ABL_SB / l;
        v4u* op = (v4u*)(Y + (size_t)m * 3072 + 1024 + hs * 128 + sub * 32);
#pragma unroll
        for (int i = 0; i < 4; ++i) { v4u w; w.x = pk2(acc[8 * i + 0] * inv, acc[8 * i + 1] * inv); w.y = pk2(acc[8 * i + 2] * inv, acc[8 * i + 3] * inv); w.z = pk2(acc[8 * i + 4] * inv, acc[8 * i + 5] * inv); w.w = pk2(acc[8 * i + 6] * inv, acc[8 * i + 7] * inv); op[i] = w; }
    }
}

struct S5P { const float *lam_re, *lam_im, *log_dt, *b_re, *b_im, *c_re, *c_im, *d_skip; };
#define S5P_MAKE(sp, l) S5P sp; sp.lam_re = ARG(9) + (size_t)(l) * 4096; sp.lam_im = ARG(10) + (size_t)(l) * 4096; sp.log_dt = ARG(11) + (size_t)(l) * 64; \
    sp.b_re = ARG(12) + (size_t)(l) * 65536; sp.b_im = ARG(13) + (size_t)(l) * 65536; sp.c_re = ARG(14) + (size_t)(l) * 65536; sp.c_im = ARG(15) + (size_t)(l) * 65536; sp.d_skip = ARG(16) + (size_t)(l) * 1024
__device__ __forceinline__ void s5_disc(const S5P& P, int g, int p, float& are, float& aim, float& fre, float& fim) {
    const float dt = expf(P.log_dt[g]), lr = P.lam_re[g * 64 + p], li = P.lam_im[g * 64 + p];
    const float mag = expf(lr * dt), ang = li * dt;
    are = mag * cosf(ang); aim = mag * sinf(ang);
    const float nr = are - 1.0f, ni = aim, den = lr * lr + li * li;
    fre = (nr * lr + ni * li) / den; fim = (ni * lr - nr * li) / den;
}
template <bool OUT>
__device__ __forceinline__ void s5_scan_phase(const S5P& P, const bf16* PROJ, float* LOC, const float* CAR, bf16* Z, LAS float* xs  , int gw, int NGW, int lane) {
    for (int job = gw; job < 2 * 64 * 16; job += NGW) {
        const int c = job & 15, g = (job >> 4) & 63, b = job >> 10, p = lane;
        float are, aim, fre, fim; s5_disc(P, g, p, are, aim, fre, fim);
        float Br[16], Bi[16];
#pragma unroll
        for (int i = 0; i < 16; ++i) { const float br = P.b_re[(g * 64 + p) * 16 + i], bi = P.b_im[(g * 64 + p) * 16 + i]; Br[i] = fre * br - fim * bi; Bi[i] = fre * bi + fim * br; }
        float xr = 0.f, xi = 0.f;
        const size_t sidx = ((size_t)((b * 64 + g) * 16 + c) * 64 + p) * 2;
        float Cr[16], Ci[16], dsk = 0.f; const int o = lane & 15, qd = lane >> 4;
        if (OUT) { xr = CAR[sidx]; xi = CAR[sidx + 1];
#pragma unroll
            for (int j = 0; j < 16; ++j) { Cr[j] = P.c_re[(g * 16 + o) * 64 + qd * 16 + j]; Ci[j] = P.c_im[(g * 16 + o) * 64 + qd * 16 + j]; }
            dsk = P.d_skip[g * 16 + o]; }
        const bf16* up = PROJ + ((size_t)b * SEQ + c * 1024) * NPROJ + PU + g * 16;
        for (int t = 0; t < 1024; ++t) {
            const v4u u0 = *(const v4u*)(up + (size_t)t * NPROJ), u1 = *(const v4u*)(up + (size_t)t * NPROJ + 8);
            const float u[16] = {bflo(u0.x), bfhi(u0.x), bflo(u0.y), bfhi(u0.y), bflo(u0.z), bfhi(u0.z), bflo(u0.w), bfhi(u0.w), bflo(u1.x), bfhi(u1.x), bflo(u1.y), bfhi(u1.y), bflo(u1.z), bfhi(u1.z), bflo(u1.w), bfhi(u1.w)};
            float br = 0.f, bi = 0.f;
#pragma unroll
            for (int i = 0; i < 16; ++i) { br += Br[i] * u[i]; bi += Bi[i] * u[i]; }
            const float nr = are * xr - aim * xi + br, ni = are * xi + aim * xr + bi; xr = nr; xi = ni;
            if (OUT) {
                xs[p] = xr; xs[64 + p] = xi; LDS_WAIT();
                float s = 0.f;
#pragma unroll
                for (int j = 0; j < 16; ++j) s += Cr[j] * xs[qd * 16 + j] - Ci[j] * xs[64 + qd * 16 + j];
                LDS_WAIT();
                s += __shfl_xor(s, 16); s += __shfl_xor(s, 32);
                float uo = u[0];
#pragma unroll
                for (int j = 1; j < 16; ++j) uo = (o == j) ? u[j] : uo;
                const float y = s + dsk * uo;
                const float z = ABL_SC * 0.5f * y * (1.0f + tanhf(0.7978845608028654f * (y + 0.044715f * y * y * y)));
                if (qd == 0) Z[((size_t)b * SEQ + c * 1024 + t) * 1024 + g * 16 + o] = (bf16)f2bf(z);
            }
        }
        if (!OUT) { LOC[sidx] = xr; LOC[sidx + 1] = xi; }
    }
}
__device__ __forceinline__ void s5_carry_phase(const f32x4* DISC, const float* LOC, float* CAR, int gtid, int NGT) {
    for (int i = gtid; i < 2 * 64 * 64; i += NGT) {
        const int p = i & 63, g = (i >> 6) & 63, b = i >> 12;
        const f32x4 dq = DISC[g * 64 + p];
        float pr = dq[0], pi = dq[1];
#pragma unroll 1
        for (int k = 0; k < 10; ++k) { const float nr = pr * pr - pi * pi, ni = 2.0f * pr * pi; pr = nr; pi = ni; }
        float cr = 0.f, ci = 0.f; asm volatile("" : "+v"(cr), "+v"(ci));
        for (int c = 0; c < 16; ++c) {
            const size_t sidx = ((size_t)((b * 64 + g) * 16 + c) * 64 + p) * 2;
            CAR[sidx] = cr; CAR[sidx + 1] = ci;
            const float lr = LOC[sidx], li = LOC[sidx + 1];
            const float nr = pr * cr - pi * ci + lr, ni = pr * ci + pi * cr + li; cr = nr; ci = ni;
        }
    }
}
constexpr int AT_PITCH = 288, AT_KOFF = 0, AT_VOFF = 256 * AT_PITCH, AT_BTOFF = 2 * 256 * AT_PITCH;
typedef short s16x4 __attribute__((ext_vector_type(4)));
typedef short s16x8 __attribute__((ext_vector_type(8)));
__device__ __forceinline__ s16x4 tr_read4(LAS unsigned char* p) { return __builtin_bit_cast(s16x4, __builtin_amdgcn_ds_read_tr16_b64_v4i16((LAS s16x4*)p)); }
struct AtUnit { int b, hh, grp, r, c, qb; };
__device__ __forceinline__ AtUnit at_unit(int u) { AtUnit a; const int blk = u & 127; a.hh = (u >> 7) % 24; a.b = u / (128 * 24); a.grp = a.hh >> 3; a.r = a.grp == 0 ? 1 : (a.grp == 1 ? 4 : 16);
    const int nbq = 128 / a.r; a.c = blk / nbq; a.qb = blk % nbq; return a; }
__device__ __forceinline__ void at_issue_loads(const bf16* PROJ, const AtUnit& a, int tid, v4u (&kreg)[8], v4u (&vreg)[8]) {
#pragma unroll
    for (int it = 0; it < 8; ++it) { const int chunk = it * NTHR + tid, row = chunk >> 4, c16 = chunk & 15; int jk = a.qb * 128 - 128 + row; jk = jk < 0 ? 0 : jk;
        const bf16* src = PROJ + ((size_t)a.b * SEQ + a.c + (size_t)a.r * jk) * NPROJ + PAK + a.hh * 128 + c16 * 8;
        kreg[it] = *(const v4u*)src; vreg[it] = *(const v4u*)(src + (PAV - PAK)); }
}
__device__ __forceinline__ void attn_mfma_phase(const bf16* PROJ, const float* rel_bias, bf16* ATT, float* LSE, LAS unsigned char* lds, int bx, int G, int tid) {
    const int lane = tid & 63, w = __builtin_amdgcn_readfirstlane(tid >> 6), ql = lane & 15, g4 = lane >> 4;
    constexpr int NU = 2 * 24 * 128;
    constexpr float SC = 0.08838834764831845f * 1.4426950408889634f;
    v4u kreg[8], vreg[8];
    float btv = -1e30f;
    if (bx < NU) { const AtUnit a0 = at_unit(bx); at_issue_loads(PROJ, a0, tid, kreg, vreg);
        if (tid < 159) { const int n = 143 - tid; btv = (n >= 0 && n <= 128) ? rel_bias[T5B[a0.grp][n] * 24 + a0.hh] * 1.4426950408889634f : -1e30f; } }
    for (int u = bx; u < NU; u += G) {
        const AtUnit a = at_unit(u);
#pragma unroll
        for (int it = 0; it < 8; ++it) { const int chunk = it * NTHR + tid, row = chunk >> 4, c16 = chunk & 15;
            *(LAS v4u*)(lds + AT_KOFF + row * AT_PITCH + c16 * 16) = kreg[it]; *(LAS v4u*)(lds + AT_VOFF + row * AT_PITCH + c16 * 16) = vreg[it]; }
        if (tid < 159) ((LAS float*)(lds + AT_BTOFF))[tid] = btv;
        __syncthreads();
        if (u + G < NU) { const AtUnit an = at_unit(u + G); at_issue_loads(PROJ, an, tid, kreg, vreg);
            if (tid < 159) { const int n = 143 - tid; btv = (n >= 0 && n <= 128) ? rel_bias[T5B[an.grp][n] * 24 + an.hh] * 1.4426950408889634f : -1e30f; } }
        const int jq = a.qb * 128 + 16 * w + ql; const size_t mq = (size_t)a.b * SEQ + a.c + (size_t)a.r * jq;
        s16x8 qf[4];
#pragma unroll
        for (int ks = 0; ks < 4; ++ks) qf[ks] = *(const s16x8*)(PROJ + mq * NPROJ + PAQ + a.hh * 128 + 32 * ks + 8 * g4);
        f32x4 s[9];
#pragma unroll
        for (int kt = 0; kt < 9; ++kt) { f32x4 acc = {0.f, 0.f, 0.f, 0.f};
#pragma unroll
            for (int ks = 0; ks < 4; ++ks) { const s16x8 kf = *(const LAS s16x8*)(lds + AT_KOFF + (16 * (w + kt) + ql) * AT_PITCH + (32 * ks + 8 * g4) * 2);
                acc = __builtin_amdgcn_mfma_f32_16x16x32_bf16(kf, qf[ks], acc, 0, 0, 0); }
            s[kt] = acc; }
        const LAS float* bt = (const LAS float*)(lds + AT_BTOFF) + (15 - ql + 4 * g4);
        float mx = -1e30f;
#pragma unroll
        for (int kt = 0; kt < 9; ++kt)
#pragma unroll
            for (int i = 0; i < 4; ++i) { float v = s[kt][i] * SC + bt[16 * kt + i];
                if (a.qb == 0) { if (16 * (w + kt) + 4 * g4 + i < 128) v = -1e30f; }
                s[kt][i] = v; mx = fmaxf(mx, v); }
        mx = fmaxf(mx, __shfl_xor(mx, 16)); mx = fmaxf(mx, __shfl_xor(mx, 32));
        float sum = 0.f;
#pragma unroll
        for (int kt = 0; kt < 9; ++kt)
#pragma unroll
            for (int i = 0; i < 4; ++i) { const float p = __builtin_amdgcn_exp2f(s[kt][i] - mx); s[kt][i] = p; sum += p; }
        sum += __shfl_xor(sum, 16); sum += __shfl_xor(sum, 32);
        f32x4 o[8];
#pragma unroll
        for (int dt = 0; dt < 8; ++dt) o[dt] = (f32x4){0.f, 0.f, 0.f, 0.f};
        LAS unsigned char* vb = lds + AT_VOFF + (16 * w + 4 * g4 + (ql >> 2)) * AT_PITCH + (ql & 3) * 8;
#pragma unroll
        for (int p = 0; p < 5; ++p) {
            v4u pk; pk.x = cvt_pk_bf16(s[2 * p][0], s[2 * p][1]); pk.y = cvt_pk_bf16(s[2 * p][2], s[2 * p][3]);
            if (p < 4) { pk.z = cvt_pk_bf16(s[2 * p + 1][0], s[2 * p + 1][1]); pk.w = cvt_pk_bf16(s[2 * p + 1][2], s[2 * p + 1][3]); } else { pk.z = 0u; pk.w = 0u; }
            const s16x8 pf = __builtin_bit_cast(s16x8, pk);
#pragma unroll
            for (int dt = 0; dt < 8; ++dt) {
                const s16x4 lo = tr_read4(vb + p * 32 * AT_PITCH + dt * 32);
                s16x4 hi = {0, 0, 0, 0}; if (p < 4) hi = tr_read4(vb + p * 32 * AT_PITCH + 16 * AT_PITCH + dt * 32);
                const s16x8 vf = {lo[0], lo[1], lo[2], lo[3], hi[0], hi[1], hi[2], hi[3]};
                o[dt] = __builtin_amdgcn_mfma_f32_16x16x32_bf16(vf, pf, o[dt], 0, 0, 0); }
        }
        const float inv = 1.0f / sum;
        bf16* op = ATT + ((size_t)a.grp * M + mq) * 1024 + (a.hh & 7) * 128 + 4 * g4;
#pragma unroll
        for (int dt = 0; dt < 8; ++dt) { v2u wv; wv.x = cvt_pk_bf16(o[dt][0] * inv, o[dt][1] * inv); wv.y = cvt_pk_bf16(o[dt][2] * inv, o[dt][3] * inv); *(v2u*)(op + dt * 16) = wv; }
        if (g4 == 0) LSE[(size_t)a.grp * (2 * 8 * SEQ) + ((size_t)(a.b * 8 + (a.hh & 7)) * a.r + a.c) * (SEQ / a.r) + jq] = mx + __builtin_amdgcn_logf(sum);
        __syncthreads();
    }
}
__device__ __forceinline__ void attn_merge_phase(const bf16* ATT, const float* LSE, bf16* Yb  , int gw, int NGW, int lane) {
    for (int m0 = 2 * gw; m0 < M; m0 += 2 * NGW) {
        const int hs = lane >> 3;
        float w[2][3]; v4u a[2][2], bq[2][2], c[2][2];
#pragma unroll
        for (int r = 0; r < 2; ++r) { const int m = m0 + r, b = m / SEQ, t = m % SEQ;
            const float* lb = LSE + (size_t)(b * 8 + hs) * SEQ;
            w[r][0] = lb[t]; w[r][1] = lb[(size_t)(2 * 8 * SEQ) + (t & 3) * (SEQ / 4) + (t >> 2)]; w[r][2] = lb[(size_t)2 * (2 * 8 * SEQ) + (t & 15) * (SEQ / 16) + (t >> 4)];
#pragma unroll
            for (int hlf = 0; hlf < 2; ++hlf) { a[r][hlf] = *(const v4u*)(ATT + (size_t)m * 1024 + 16 * lane + 8 * hlf); bq[r][hlf] = *(const v4u*)(ATT + ((size_t)M + m) * 1024 + 16 * lane + 8 * hlf); c[r][hlf] = *(const v4u*)(ATT + ((size_t)2 * M + m) * 1024 + 16 * lane + 8 * hlf); } }
#pragma unroll
        for (int r = 0; r < 2; ++r) { const int m = m0 + r;
            const float l0 = w[r][0], l1 = w[r][1], l2 = w[r][2];
            const float mx = fmaxf(l0, fmaxf(l1, l2));
            float w0 = __builtin_amdgcn_exp2f(l0 - mx), w1 = __builtin_amdgcn_exp2f(l1 - mx), w2 = __builtin_amdgcn_exp2f(l2 - mx);
            const float inv = 1.0f / (w0 + w1 + w2); w0 *= inv; w1 *= inv; w2 *= inv;
            float y[16];
#pragma unroll
            for (int hlf = 0; hlf < 2; ++hlf) { const v4u A = a[r][hlf], B = bq[r][hlf], C = c[r][hlf];
                y[8 * hlf + 0] = w0 * bflo(A.x) + w1 * bflo(B.x) + w2 * bflo(C.x); y[8 * hlf + 1] = w0 * bfhi(A.x) + w1 * bfhi(B.x) + w2 * bfhi(C.x);
                y[8 * hlf + 2] = w0 * bflo(A.y) + w1 * bflo(B.y) + w2 * bflo(C.y); y[8 * hlf + 3] = w0 * bfhi(A.y) + w1 * bfhi(B.y) + w2 * bfhi(C.y);
                y[8 * hlf + 4] = w0 * bflo(A.z) + w1 * bflo(B.z) + w2 * bflo(C.z); y[8 * hlf + 5] = w0 * bfhi(A.z) + w1 * bfhi(B.z) + w2 * bfhi(C.z);
                y[8 * hlf + 6] = w0 * bflo(A.w) + w1 * bflo(B.w) + w2 * bflo(C.w); y[8 * hlf + 7] = w0 * bfhi(A.w) + w1 * bfhi(B.w) + w2 * bfhi(C.w); }
            v4u o0, o1; o0.x = pk2(y[0], y[1]); o0.y = pk2(y[2], y[3]); o0.z = pk2(y[4], y[5]); o0.w = pk2(y[6], y[7]); o1.x = pk2(y[8], y[9]); o1.y = pk2(y[10], y[11]); o1.z = pk2(y[12], y[13]); o1.w = pk2(y[14], y[15]);
            *(v4u*)(Yb + (size_t)m * 3072 + 16 * lane) = o0; *(v4u*)(Yb + (size_t)m * 3072 + 16 * lane + 8) = o1; }
    }
}
constexpr int ML_PITCH = 544, ML_KOFF = 0, ML_VOFF = 128 * ML_PITCH, ML_GOFF = 2 * 128 * ML_PITCH;
constexpr int ML_ROWS = 257, ML_USZ = ML_ROWS * 256;
__device__ __forceinline__ void ml_gates(const float* IFG, size_t m0, int h, LAS float* gv, int tid) {
    if (tid < 64) {
        const int l = tid; const float x0 = IFG[(m0 + 2 * l) * 8 + 4 + h], x1 = IFG[(m0 + 2 * l + 1) * 8 + 4 + h], i0 = IFG[(m0 + 2 * l) * 8 + h], i1 = IFG[(m0 + 2 * l + 1) * 8 + h];
        float inc = x0 + x1;
#pragma unroll
        for (int d = 1; d < 64; d <<= 1) { const float t = __shfl_up(inc, d); if (l >= d) inc += t; }
        const float b1 = inc, b0 = inc - x1, bL = __shfl(inc, 63);
        gv[2 * l] = b0; gv[2 * l + 1] = b1; gv[128 + 2 * l] = i0 - b0; gv[128 + 2 * l + 1] = i1 - b1;
        gv[256 + 2 * l] = __expf(bL - b0 + i0); gv[256 + 2 * l + 1] = __expf(bL - b1 + i1);
    }
}
template <bool SCALE>
__device__ __forceinline__ void ml_stage(const bf16* QKC, const bf16* PROJ, size_t m0, int h, LAS unsigned char* lds, int tid) {
    const LAS float* Wv = (const LAS float*)(lds + ML_GOFF) + 256;
#pragma unroll
    for (int it = 0; it < 8; ++it) { const int chunk = it * NTHR + tid, row = chunk >> 5, c16 = chunk & 31;
        const v4u kv = *(const v4u*)(QKC + (m0 + row) * 2048 + 1024 + h * 256 + c16 * 8); v4u vv = *(const v4u*)(PROJ + (m0 + row) * NPROJ + PV + h * 256 + c16 * 8);
        if (SCALE) { const float w = Wv[row]; vv.x = pk2(bflo(vv.x) * w, bfhi(vv.x) * w); vv.y = pk2(bflo(vv.y) * w, bfhi(vv.y) * w); vv.z = pk2(bflo(vv.z) * w, bfhi(vv.z) * w); vv.w = pk2(bflo(vv.w) * w, bfhi(vv.w) * w); }
        *(LAS v4u*)(lds + ML_KOFF + row * ML_PITCH + c16 * 16) = kv; *(LAS v4u*)(lds + ML_VOFF + row * ML_PITCH + c16 * 16) = vv; }
    if (tid < 256) { const int row = tid >> 1, hf = tid & 1; v4u z = {0u, 0u, 0u, 0u}; if (hf == 0) z.x = SCALE ? f2bf(Wv[row]) : 0x3f80u; *(LAS v4u*)(lds + ML_VOFF + row * ML_PITCH + 512 + hf * 16) = z; }
}
__device__ __forceinline__ void mlstm_a1_phase(const bf16* QKC, const bf16* PROJ, const float* IFG, bf16* CST, float* MF, LAS unsigned char* lds, int bx, int G, int tid) {
    const int lane = tid & 63, w = __builtin_amdgcn_readfirstlane(tid >> 6), li = lane & 15, g4 = lane >> 4;
    for (int u = bx; u < 1024; u += G) {
        const int c = u & 127, h = (u >> 7) & 3, b = u >> 9; const size_t m0 = (size_t)b * SEQ + c * 128;
        LAS float* gv = (LAS float*)(lds + ML_GOFF);
        ml_gates(IFG, m0, h, gv, tid);
        __syncthreads();
        if (tid == 0) MF[u * 32] = __expf(gv[127]);
        ml_stage<true>(QKC, PROJ, m0, h, lds, tid);
        __syncthreads();
        s16x8 kf[2][4];
        LAS unsigned char* kb = lds + ML_KOFF + (8 * g4 + (li >> 2)) * ML_PITCH + (li & 3) * 8;
        LAS unsigned char* vb = lds + ML_VOFF + (8 * g4 + (li >> 2)) * ML_PITCH + (li & 3) * 8;
#pragma unroll
        for (int dt = 0; dt < 2; ++dt)
#pragma unroll
            for (int ks = 0; ks < 4; ++ks) { const s16x4 lo = tr_read4(kb + ks * 32 * ML_PITCH + (2 * w + dt) * 32), hi = tr_read4(kb + ks * 32 * ML_PITCH + 4 * ML_PITCH + (2 * w + dt) * 32);
                kf[dt][ks] = (s16x8){lo[0], lo[1], lo[2], lo[3], hi[0], hi[1], hi[2], hi[3]}; }
        bf16* cu = CST + (size_t)u * ML_USZ;
#pragma unroll 1
        for (int et = 0; et < 17; ++et) {
            f32x4 a0 = {0.f, 0.f, 0.f, 0.f}, a1 = {0.f, 0.f, 0.f, 0.f};
#pragma unroll
            for (int ks = 0; ks < 4; ++ks) { const s16x4 lo = tr_read4(vb + ks * 32 * ML_PITCH + et * 32), hi = tr_read4(vb + ks * 32 * ML_PITCH + 4 * ML_PITCH + et * 32);
                const s16x8 vf = {lo[0], lo[1], lo[2], lo[3], hi[0], hi[1], hi[2], hi[3]};
                a0 = __builtin_amdgcn_mfma_f32_16x16x32_bf16(kf[0][ks], vf, a0, 0, 0, 0); a1 = __builtin_amdgcn_mfma_f32_16x16x32_bf16(kf[1][ks], vf, a1, 0, 0, 0); }
            const int e = et * 16 + li;
            if (e < ML_ROWS) { v2u o0, o1; o0.x = cvt_pk_bf16(a0[0], a0[1]); o0.y = cvt_pk_bf16(a0[2], a0[3]); o1.x = cvt_pk_bf16(a1[0], a1[1]); o1.y = cvt_pk_bf16(a1[2], a1[3]);
                *(v2u*)(cu + (size_t)e * 256 + 32 * w + 4 * g4) = o0; *(v2u*)(cu + (size_t)e * 256 + 32 * w + 16 + 4 * g4) = o1; }
        }
        __syncthreads();
    }
}
__device__ __forceinline__ void mlstm_a2_phase(const bf16* DC, bf16* CIN, const float* MF, int gtid, int NGT) {
    constexpr int NQ = ML_USZ / 8;
    for (int job = gtid; job < 8 * NQ; job += NGT) {
        const int bh = job / NQ, q = job % NQ;
        float cr[8];
#pragma unroll
        for (int j = 0; j < 8; ++j) cr[j] = 0.f;
        const bf16* p = DC + (size_t)bh * 128 * ML_USZ + (size_t)q * 8; bf16* po = CIN + (size_t)bh * 128 * ML_USZ + (size_t)q * 8;
        for (int c0 = 0; c0 < 128; c0 += 8) {
            v4u d[8]; float f[8];
#pragma unroll
            for (int k = 0; k < 8; ++k) { d[k] = *(const v4u*)(p + (size_t)(c0 + k) * ML_USZ); f[k] = MF[(bh * 128 + c0 + k) * 32]; }
#pragma unroll
            for (int k = 0; k < 8; ++k) {
                v4u o; o.x = pk2(cr[0], cr[1]); o.y = pk2(cr[2], cr[3]); o.z = pk2(cr[4], cr[5]); o.w = pk2(cr[6], cr[7]);
                *(v4u*)(po + (size_t)(c0 + k) * ML_USZ) = o;
                cr[0] = f[k] * cr[0] + bflo(d[k].x); cr[1] = f[k] * cr[1] + bfhi(d[k].x); cr[2] = f[k] * cr[2] + bflo(d[k].y); cr[3] = f[k] * cr[3] + bfhi(d[k].y);
                cr[4] = f[k] * cr[4] + bflo(d[k].z); cr[5] = f[k] * cr[5] + bfhi(d[k].z); cr[6] = f[k] * cr[6] + bflo(d[k].w); cr[7] = f[k] * cr[7] + bfhi(d[k].w);
            }
        }
    }
}
constexpr int ML3_GOFF = 139840;
__device__ __forceinline__ void mlstm_a3_phase(const bf16* QKC, const bf16* PROJ, const float* IFG, const bf16* CST, const float* mg, bf16* Yo, LAS unsigned char* lds, int bx, int G, int tid) {
    const int lane = tid & 63, w = __builtin_amdgcn_readfirstlane(tid >> 6), li = lane & 15, g4 = lane >> 4;
    for (int u = bx; u < 1024; u += G) {
        const int c = u & 127, h = (u >> 7) & 3, b = u >> 9; const size_t m0 = (size_t)b * SEQ + c * 128;
        LAS float* gv = (LAS float*)(lds + ML3_GOFF);
        ml_gates(IFG, m0, h, gv, tid);
        const bf16* cu = CST + (size_t)u * ML_USZ;
#pragma unroll 1
        for (int hf = 0; hf < 2; ++hf) { v4u r[8];
#pragma unroll
            for (int it = 0; it < 8; ++it) { const int chunk = (hf * 8 + it) * NTHR + tid; r[it] = *(const v4u*)(cu + (size_t)(chunk >> 5) * 256 + (chunk & 31) * 8); }
#pragma unroll
            for (int it = 0; it < 8; ++it) { const int chunk = (hf * 8 + it) * NTHR + tid; *(LAS v4u*)(lds + (chunk >> 5) * ML_PITCH + (chunk & 31) * 16) = r[it]; } }
        if (tid < 32) *(LAS v4u*)(lds + 256 * ML_PITCH + tid * 16) = *(const v4u*)(cu + (size_t)256 * 256 + tid * 8);
        const size_t mq = m0 + 16 * w + li;
        __syncthreads();
        s16x8 qf[8];
#pragma unroll
        for (int ks = 0; ks < 8; ++ks) qf[ks] = *(const s16x8*)(QKC + mq * 2048 + h * 256 + 32 * ks + 8 * g4);
        f32x4 o[17];
#pragma unroll
        for (int et = 0; et < 17; ++et) { f32x4 acc = {0.f, 0.f, 0.f, 0.f}; const int row = (et * 16 + li) < ML_ROWS ? (et * 16 + li) : (ML_ROWS - 1);
#pragma unroll
            for (int ks = 0; ks < 8; ++ks) { const s16x8 cf = *(const LAS s16x8*)(lds + row * ML_PITCH + (32 * ks + 8 * g4) * 2); acc = __builtin_amdgcn_mfma_f32_16x16x32_bf16(cf, qf[ks], acc, 0, 0, 0); }
            o[et] = acc; if (et & 1) __builtin_amdgcn_sched_barrier(0); }
        const float bt = gv[16 * w + li], ebt = __expf(bt);
#pragma unroll
        for (int et = 0; et < 17; ++et) o[et] *= ebt;
        v4u kr[8], vr[8];
#pragma unroll
        for (int it = 0; it < 8; ++it) { const int chunk = it * NTHR + tid, row = chunk >> 5, c16 = chunk & 31;
            kr[it] = *(const v4u*)(QKC + (m0 + row) * 2048 + 1024 + h * 256 + c16 * 8); vr[it] = *(const v4u*)(PROJ + (m0 + row) * NPROJ + PV + h * 256 + c16 * 8); }
        __syncthreads();
#pragma unroll
        for (int it = 0; it < 8; ++it) { const int chunk = it * NTHR + tid, row = chunk >> 5, c16 = chunk & 31;
            *(LAS v4u*)(lds + ML_KOFF + row * ML_PITCH + c16 * 16) = kr[it]; *(LAS v4u*)(lds + ML_VOFF + row * ML_PITCH + c16 * 16) = vr[it]; }
        if (tid < 256) { const int row = tid >> 1, hf = tid & 1; v4u z = {0u, 0u, 0u, 0u}; if (hf == 0) z.x = 0x3f80u; *(LAS v4u*)(lds + ML_VOFF + row * ML_PITCH + 512 + hf * 16) = z; }
        __syncthreads();
        v4u pk[4];
#pragma unroll
        for (int p = 0; p < 4; ++p) pk[p] = (v4u){0u, 0u, 0u, 0u};
#pragma unroll
        for (int kt = 0; kt < 8; ++kt) {
            if (kt <= w) {
                f32x4 acc = {0.f, 0.f, 0.f, 0.f};
#pragma unroll
                for (int ks = 0; ks < 8; ++ks) { const s16x8 kf = *(const LAS s16x8*)(lds + ML_KOFF + (16 * kt + li) * ML_PITCH + (32 * ks + 8 * g4) * 2); acc = __builtin_amdgcn_mfma_f32_16x16x32_bf16(kf, qf[ks], acc, 0, 0, 0); }
                const f32x4 av = *(const LAS f32x4*)(gv + 128 + 16 * kt + 4 * g4);
                float pv[4];
#pragma unroll
                for (int i = 0; i < 4; ++i) { const bool ok = (16 * kt + 4 * g4 + i) <= (16 * w + li); pv[i] = ok ? acc[i] * __expf(bt + av[i]) : 0.f; }
                if (kt & 1) { pk[kt >> 1].z = cvt_pk_bf16(pv[0], pv[1]); pk[kt >> 1].w = cvt_pk_bf16(pv[2], pv[3]); } else { pk[kt >> 1].x = cvt_pk_bf16(pv[0], pv[1]); pk[kt >> 1].y = cvt_pk_bf16(pv[2], pv[3]); }
            }
        }
        LAS unsigned char* vb = lds + ML_VOFF + (4 * g4 + (li >> 2)) * ML_PITCH + (li & 3) * 8;
#pragma unroll
        for (int p = 0; p < 4; ++p) {
            if (2 * p <= w) {
                const s16x8 pf = __builtin_bit_cast(s16x8, pk[p]);
#pragma unroll
                for (int et = 0; et < 17; ++et) { const s16x4 lo = tr_read4(vb + p * 32 * ML_PITCH + et * 32), hi = tr_read4(vb + p * 32 * ML_PITCH + 16 * ML_PITCH + et * 32);
                    const s16x8 vf = {lo[0], lo[1], lo[2], lo[3], hi[0], hi[1], hi[2], hi[3]};
                    o[et] = __builtin_amdgcn_mfma_f32_16x16x32_bf16(vf, pf, o[et], 0, 0, 0); }
            }
        }
        const float den = __shfl(o[16][0], li), rden = 1.0f / fmaxf(fabsf(den), 1.0f);
        float ss = 0.f;
#pragma unroll
        for (int et = 0; et < 16; ++et) { o[et] *= rden; ss += (o[et][0] * o[et][0] + o[et][1] * o[et][1]) + (o[et][2] * o[et][2] + o[et][3] * o[et][3]); }
        ss += __shfl_xor(ss, 16); ss += __shfl_xor(ss, 32);
        const float rn = 1.0f / sqrtf(ss * (1.0f / 256.0f) + NORM_EPS);
#pragma unroll
        for (int et = 0; et < 16; ++et) { const int ch = h * 256 + 16 * et + 4 * g4;
            const v2u og = *(const v2u*)(PROJ + mq * NPROJ + PO + ch); const f32x4 gn = *(const f32x4*)(mg + ch);
            v2u wv; wv.x = cvt_pk_bf16(bflo(og.x) * (o[et][0] * rn) * gn[0], bfhi(og.x) * (o[et][1] * rn) * gn[1]); wv.y = cvt_pk_bf16(bflo(og.y) * (o[et][2] * rn) * gn[2], bfhi(og.y) * (o[et][3] * rn) * gn[3]);
            *(v2u*)(Yo + mq * 3072 + ch) = wv; }
        __syncthreads();
    }
}
__device__ __forceinline__ float dpp_row_shr1(float v) { return __builtin_bit_cast(float, __builtin_amdgcn_update_dpp(0, __builtin_bit_cast(int, v), 0x111, 0xF, 0xF, true)); }
__device__ __forceinline__ float dpp_row_shr2(float v) { return __builtin_bit_cast(float, __builtin_amdgcn_update_dpp(0, __builtin_bit_cast(int, v), 0x112, 0xF, 0xF, true)); }
__device__ __forceinline__ float dpp_row_shr4(float v) { return __builtin_bit_cast(float, __builtin_amdgcn_update_dpp(0, __builtin_bit_cast(int, v), 0x114, 0xF, 0xF, true)); }
__device__ __forceinline__ float dpp_row_shr8(float v) { return __builtin_bit_cast(float, __builtin_amdgcn_update_dpp(0, __builtin_bit_cast(int, v), 0x118, 0xF, 0xF, true)); }
__device__ __forceinline__ float dpp_row_ror1(float v) { return __builtin_bit_cast(float, __builtin_amdgcn_update_dpp(0, __builtin_bit_cast(int, v), 0x121, 0xF, 0xF, true)); }
__device__ __forceinline__ float gelu_tanh_f(float y) { const float x = 0.7978845608028654f * (y + 0.044715f * y * y * y); const float th = 1.0f - 2.0f * __builtin_amdgcn_rcpf(1.0f + __builtin_amdgcn_exp2f(2.8853900817779268f * x)); return 0.5f * y * (1.0f + th); }
__device__ __forceinline__ void s5_disc_phase(const S5P& P, f32x4* DISC, int gtid) { if (gtid < 4096) { float a_r, a_i, f_r, f_i; s5_disc(P, gtid >> 6, gtid & 63, a_r, a_i, f_r, f_i); DISC[gtid] = (f32x4){a_r, a_i, f_r, f_i};
    const float t2 = a_r * a_i, a2r = a_r * a_r - a_i * a_i, a2i = t2 + t2, t4 = a2r * a2i, a4r = a2r * a2r - a2i * a2i, a4i = t4 + t4, t8 = a4r * a4i, a8r = a4r * a4r - a4i * a4i, a8i = t8 + t8;
    const float t16 = a8r * a8i, a12r = a8r * a4r - a8i * a4i, a12i = a8r * a4i + a8i * a4r, a16r = a8r * a8r - a8i * a8i, a16i = t16 + t16;
    float one = 1.f, zero = 0.f; asm volatile("" : "+v"(one), "+v"(zero));
    f32x4* E = DISC + 4096 + (size_t)gtid * 4; E[0] = (f32x4){one, zero, a4r, a4i}; E[1] = (f32x4){a8r, a8i, a12r, a12i}; E[2] = (f32x4){a16r, a16i, a_r, a_i}; E[3] = (f32x4){f_r, f_i, zero, zero}; } }
constexpr int S5_WLDS = 16384, S5_BOFF = 0, S5_COFF = 8192, S5_AOFF = 12288, S5_XOFF = 12800;
template <bool OUT>
__device__ __forceinline__ void s5_mfma_phase(const S5P& P, const f32x4* DISC, const bf16* PROJ, float* LOC, const float* CAR, bf16* Zb, LAS unsigned char* wl, int gw, int NGW, int lane) {
    const int li = lane & 15, g4 = lane >> 4;
    LAS v4u* bl = (LAS v4u*)(wl + S5_BOFF); LAS v4u* cl = (LAS v4u*)(wl + S5_COFF);
    LAS f32x4* at = (LAS f32x4*)(wl + S5_AOFF) + g4 * 8;
    LAS f32x4* xt = (LAS f32x4*)(wl + S5_XOFF) + g4 * 8;
    for (int wj = gw >> 3; wj < 256; wj += NGW >> 3) {
        const int wv = gw & 7, c = (wj & 7) * 2 + (wv >> 2), grp = ((wj >> 3) & 15) * 4 + (wv & 3), b = wj >> 7;
#pragma unroll
        for (int T = 0; T < 4; ++T) { const int p = 16 * T + li; const f32x4 dq = DISC[grp * 64 + p]; const float f_r = dq[2], f_i = dq[3];
            v4u re = {0u, 0u, 0u, 0u}, im = {0u, 0u, 0u, 0u};
            if (g4 < 2) { const float* br = P.b_re + (grp * 64 + p) * 16 + 8 * g4; const float* bi = P.b_im + (grp * 64 + p) * 16 + 8 * g4; float vr[8], vi[8];
#pragma unroll
                for (int j = 0; j < 8; ++j) { vr[j] = f_r * br[j] - f_i * bi[j]; vi[j] = f_r * bi[j] + f_i * br[j]; }
                re.x = pk2(vr[0], vr[1]); re.y = pk2(vr[2], vr[3]); re.z = pk2(vr[4], vr[5]); re.w = pk2(vr[6], vr[7]); im.x = pk2(vi[0], vi[1]); im.y = pk2(vi[2], vi[3]); im.z = pk2(vi[4], vi[5]); im.w = pk2(vi[6], vi[7]); }
            bl[T * 64 + lane] = re; bl[(4 + T) * 64 + lane] = im; }
        if (OUT) {
#pragma unroll
            for (int ks = 0; ks < 4; ++ks) { float cv[8];
#pragma unroll
                for (int j = 0; j < 8; ++j) { const int pp = 16 * (2 * ks + (j >> 2)) + 4 * g4 + (j & 3);
                    cv[j] = (pp < 64) ? P.c_re[(grp * 16 + li) * 64 + pp] : -P.c_im[(grp * 16 + li) * 64 + pp - 64]; }
                v4u w; w.x = pk2(cv[0], cv[1]); w.y = pk2(cv[2], cv[3]); w.z = pk2(cv[4], cv[5]); w.w = pk2(cv[6], cv[7]); cl[ks * 64 + lane] = w; }
        }
        if (li < 8) {
            const int q0 = 2 * li, p0 = 16 * (q0 >> 2) + 4 * g4 + (q0 & 3), p1 = p0 + 1; const f32x4 d0 = DISC[grp * 64 + p0], d1 = DISC[grp * 64 + p1];
            at[li] = (f32x4){d0[0], d0[1], d1[0], d1[1]};
            float zf = 0.f; asm volatile("" : "+v"(zf));
            f32x4 c0 = {zf, zf, zf, zf};
            if (OUT) { const size_t s0 = ((size_t)((b * 64 + grp) * 16 + c) * 64 + p0) * 2; c0 = (f32x4){CAR[s0], CAR[s0 + 1], CAR[s0 + 2], CAR[s0 + 3]}; }
            xt[li] = c0; }
        float dsk[4] = {0.f, 0.f, 0.f, 0.f};
        if (OUT) {
#pragma unroll
            for (int i = 0; i < 4; ++i) dsk[i] = P.d_skip[grp * 16 + 4 * g4 + i]; }
        LDS_WAIT();
        const bf16* ub = PROJ + ((size_t)b * SEQ + c * 1024 + li) * NPROJ + PU + grp * 16;
        v4u un0 = {0u, 0u, 0u, 0u}, un1 = {0u, 0u, 0u, 0u};
        if (g4 < 2) { un0 = *(const v4u*)(ub + 8 * g4); un1 = *(const v4u*)(ub + (size_t)16 * NPROJ + 8 * g4); }
        v2u us0 = {0u, 0u}, us1 = {0u, 0u};
        if (OUT) { us0 = *(const v2u*)(ub + 4 * g4); us1 = *(const v2u*)(ub + (size_t)16 * NPROJ + 4 * g4); }
#pragma unroll 1
        for (int tt = 0; tt < 64; ++tt) {
            const v4u uv = un0; const v2u us = us0; un0 = un1; us0 = us1;
            { const int t2 = tt + 2 < 64 ? tt + 2 : 63; const bf16* u2 = ub + (size_t)t2 * 16 * NPROJ;
              if (g4 < 2) un1 = *(const v4u*)(u2 + 8 * g4);
              if (OUT) us1 = *(const v2u*)(u2 + 4 * g4); }
            const s16x8 uf = __builtin_bit_cast(s16x8, uv);
            f32x4 y = {0.f, 0.f, 0.f, 0.f};
#pragma unroll 1
            for (int h2 = 0; h2 < 2; ++h2) {
                float xr[8], xi[8], ar[8], ai[8];
#pragma unroll
                for (int Tl = 0; Tl < 2; ++Tl) { const int T = 2 * h2 + Tl; const f32x4 z4 = {0.f, 0.f, 0.f, 0.f};
                    const s16x8 bre = __builtin_bit_cast(s16x8, bl[T * 64 + lane]), bim = __builtin_bit_cast(s16x8, bl[(4 + T) * 64 + lane]);
                    const f32x4 dre = __builtin_amdgcn_mfma_f32_16x16x32_bf16(bre, uf, z4, 0, 0, 0), dim = __builtin_amdgcn_mfma_f32_16x16x32_bf16(bim, uf, z4, 0, 0, 0);
#pragma unroll
                    for (int i = 0; i < 4; ++i) { xr[4 * Tl + i] = dre[i]; xi[4 * Tl + i] = dim[i]; } }
#pragma unroll
                for (int k = 0; k < 4; ++k) { const f32x4 av = at[4 * h2 + k], cv = xt[4 * h2 + k];
                    ar[2 * k] = av[0]; ai[2 * k] = av[1]; ar[2 * k + 1] = av[2]; ai[2 * k + 1] = av[3];
                    if (li == 0) { xr[2 * k] += av[0] * cv[0] - av[1] * cv[1]; xi[2 * k] += av[0] * cv[1] + av[1] * cv[0]; xr[2 * k + 1] += av[2] * cv[2] - av[3] * cv[3]; xi[2 * k + 1] += av[2] * cv[3] + av[3] * cv[2]; } }
#pragma unroll
                for (int q = 0; q < 8; ++q) {
                    float vr = xr[q], vi = xi[q], wr = ar[q], wi = ai[q];
                    { const float tr = dpp_row_shr1(vr), ti = dpp_row_shr1(vi); vr += wr * tr - wi * ti; vi += wr * ti + wi * tr; }
                    { const float nr = wr * wr - wi * wi, ni = 2.f * wr * wi; wr = nr; wi = ni; }
                    { const float tr = dpp_row_shr2(vr), ti = dpp_row_shr2(vi); vr += wr * tr - wi * ti; vi += wr * ti + wi * tr; }
                    { const float nr = wr * wr - wi * wi, ni = 2.f * wr * wi; wr = nr; wi = ni; }
                    { const float tr = dpp_row_shr4(vr), ti = dpp_row_shr4(vi); vr += wr * tr - wi * ti; vi += wr * ti + wi * tr; }
                    { const float nr = wr * wr - wi * wi, ni = 2.f * wr * wi; wr = nr; wi = ni; }
                    { const float tr = dpp_row_shr8(vr), ti = dpp_row_shr8(vi); vr += wr * tr - wi * ti; vi += wr * ti + wi * tr; }
                    xr[q] = vr; xi[q] = vi; }
                if (li == 15) {
#pragma unroll
                    for (int k = 0; k < 4; ++k) xt[4 * h2 + k] = (f32x4){xr[2 * k], xi[2 * k], xr[2 * k + 1], xi[2 * k + 1]}; }
                if (OUT) { v4u wre, wim;
                    wre.x = cvt_pk_bf16(xr[0], xr[1]); wre.y = cvt_pk_bf16(xr[2], xr[3]); wre.z = cvt_pk_bf16(xr[4], xr[5]); wre.w = cvt_pk_bf16(xr[6], xr[7]);
                    wim.x = cvt_pk_bf16(xi[0], xi[1]); wim.y = cvt_pk_bf16(xi[2], xi[3]); wim.z = cvt_pk_bf16(xi[4], xi[5]); wim.w = cvt_pk_bf16(xi[6], xi[7]);
                    y = __builtin_amdgcn_mfma_f32_16x16x32_bf16(__builtin_bit_cast(s16x8, cl[h2 * 64 + lane]), __builtin_bit_cast(s16x8, wre), y, 0, 0, 0);
                    y = __builtin_amdgcn_mfma_f32_16x16x32_bf16(__builtin_bit_cast(s16x8, cl[(2 + h2) * 64 + lane]), __builtin_bit_cast(s16x8, wim), y, 0, 0, 0); }
            }
            if (OUT) {
                const float u4[4] = {bflo(us.x), bfhi(us.x), bflo(us.y), bfhi(us.y)};
                float z[4];
#pragma unroll
                for (int i = 0; i < 4; ++i) z[i] = gelu_tanh_f(y[i] + dsk[i] * u4[i]);
                v2u zo; zo.x = cvt_pk_bf16(z[0], z[1]); zo.y = cvt_pk_bf16(z[2], z[3]);
                *(v2u*)(Zb + ((size_t)b * SEQ + c * 1024 + tt * 16 + li) * 1024 + grp * 16 + 4 * g4) = zo;
            }
        }
        if (!OUT) { if (li < 8) { const f32x4 fv = xt[li];
#pragma unroll
            for (int e = 0; e < 2; ++e) { const int q = 2 * li + e, p = 16 * (q >> 2) + 4 * g4 + (q & 3); const size_t sidx = ((size_t)((b * 64 + grp) * 16 + c) * 64 + p) * 2; LOC[sidx] = fv[2 * e]; LOC[sidx + 1] = fv[2 * e + 1]; } } }
        LDS_WAIT();
    }
}
__device__ __forceinline__ void s5a_reduce_phase(const S5P& P, const f32x4* DISC, const bf16* PROJ, float* LOC, LAS unsigned char* wl, int gw, int NGW, int lane) {
    const int li = lane & 15, g4 = lane >> 4;
    LAS v4u* bl = (LAS v4u*)(wl + S5_BOFF);
    for (int wj = gw >> 3; wj < 256; wj += NGW >> 3) {
        const int wv = gw & 7, c = (wj & 7) * 2 + (wv >> 2), grp = ((wj >> 3) & 15) * 4 + (wv & 3), b = wj >> 7;
#pragma unroll
        for (int T = 0; T < 4; ++T) { const int p = 16 * T + li; const f32x4 dq = DISC[grp * 64 + p]; const float f_r = dq[2], f_i = dq[3];
            v4u re = {0u, 0u, 0u, 0u}, im = {0u, 0u, 0u, 0u};
            if (g4 < 2) { const float* br = P.b_re + (grp * 64 + p) * 16 + 8 * g4; const float* bi = P.b_im + (grp * 64 + p) * 16 + 8 * g4; float vr[8], vi[8];
#pragma unroll
                for (int j = 0; j < 8; ++j) { vr[j] = f_r * br[j] - f_i * bi[j]; vi[j] = f_r * bi[j] + f_i * br[j]; }
                re.x = pk2(vr[0], vr[1]); re.y = pk2(vr[2], vr[3]); re.z = pk2(vr[4], vr[5]); re.w = pk2(vr[6], vr[7]); im.x = pk2(vi[0], vi[1]); im.y = pk2(vi[2], vi[3]); im.z = pk2(vi[4], vi[5]); im.w = pk2(vi[6], vi[7]); }
            bl[T * 64 + lane] = re; bl[(4 + T) * 64 + lane] = im; }
        float wr[16], wi[16], sr[16], si[16], cr[16], ci[16];
        const int ex = 15 - li;
#pragma unroll
        for (int q = 0; q < 16; ++q) { const f32x4 da = DISC[grp * 64 + 16 * (q >> 2) + 4 * g4 + (q & 3)];
            float pr = da[0], pi = da[1], ar_ = 1.f, ai_ = 0.f;
#pragma unroll
            for (int bit = 0; bit < 4; ++bit) { if ((ex >> bit) & 1) { const float nr = ar_ * pr - ai_ * pi, ni = ar_ * pi + ai_ * pr; ar_ = nr; ai_ = ni; }
                const float qr = pr * pr - pi * pi, qi = 2.f * pr * pi; pr = qr; pi = qi; }
            wr[q] = ar_; wi[q] = ai_; sr[q] = pr; si[q] = pi; cr[q] = 0.f; ci[q] = 0.f; }
        LDS_WAIT();
        const bf16* ub = PROJ + ((size_t)b * SEQ + c * 1024 + li) * NPROJ + PU + grp * 16;
        v4u un0 = {0u, 0u, 0u, 0u}, un1 = {0u, 0u, 0u, 0u};
        if (g4 < 2) { un0 = *(const v4u*)(ub + 8 * g4); un1 = *(const v4u*)(ub + (size_t)16 * NPROJ + 8 * g4); }
#pragma unroll 1
        for (int tt = 0; tt < 64; ++tt) {
            const v4u uv = un0; un0 = un1;
            { const int t2 = tt + 2 < 64 ? tt + 2 : 63; if (g4 < 2) un1 = *(const v4u*)(ub + (size_t)t2 * 16 * NPROJ + 8 * g4); }
            const s16x8 uf = __builtin_bit_cast(s16x8, uv);
#pragma unroll
            for (int T = 0; T < 4; ++T) { const f32x4 z4 = {0.f, 0.f, 0.f, 0.f};
                const s16x8 bre = __builtin_bit_cast(s16x8, bl[T * 64 + lane]), bim = __builtin_bit_cast(s16x8, bl[(4 + T) * 64 + lane]);
                const f32x4 dre = __builtin_amdgcn_mfma_f32_16x16x32_bf16(bre, uf, z4, 0, 0, 0), dim = __builtin_amdgcn_mfma_f32_16x16x32_bf16(bim, uf, z4, 0, 0, 0);
#pragma unroll
                for (int i = 0; i < 4; ++i) { const int q = 4 * T + i;
                    float vr = dre[i] * wr[q] - dim[i] * wi[q], vi = dre[i] * wi[q] + dim[i] * wr[q];
                    vr += dpp_row_shr1(vr); vi += dpp_row_shr1(vi); vr += dpp_row_shr2(vr); vi += dpp_row_shr2(vi);
                    vr += dpp_row_shr4(vr); vi += dpp_row_shr4(vi); vr += dpp_row_shr8(vr); vi += dpp_row_shr8(vi);
                    const float nr = sr[q] * cr[q] - si[q] * ci[q] + vr, ni = sr[q] * ci[q] + si[q] * cr[q] + vi; cr[q] = nr; ci[q] = ni; }
                __builtin_amdgcn_sched_barrier(0); }
        }
        if (li == 15) {
#pragma unroll
            for (int q = 0; q < 16; ++q) { const int p = 16 * (q >> 2) + 4 * g4 + (q & 3); const size_t sidx = ((size_t)((b * 64 + grp) * 16 + c) * 64 + p) * 2; LOC[sidx] = cr[q]; LOC[sidx + 1] = ci[q]; } }
        LDS_WAIT();
    }
}
__device__ __forceinline__ float bperm_f(int addr, float v) { return __builtin_bit_cast(float, __builtin_amdgcn_ds_bpermute(addr, __builtin_bit_cast(int, v))); }
struct S5Pw { float ar, ai, a4r, a4i, a8r, a8i, a16r, a16i; };
__device__ __forceinline__ S5Pw s5_powers(const f32x4 dq) { S5Pw w; w.ar = dq[0]; w.ai = dq[1];
    const float a2r = w.ar * w.ar - w.ai * w.ai, a2i = 2.f * w.ar * w.ai; w.a4r = a2r * a2r - a2i * a2i; w.a4i = 2.f * a2r * a2i;
    w.a8r = w.a4r * w.a4r - w.a4i * w.a4i; w.a8i = 2.f * w.a4r * w.a4i; w.a16r = w.a8r * w.a8r - w.a8i * w.a8i; w.a16i = 2.f * w.a8r * w.a8i; return w; }
__device__ __forceinline__ void s5_fill_bfrags(const S5P& P, const f32x4* DISC, int grp, LAS v4u* bl, int lane) {
    const int li = lane & 15, g4 = lane >> 4;
#pragma unroll
    for (int T = 0; T < 4; ++T) { const int p = 16 * T + li; const f32x4 dq = DISC[grp * 64 + p]; const float f_r = dq[2], f_i = dq[3];
        v4u re = {0u, 0u, 0u, 0u}, im = {0u, 0u, 0u, 0u};
        if (g4 < 2) { const float* br = P.b_re + (grp * 64 + p) * 16 + 8 * g4; const float* bi = P.b_im + (grp * 64 + p) * 16 + 8 * g4; float vr[8], vi[8];
#pragma unroll
            for (int j = 0; j < 8; ++j) { vr[j] = f_r * br[j] - f_i * bi[j]; vi[j] = f_r * bi[j] + f_i * br[j]; }
            re.x = pk2(vr[0], vr[1]); re.y = pk2(vr[2], vr[3]); re.z = pk2(vr[4], vr[5]); re.w = pk2(vr[6], vr[7]); im.x = pk2(vi[0], vi[1]); im.y = pk2(vi[2], vi[3]); im.z = pk2(vi[4], vi[5]); im.w = pk2(vi[6], vi[7]); }
        bl[T * 64 + lane] = re; bl[(4 + T) * 64 + lane] = im; }
}
__device__ __forceinline__ float afma(float a, float b, float c) { float d; asm("v_fma_f32 %0, %1, %2, %3" : "=v"(d) : "v"(a), "v"(b), "v"(c)); return d; }
__device__ __forceinline__ float anfma(float a, float b, float c) { float d; asm("v_fma_f32 %0, -%1, %2, %3" : "=v"(d) : "v"(a), "v"(b), "v"(c)); return d; }
__device__ __forceinline__ float aadd(float a, float b) { float d; asm("v_add_f32 %0, %1, %2" : "=v"(d) : "v"(a), "v"(b)); return d; }
#define CFMA(rr, ri, ar, ai, xr_, xi_, cr_, ci_) do { const float t0_ = anfma(ai, xi_, cr_), t1_ = afma(ai, xr_, ci_); rr = afma(ar, xr_, t0_); ri = afma(ar, xi_, t1_); } while (0)
__device__ __forceinline__ void s5a_ls_phase(const S5P& P, const f32x4* DISC, const bf16* PROJ, float* LOC, LAS unsigned char* wl, int gw, int NGW, int lane) {
    float zf = 0.f; asm volatile("" : "+v"(zf));
    const int li = lane & 15, g4 = lane >> 4;
    LAS v4u* bl = (LAS v4u*)(wl + S5_BOFF);
    const int ax16 = (lane ^ 16) << 2, ax32 = (lane ^ 32) << 2;
    for (int wj = gw >> 3; wj < 256; wj += NGW >> 3) {
        const int wv = gw & 7, c = (wj & 7) * 2 + (wv >> 2), grp = ((wj >> 3) & 15) * 4 + (wv & 3), b = wj >> 7;
        s5_fill_bfrags(P, DISC, grp, bl, lane);
        S5Pw pw[4]; float qr[4], qi[4], cr[4], ci[4];
        const f32x2* E = (const f32x2*)(DISC + 4096);
#pragma unroll
        for (int T = 0; T < 4; ++T) { const f32x2* e = E + (size_t)(grp * 64 + 16 * T + li) * 8; const f32x2 a = e[5], q = e[3 - g4], s16 = e[4];
            pw[T].ar = a[0]; pw[T].ai = a[1]; pw[T].a16r = s16[0]; pw[T].a16i = s16[1]; qr[T] = q[0]; qi[T] = q[1]; cr[T] = 0.f; ci[T] = 0.f; }
        LDS_WAIT();
        const bf16* ub = PROJ + ((size_t)b * SEQ + c * 1024 + li) * NPROJ + PU + grp * 16;
        v4u un0 = {0u, 0u, 0u, 0u}, un1 = {0u, 0u, 0u, 0u};
        if (g4 < 2) { un0 = *(const v4u*)(ub + 8 * g4); un1 = *(const v4u*)(ub + (size_t)16 * NPROJ + 8 * g4); }
#pragma unroll 1
        for (int tt = 0; tt < 64; ++tt) {
            const v4u uv = un0; un0 = un1;
            { const int t2 = tt + 2 < 64 ? tt + 2 : 63; if (g4 < 2) un1 = *(const v4u*)(ub + (size_t)t2 * 16 * NPROJ + 8 * g4); }
            const s16x8 uf = __builtin_bit_cast(s16x8, uv);
            f32x4 dre4[4], dim4[4];
#pragma unroll
            for (int T = 0; T < 4; ++T) { const f32x4 z4 = {0.f, 0.f, 0.f, 0.f};
                dre4[T] = __builtin_amdgcn_mfma_f32_16x16x32_bf16(uf, __builtin_bit_cast(s16x8, bl[T * 64 + lane]), z4, 0, 0, 0); dim4[T] = __builtin_amdgcn_mfma_f32_16x16x32_bf16(uf, __builtin_bit_cast(s16x8, bl[(4 + T) * 64 + lane]), z4, 0, 0, 0); }
            asm volatile("s_nop 7\n\ts_nop 3" : "+v"(dre4[0]), "+v"(dim4[0]), "+v"(dre4[1]), "+v"(dim4[1]), "+v"(dre4[2]), "+v"(dim4[2]), "+v"(dre4[3]), "+v"(dim4[3]));
#pragma unroll
            for (int T = 0; T < 4; ++T) { const f32x4 dre = dre4[T], dim = dim4[T];
                const float a_r = pw[T].ar, a_i = pw[T].ai;
                float hr = dre[0], hi = dim[0];
#pragma unroll
                for (int i = 1; i < 4; ++i) { float nr, ni; CFMA(nr, ni, a_r, a_i, hr, hi, dre[i], dim[i]); hr = nr; hi = ni; }
                float wr, wi; CFMA(wr, wi, qr[T], qi[T], hr, hi, zf, zf);
                wr = aadd(wr, bperm_f(ax16, wr)); wi = aadd(wi, bperm_f(ax16, wi)); wr = aadd(wr, bperm_f(ax32, wr)); wi = aadd(wi, bperm_f(ax32, wi));
                { float nr, ni; CFMA(nr, ni, pw[T].a16r, pw[T].a16i, cr[T], ci[T], wr, wi); cr[T] = nr; ci[T] = ni; } }
        }
        if (g4 == 0) {
#pragma unroll
            for (int T = 0; T < 4; ++T) { const int p = 16 * T + li; const size_t sidx = ((size_t)((b * 64 + grp) * 16 + c) * 64 + p) * 2; LOC[sidx] = cr[T]; LOC[sidx + 1] = ci[T]; } }
        LDS_WAIT();
    }
}
constexpr int S5_XTOFF = 12288;
__device__ __forceinline__ void s5c_ls_phase(const S5P& P, const f32x4* DISC, const bf16* PROJ, const float* CAR, bf16* Zb, LAS unsigned char* wl, int gw, int NGW, int lane) {
    float zf = 0.f; asm volatile("" : "+v"(zf));
    const int li = lane & 15, g4 = lane >> 4;
    LAS v4u* bl = (LAS v4u*)(wl + S5_BOFF); LAS v4u* cl = (LAS v4u*)(wl + S5_COFF); LAS unsigned char* xt = wl + S5_XTOFF;
    const int au16 = ((lane - 16) & 63) << 2, au32 = ((lane - 32) & 63) << 2, ab3 = (48 + li) << 2;
    for (int wj = gw >> 3; wj < 256; wj += NGW >> 3) {
        const int wv = gw & 7, c = (wj & 7) * 2 + (wv >> 2), grp = ((wj >> 3) & 15) * 4 + (wv & 3), b = wj >> 7;
        s5_fill_bfrags(P, DISC, grp, bl, lane);
#pragma unroll
        for (int ks = 0; ks < 4; ++ks) { float cv[8];
#pragma unroll
            for (int j = 0; j < 8; ++j) { const int pp = 32 * ks + 8 * g4 + j; cv[j] = (pp < 64) ? P.c_re[(grp * 16 + li) * 64 + pp] : -P.c_im[(grp * 16 + li) * 64 + pp - 64]; }
            v4u w; w.x = pk2(cv[0], cv[1]); w.y = pk2(cv[2], cv[3]); w.z = pk2(cv[4], cv[5]); w.w = pk2(cv[6], cv[7]); cl[ks * 64 + lane] = w; }
        S5Pw pw[4]; float gr[4], gi[4], cr[4], ci[4];
        const f32x2* E = (const f32x2*)(DISC + 4096);
#pragma unroll
        for (int T = 0; T < 4; ++T) { const int p = 16 * T + li; const f32x2* e = E + (size_t)(grp * 64 + p) * 8; const f32x2 a = e[5], p4 = e[1], p8 = e[2], gq = e[g4];
            pw[T].ar = a[0]; pw[T].ai = a[1]; pw[T].a4r = p4[0]; pw[T].a4i = p4[1]; pw[T].a8r = p8[0]; pw[T].a8i = p8[1]; gr[T] = gq[0]; gi[T] = gq[1];
            const size_t sidx = ((size_t)((b * 64 + grp) * 16 + c) * 64 + p) * 2; cr[T] = CAR[sidx]; ci[T] = CAR[sidx + 1]; }
        float dsk[4];
#pragma unroll
        for (int i = 0; i < 4; ++i) dsk[i] = P.d_skip[grp * 16 + 4 * g4 + i];
        LDS_WAIT();
        const bf16* ub = PROJ + ((size_t)b * SEQ + c * 1024 + li) * NPROJ + PU + grp * 16;
        v4u un0 = {0u, 0u, 0u, 0u}, un1 = {0u, 0u, 0u, 0u};
        if (g4 < 2) { un0 = *(const v4u*)(ub + 8 * g4); un1 = *(const v4u*)(ub + (size_t)16 * NPROJ + 8 * g4); }
        v2u us0 = *(const v2u*)(ub + 4 * g4), us1 = *(const v2u*)(ub + (size_t)16 * NPROJ + 4 * g4);
#pragma unroll 1
        for (int tt = 0; tt < 64; ++tt) {
            const v4u uv = un0; const v2u us = us0; un0 = un1; us0 = us1;
            { const int t2 = tt + 2 < 64 ? tt + 2 : 63; const bf16* u2 = ub + (size_t)t2 * 16 * NPROJ; if (g4 < 2) un1 = *(const v4u*)(u2 + 8 * g4); us1 = *(const v2u*)(u2 + 4 * g4); }
            const s16x8 uf = __builtin_bit_cast(s16x8, uv);
            f32x4 dre4[4], dim4[4];
#pragma unroll
            for (int T = 0; T < 4; ++T) { const f32x4 z4 = {0.f, 0.f, 0.f, 0.f};
                dre4[T] = __builtin_amdgcn_mfma_f32_16x16x32_bf16(uf, __builtin_bit_cast(s16x8, bl[T * 64 + lane]), z4, 0, 0, 0); dim4[T] = __builtin_amdgcn_mfma_f32_16x16x32_bf16(uf, __builtin_bit_cast(s16x8, bl[(4 + T) * 64 + lane]), z4, 0, 0, 0); }
            asm volatile("s_nop 7\n\ts_nop 3" : "+v"(dre4[0]), "+v"(dim4[0]), "+v"(dre4[1]), "+v"(dim4[1]), "+v"(dre4[2]), "+v"(dim4[2]), "+v"(dre4[3]), "+v"(dim4[3]));
#pragma unroll
            for (int T = 0; T < 4; ++T) { const f32x4 dre = dre4[T], dim = dim4[T];
                const float a_r = pw[T].ar, a_i = pw[T].ai;
                float xr[4], xi[4]; xr[0] = dre[0]; xi[0] = dim[0];
#pragma unroll
                for (int i = 1; i < 4; ++i) { CFMA(xr[i], xi[i], a_r, a_i, xr[i - 1], xi[i - 1], dre[i], dim[i]); }
                float er = xr[3], ei = xi[3];
                { float sr = bperm_f(au16, er), si = bperm_f(au16, ei); if (g4 < 1) { sr = 0.f; si = 0.f; } float nr, ni; CFMA(nr, ni, pw[T].a4r, pw[T].a4i, sr, si, er, ei); er = nr; ei = ni; }
                { float sr = bperm_f(au32, er), si = bperm_f(au32, ei); if (g4 < 2) { sr = 0.f; si = 0.f; } float nr, ni; CFMA(nr, ni, pw[T].a8r, pw[T].a8i, sr, si, er, ei); er = nr; ei = ni; }
                float mr = bperm_f(au16, er), mi = bperm_f(au16, ei); if (g4 < 1) { mr = 0.f; mi = 0.f; }
                float tr, ti; CFMA(tr, ti, gr[T], gi[T], cr[T], ci[T], mr, mi);
#pragma unroll
                for (int i = 0; i < 4; ++i) { float nr, ni; CFMA(nr, ni, a_r, a_i, tr, ti, zf, zf); tr = nr; ti = ni; xr[i] = aadd(xr[i], tr); xi[i] = aadd(xi[i], ti); }
                cr[T] = bperm_f(ab3, xr[3]); ci[T] = bperm_f(ab3, xi[3]);
                v2u wre, wim; wre.x = cvt_pk_bf16(xr[0], xr[1]); wre.y = cvt_pk_bf16(xr[2], xr[3]); wim.x = cvt_pk_bf16(xi[0], xi[1]); wim.y = cvt_pk_bf16(xi[2], xi[3]);
                *(LAS v2u*)(xt + (16 * T + li) * 32 + g4 * 8) = wre; *(LAS v2u*)(xt + (64 + 16 * T + li) * 32 + g4 * 8) = wim; }
            f32x4 y = {0.f, 0.f, 0.f, 0.f};
#pragma unroll
            for (int ks = 0; ks < 4; ++ks) { const s16x4 lo = tr_read4(xt + (32 * ks + 8 * g4 + (li >> 2)) * 32 + (li & 3) * 8), hi = tr_read4(xt + (32 * ks + 8 * g4 + 4 + (li >> 2)) * 32 + (li & 3) * 8);
                const s16x8 xf = {lo[0], lo[1], lo[2], lo[3], hi[0], hi[1], hi[2], hi[3]};
                y = __builtin_amdgcn_mfma_f32_16x16x32_bf16(__builtin_bit_cast(s16x8, cl[ks * 64 + lane]), xf, y, 0, 0, 0); }
            const float u4[4] = {bflo(us.x), bfhi(us.x), bflo(us.y), bfhi(us.y)};
            float z[4];
#pragma unroll
            for (int i = 0; i < 4; ++i) z[i] = gelu_tanh_f(y[i] + dsk[i] * u4[i]);
            v2u zo; zo.x = cvt_pk_bf16(z[0], z[1]); zo.y = cvt_pk_bf16(z[2], z[3]);
            *(v2u*)(Zb + ((size_t)b * SEQ + c * 1024 + tt * 16 + li) * 1024 + grp * 16 + 4 * g4) = zo;
        }
        LDS_WAIT();
    }
}
#ifndef PH_MASK
#define PH_MASK 0x1FFF
#endif
#define PHEN(k) (((PH_MASK) >> (k)) & 1)
#ifndef DUP_MASK
#define DUP_MASK 0
#endif
#define NREP(k) ((((DUP_MASK) >> (k)) & 1) ? 2 : 1)
#ifndef SUB_MASK
#define SUB_MASK 0
#endif
#define SUBREP(k) for (int srep = 0; srep < ((((SUB_MASK) >> (k)) & 1) ? 2 : 1); ++srep)
__device__ unsigned g_ctl[2 * (XCD_BAR_WORDS + 64) + 64];
struct Args { const float* in[26]; float* out; unsigned char* ws; int ph_lo, ph_hi; };
__global__ void __launch_bounds__(NTHR, 2) fwd_kernel(Args args) {
    extern __shared__ __attribute__((aligned(16))) unsigned char lds_raw[];
    LAS unsigned char* lds = (LAS unsigned char*)lds_raw;
    volatile LAS unsigned* MISC = (volatile LAS unsigned*)(lds + MISC_OFF);
#define PHASE_IDS() PHASE_PTRS(); int tid = threadIdx.x; asm volatile("" : "+v"(tid)); const int lane = tid & 63, wave = __builtin_amdgcn_readfirstlane(tid >> 6); \
    const int gw = bx * NWAVES + wave, NGW = G * NWAVES, gtid = bx * NTHR + tid, NGT = G * NTHR; (void)lane; (void)gw; (void)NGW; (void)gtid; (void)NGT
#define PHASE_PTRS() int zq = 0, G = gridDim.x, bx = blockIdx.x; asm volatile("" : "+s"(zq), "+s"(G), "+s"(bx)); const __attribute__((address_space(4))) unsigned long long* kargs = (const __attribute__((address_space(4))) unsigned long long*)__builtin_amdgcn_kernarg_segment_ptr(); \
    unsigned char* ws = (unsigned char*)(GAS unsigned char*)kargs[27 + zq]; float* X = (float*)(GAS float*)kargs[26 + zq]; (void)ws; (void)X
#define ARG(k) ((const float*)(const GAS float*)kargs[(k) + zq])
    for (int u = threadIdx.x; u < LDS_BYTES / 16; u += NTHR) ((LAS v4u*)lds)[u] = (v4u){0u, 0u, 0u, 0u};
    __syncthreads();
    { unsigned* gctl = (unsigned*)(GAS unsigned*)g_ctl;
      if (threadIdx.x == 0) MISC[16] = (xb_add(gctl + 2 * (XCD_BAR_WORDS + 64), 1u) / gridDim.x) & 1u;
      __syncthreads();
      const unsigned bsel = (unsigned)__builtin_amdgcn_readfirstlane((int)MISC[16]);
      (void)xcd_barrier_post(gctl + bsel * (XCD_BAR_WORDS + 64), MISC + 8); }
#define GRID_BARRIER() do { XcdBarrier b_; unsigned* gp_ = (unsigned*)(GAS unsigned*)g_ctl; asm volatile("" : "+s"(gp_)); b_.bar = gp_ + (unsigned)__builtin_amdgcn_readfirstlane((int)MISC[16]) * (XCD_BAR_WORDS + 64); b_.x = xb_xcc_id(); b_.st = MISC + 8; xcd_barrier(b_); } while (0)
    const int lo = args.ph_lo, hi = args.ph_hi;
#ifndef START_HOLD
#define START_HOLD 0
#endif
    if (hi - lo > 1) { for (int dl = 0; dl < START_HOLD; ++dl) __builtin_amdgcn_s_sleep(127); }
#define IN(k) (lo <= (k) && (k) < hi)
#define SEAM(k) do { if (IN(k) && IN((k) + 1)) GRID_BARRIER(); } while (0)

#define XN ((bf16*)(ws + WS_XN))
#define PROJ ((bf16*)(ws + WS_PROJ))
#define HID ((bf16*)(ws + WS_PROJ))
#define QKC ((bf16*)(ws + WS_QKC))
#define MIX ((bf16*)(ws + WS_QKC))
#define HM ((float*)(ws + WS_HM))
#define Y ((bf16*)(ws + WS_Y))
#define Z ((bf16*)(ws + WS_Z))
#define LOFF ((size_t)l * SMALL_STRIDE)
#define IFG ((float*)(ws + WS_IFG + LOFF))
#define S5LOC ((float*)(ws + WS_S5LOC + LOFF))
#define S5CAR ((float*)(ws + WS_S5CAR + LOFF))

    for (int l = 0; l < DEPTH; ++l) {
        const int pb = l * NPH;

        if (PHEN(0) && IN(pb + 0)) for (int rep = 0; rep < NREP(0); ++rep) {
            PHASE_IDS();
            { S5P_MAKE(sp, l); s5_disc_phase(sp, (f32x4*)(ws + WS_DISC + LOFF), gtid); }
            wconv_phase(ARG(2) + (size_t)l * DM * N_IN, ARG(17) + (size_t)l * 1024 * 2048, ARG(18) + (size_t)l * 1024 * DM, ARG(19) + (size_t)l * 1024 * DM,
                        ARG(20) + (size_t)l * 1024 * DM, ARG(21) + (size_t)l * DM * DM, ARG(23) + (size_t)l * DM * FF, ARG(24) + (size_t)l * FF * DM, ARG(22) + (size_t)l * DM, ws, lds, gw, NGW, wave, lane);
            __syncthreads();
            { LAS float* IFW = (LAS float*)lds; const float* src = ARG(2) + (size_t)l * DM * N_IN + 4096;
              for (int i = tid; i < DM * 8; i += NTHR) IFW[i] = src[(size_t)(i >> 3) * N_IN + (i & 7)];
              __syncthreads();
              norm_phase<true>((l == 0) ? ARG(0) : (const float*)X, ARG(1) + (size_t)l * DM, XN, IFW, ARG(5) + l * 4, ARG(6) + l * 4, IFG, gw, NGW, lane);
              __syncthreads(); }
        }
        SEAM(pb + 0);
        if (l == 0 && IN(0) && IN(1) && blockIdx.x == 0) { const unsigned bsel = (unsigned)__builtin_amdgcn_readfirstlane((int)MISC[16]); unsigned* gp_ = (unsigned*)(GAS unsigned*)g_ctl; asm volatile("" : "+s"(gp_)); unsigned* other = gp_ + (bsel ^ 1u) * (XCD_BAR_WORDS + 64);
            int tz = threadIdx.x; asm volatile("" : "+v"(tz));
            for (int u = tz; u < XCD_BAR_WORDS + 64; u += NTHR) __hip_atomic_store(other + u, 0u, __ATOMIC_RELAXED, __HIP_MEMORY_SCOPE_AGENT); }
        if (PHEN(1) && IN(pb + 1)) for (int rep = 0; rep < NREP(1); ++rep) {
            PHASE_PTRS();
            pg8::Gemm g{XN, (const bf16*)(ws + WS_WIN), M, NPROJ, DM, DM, DM}; pg8::StaticOrder S; S.init(M, NPROJ, G, bx);
            EpiProj E{PROJ};
            pg8::gemm_phase<EpiProj, pg8::StaticOrder>(lds, g, S, E);
        }
        SEAM(pb + 1);
        if (PHEN(2) && IN(pb + 2)) for (int rep = 0; rep < NREP(2); ++rep) {
            PHASE_IDS();
            S5P_MAKE(sp, l);
            SUBREP(0) mconv_phase(PROJ, ARG(3) + (size_t)l * 4 * 2048, ARG(4) + (size_t)l * 2048, QKC, gtid, NGT);
            SUBREP(1) s5a_ls_phase(sp, (const f32x4*)(ws + WS_DISC + LOFF), PROJ, S5LOC, lds + wave * S5_WLDS, gw, NGW, lane);
        }
        SEAM(pb + 2);
        if (PHEN(3) && IN(pb + 3)) for (int rep = 0; rep < NREP(3); ++rep) {
            PHASE_IDS();
            S5P_MAKE(sp, l);
            SUBREP(2) mlstm_a1_phase(QKC, PROJ, IFG, (bf16*)(ws + WS_CST), (float*)(ws + WS_MF + LOFF), lds, bx, G, tid);
            SUBREP(3) s5_carry_phase((const f32x4*)(ws + WS_DISC + LOFF), S5LOC, S5CAR, gtid, NGT);
        }
        SEAM(pb + 3);
        if (PHEN(4) && IN(pb + 4)) for (int rep = 0; rep < NREP(4); ++rep) { PHASE_IDS(); mlstm_a2_phase((const bf16*)(ws + WS_CST), (bf16*)(ws + WS_CIN), (const float*)(ws + WS_MF + LOFF), gtid, NGT); }
        SEAM(pb + 4);
        if (PHEN(5) && IN(pb + 5)) for (int rep = 0; rep < NREP(5); ++rep) {
            PHASE_IDS();
            S5P_MAKE(sp, l);
            SUBREP(4) { mlstm_a3_phase(QKC, PROJ, IFG, (const bf16*)(ws + WS_CIN), ARG(7) + (size_t)l * 1024, Y, lds, bx, G, tid);
            __syncthreads(); }
            SUBREP(5) { attn_mfma_phase(PROJ, ARG(8), (bf16*)(ws + WS_ATT), (float*)(ws + WS_LSE + LOFF), lds, bx, G, tid);
            __syncthreads(); }
            SUBREP(6) { s5c_ls_phase(sp, (const f32x4*)(ws + WS_DISC + LOFF), PROJ, S5CAR, Z, lds + wave * S5_WLDS, gw, NGW, lane);
            __syncthreads(); }
        }
        SEAM(pb + 5);
        if (PHEN(6) && IN(pb + 6)) for (int rep = 0; rep < NREP(6); ++rep) {
            SUBREP(7) { PHASE_IDS(); attn_merge_phase((const bf16*)(ws + WS_ATT), (const float*)(ws + WS_LSE + LOFF), Y + 1024, gw, NGW, lane); }
            PHASE_PTRS();
            pg8::Gemm g{Z, (const bf16*)(ws + WS_WGLU), M, 2048, 1024, 1024, 1024}; pg8::StaticOrder S; S.init(M, 2048, G, bx);
            EpiGlu E{Y + 2048, 3072};
            pg8::gemm_phase<EpiGlu, pg8::StaticOrder>(lds, g, S, E);
        }
        SEAM(pb + 6);
        if (PHEN(7) && IN(pb + 7)) for (int rep = 0; rep < NREP(7); ++rep) {
            PHASE_PTRS();
            pg8::Gemm g{Y, (const bf16*)(ws + WS_WBR), M, DM, 3072, 3072, 3072}; pg8::StaticOrder S; S.init(M, DM, G, bx);
            EpiMerge E{PROJ + PG, MIX};
            pg8::gemm_phase<EpiMerge, pg8::StaticOrder>(lds, g, S, E);
        }
        SEAM(pb + 7);
        if (PHEN(8) && IN(pb + 8)) {
            PHASE_PTRS();
            pg8::Gemm g{MIX, (const bf16*)(ws + WS_WOUT), M, DM, DM, DM, DM}; pg8::StaticOrder S; S.init(M, DM, G, bx);
            EpiResidT<true> E{(l == 0) ? ARG(0) : (const float*)X, X, 1.0f};
            pg8::gemm_phase<EpiResidT<true>, pg8::StaticOrder>(lds, g, S, E);
        }
        SEAM(pb + 8);
        if (PHEN(9) && IN(pb + 9)) { PHASE_IDS();
            const f32x4* pp = (const f32x4*)(GAS const f32x4*)(ws + WS_Y); float* rsd = (float*)(GAS float*)(ws + WS_Y + 8 * MiB);
            for (int m = gtid; m < M; m += NGT) { f32x4 a = pp[(size_t)m * 8];
#pragma unroll
                for (int j = 1; j < 8; ++j) a += pp[(size_t)m * 8 + j];
                rsd[m] = 1.0f / sqrtf(((a[0] + a[1]) + (a[2] + a[3])) * (1.0f / DM) + NORM_EPS); } }
        SEAM(pb + 9);
        if (PHEN(10) && IN(pb + 10)) for (int rep = 0; rep < NREP(10); ++rep) {
            PHASE_PTRS();
            pg8::Gemm g{XN, (const bf16*)(ws + WS_W1), M, FF, DM, DM, DM}; pg8::StaticOrder S; S.init(M, FF, G, bx);
            EpiFF1 E{HID, (const float*)(GAS const float*)(ws + WS_Y + 8 * MiB)};
            pg8::gemm_phase<EpiFF1, pg8::StaticOrder>(lds, g, S, E);
        }
        SEAM(pb + 10);
        if (PHEN(11) && IN(pb + 11)) {
            PHASE_PTRS();
            pg8::Gemm g{HID, (const bf16*)(ws + WS_W2), M, DM, FF, FF, FF}; pg8::StaticOrder S; S.init(M, DM, G, bx);
            EpiResid E{X, X, ABL_SF};
            pg8::gemm_phase<EpiResid, pg8::StaticOrder>(lds, g, S, E);
        }
        SEAM(pb + 11);
    }
    if (PHEN(12) && IN(DEPTH * NPH)) {
        PHASE_IDS();
        const float* gain = ARG(25);
        f32x4 gv[8];
#pragma unroll
        for (int j = 0; j < 8; ++j) gv[j] = *(const f32x4*)(gain + 4 * lane + 256 * j);
        for (int m = gw; m < M; m += NGW) {
            f32x4* xr = (f32x4*)(X + (size_t)m * DM) + lane;
            f32x4 v[8]; float ss = 0.f;
#pragma unroll
            for (int j = 0; j < 8; ++j) { v[j] = xr[64 * j]; ss += (v[j].x * v[j].x + v[j].y * v[j].y) + (v[j].z * v[j].z + v[j].w * v[j].w); }
            const float rstd = 1.0f / sqrtf(wave_sum(ss) * (1.0f / DM) + NORM_EPS);
#pragma unroll
            for (int j = 0; j < 8; ++j) xr[64 * j] = (v[j] * rstd) * gv[j];
        }
    }
#undef IN
#undef SEAM
}

extern "C" void kernel_launch(void* const* d_in, const int* in_sizes, int n_in, void* d_out, int out_size, void* d_ws, size_t ws_size, hipStream_t stream) {
    static int grid = 0;
    if (grid == 0) {
        if (n_in != 26 || in_sizes[0] != M * DM || out_size != M * DM || ws_size < WS_END) { fprintf(stderr, "kernel_launch: unexpected shapes (n_in %d, in0 %d, out %d, ws %zu); nothing launched\n", n_in, n_in > 0 ? in_sizes[0] : -1, out_size, ws_size); grid = -1; return; }
        int dev = 0, cus = 0, per_cu = 0;
        if (hipGetDevice(&dev) != hipSuccess || hipDeviceGetAttribute(&cus, hipDeviceAttributeMultiprocessorCount, dev) != hipSuccess) { grid = -1; return; }
        if (hipFuncSetAttribute((const void*)fwd_kernel, hipFuncAttributeMaxDynamicSharedMemorySize, LDS_BYTES) != hipSuccess) { fprintf(stderr, "kernel_launch: hipFuncSetAttribute failed\n"); grid = -1; return; }
        if (hipOccupancyMaxActiveBlocksPerMultiprocessor(&per_cu, (const void*)fwd_kernel, NTHR, LDS_BYTES) != hipSuccess || per_cu < 1) fprintf(stderr, "kernel_launch: occupancy query reports %d\n", per_cu);
        (void)hipGetLastError();
        grid = cus;
    }
    if (grid < 0) return;
    Args a{};
    for (int i = 0; i < 26; ++i) a.in[i] = (const float*)d_in[i];
    a.out = (float*)d_out; a.ws = (unsigned char*)d_ws;
#if MK_SPLIT
    for (int p = 0; p < NPHASES; ++p) { a.ph_lo = p; a.ph_hi = p + 1; hipLaunchKernelGGL(fwd_kernel, dim3(grid), dim3(NTHR), LDS_BYTES, stream, a); }
#else
    a.ph_lo = 0; a.ph_hi = NPHASES;
    hipLaunchKernelGGL(fwd_kernel, dim3(grid), dim3(NTHR), LDS_BYTES, stream, a);
#endif
    const hipError_t le = hipPeekAtLastError();
    if (le != hipSuccess) fprintf(stderr, "kernel_launch: launch failed: %s\n", hipGetErrorName(le));
}
```

```cpp
#include <hip/hip_runtime.h>
#include <cstdio>
#include <cstdint>
namespace pg8 {
#define PG8_LAS __attribute__((address_space(3)))
typedef unsigned short bf16_t;
typedef short bf16x8 __attribute__((ext_vector_type(8)));
typedef float f32x4 __attribute__((ext_vector_type(4)));
typedef unsigned u32x4 __attribute__((ext_vector_type(4)));
constexpr int BM = 256, BK = 64, HALF = 128, HTB = HALF * BK * 2  , STAGE_BYTES = 8 * HTB, NXCD = 8, WGM = 4;

__host__ __device__ __forceinline__ int lds_byte(int r, int c) { const int st = (r >> 4) * 2 + (c >> 5), rr = r & 15, cc = c & 31, ob = rr * 64 + cc * 2; return st * 1024 + (ob ^ (((ob >> 9) & 1) << 5)); }
__host__ __device__ __forceinline__ void stage_rc(int b, int& R, int& C) { const int st = b / 1024, sb = b % 1024, swz = sb ^ (((sb >> 9) & 1) << 5); R = (st >> 1) * 16 + swz / 64; C = (st & 1) * 32 + (swz % 64) / 2; }
__host__ __device__ __forceinline__ int perm32(int rho) { const int n = rho >> 4, i = rho & 15; return 8 * (i >> 2) + 4 * n + (i & 3); }

struct Unit { int pm, pn; };
struct Gemm { const bf16_t* A; const bf16_t* Bt; int M, N, K, lda, ldb; };

struct StaticOrder {
    int nM, nN, nwg, G, c;
    __host__ __device__ void init(int M, int N, int G_, int c_) { nM = M / BM; nN = N / BM; nwg = nM * nN; G = G_; c = c_; }
    __host__ __device__ bool next(int i, Unit& u) const {
        const long L = (long)i * G + c; if (L >= nwg) return false;
        int wgid = (int)L; { const int q = nwg / NXCD, r = nwg % NXCD, xcd = wgid % NXCD, off = wgid / NXCD; wgid = (xcd < r ? xcd * (q + 1) : r * (q + 1) + (xcd - r) * q) + off; }
        const int nig = WGM * nN, gid = wgid / nig, fm = gid * WGM, gsz = (nM - fm) < WGM ? (nM - fm) : WGM;
        u.pm = fm + ((wgid % nig) % gsz); u.pn = (wgid % nig) / gsz; return true;
    }
    __device__ __forceinline__ void a_ready(const Unit&) const {}
    __device__ __forceinline__ void done(const Unit&) const {}
};

typedef __bf16 bf16x2_t __attribute__((ext_vector_type(2)));
typedef float f32x2_t __attribute__((ext_vector_type(2)));
__device__ __forceinline__ unsigned cvt_pk_bf16(float lo, float hi) { const f32x2_t v = {lo, hi}; const bf16x2_t r = __builtin_convertvector(v, bf16x2_t); return __builtin_bit_cast(unsigned, r); }

template <class Epi, class Sched, bool ALIGN_EPI = true>
__device__ __forceinline__ void gemm_phase(PG8_LAS unsigned char* lds, const Gemm g, const Sched& S, const Epi& E) {
    int tid = threadIdx.x; asm volatile("" : "+v"(tid));
    const int wid = __builtin_amdgcn_readfirstlane(tid >> 6), lane = tid & 63, wr = wid >> 2, wc = wid & 3, fr = lane & 15, fq = lane >> 4;
    const int nt = g.K / BK;
    unsigned voffA[2], voffB[2];
#pragma unroll
    for (int i = 0; i < 2; ++i) { int R, C; stage_rc(tid * 16 + i * 8192, R, C); const int Rb = Epi::PERM ? ((R & ~31) + perm32(R & 31)) : R;
        voffA[i] = (unsigned)(R * g.lda + C) * 2u; voffB[i] = (unsigned)(Rb * g.ldb + C) * 2u; }
    const size_t kstep = (size_t)(BK * 2);
    const size_t hstepA = (size_t)HALF * g.lda * 2, hstepB = (size_t)HALF * g.ldb * 2;
    const size_t tstepA = 2 * hstepA, tstepB = 2 * hstepB;
    const unsigned ldsw = (unsigned)wid * 1024u;
    const int aoff = lds_byte(wr * 64 + fr, fq * 8), boff = lds_byte(wc * 32 + fr, fq * 8);
#define PG8_SA(b, h) (((b) * 2 + (h)) * HTB)
#define PG8_SB(b, h) ((4 + (b) * 2 + (h)) * HTB)
#define PG8_STAGE(bufoff, gbase, voff) do { _Pragma("unroll") for (int _i = 0; _i < 2; ++_i) \
        __builtin_amdgcn_global_load_lds((const unsigned*)((const char*)(gbase) + (voff)[_i]), (PG8_LAS unsigned*)(lds + (bufoff) + ldsw + _i * 8192), 16, 0, 0); } while (0)
#define PG8_LDA(dst, b, h) do { _Pragma("unroll") for (int m = 0; m < 4; ++m) _Pragma("unroll") for (int k = 0; k < 2; ++k) dst[m][k] = *(const PG8_LAS bf16x8*)(lds + PG8_SA(b, h) + aoff + m * 2048 + k * 1024); } while (0)
#define PG8_LDB(dst, b, h) do { _Pragma("unroll") for (int n = 0; n < 2; ++n) _Pragma("unroll") for (int k = 0; k < 2; ++k) dst[n][k] = *(const PG8_LAS bf16x8*)(lds + PG8_SB(b, h) + boff + n * 2048 + k * 1024); } while (0)
#define PG8_MMA(ai, bj, At, Bt) do { __builtin_amdgcn_s_setprio(1); _Pragma("unroll") for (int m = 0; m < 4; ++m) _Pragma("unroll") for (int n = 0; n < 2; ++n) _Pragma("unroll") for (int k = 0; k < 2; ++k) \
        acc[ai][bj][m][n] = __builtin_amdgcn_mfma_f32_16x16x32_bf16(Bt[n][k], At[m][k], acc[ai][bj][m][n], 0, 0, 0); __builtin_amdgcn_s_setprio(0); } while (0)
#define PG8_WAIT_V(n) asm volatile("s_waitcnt vmcnt(" #n ")" ::: "memory")
#define PG8_WAIT_L(n) asm volatile("s_waitcnt lgkmcnt(" #n ")" ::: "memory")
#define PG8_BAR __builtin_amdgcn_s_barrier()
#define PG8_SCHED __builtin_amdgcn_sched_barrier(0)
    Unit cur, nxt; int ui = 0;
    if (!S.next(0, cur)) return;
    f32x4 acc[2][2][4][2];
#pragma unroll
    for (int a = 0; a < 2; ++a)
#pragma unroll
        for (int b = 0; b < 2; ++b)
#pragma unroll
            for (int m = 0; m < 4; ++m)
#pragma unroll
                for (int n = 0; n < 2; ++n) acc[a][b][m][n] = (f32x4){0.f, 0.f, 0.f, 0.f};
    bf16x8 At[4][2], B0[2][2], B1[2][2];
    const char* cA = (const char*)g.A + (size_t)cur.pm * tstepA; const char* cB = (const char*)g.Bt + (size_t)cur.pn * tstepB;
    S.a_ready(cur);
    PG8_STAGE(PG8_SB(0, 0), cB, voffB); PG8_STAGE(PG8_SB(0, 1), cB + hstepB, voffB); PG8_STAGE(PG8_SA(0, 0), cA, voffA); PG8_STAGE(PG8_SA(0, 1), cA + hstepA, voffA);
    if (wr == 1) PG8_BAR;
    PG8_WAIT_V(2); PG8_BAR;
    PG8_STAGE(PG8_SB(1, 0), cB + kstep, voffB); PG8_STAGE(PG8_SA(1, 0), cA + kstep, voffA); PG8_STAGE(PG8_SB(1, 1), cB + hstepB + kstep, voffB);
    PG8_WAIT_V(6); PG8_BAR;
    for (;;) {
        const bool has_next = S.next(ui + 1, nxt);
        const char* nA = has_next ? (const char*)g.A + (size_t)nxt.pm * tstepA : cA; const char* nB = has_next ? (const char*)g.Bt + (size_t)nxt.pn * tstepB : cB;
        for (int t = 0; t < nt; t += 2) {
            const bool last = (t == nt - 2);
            const char* a1 = cA + (size_t)(t + 1) * kstep;
            const char* a2 = last ? nA : cA + (size_t)(t + 2) * kstep; const char* b2 = last ? nB : cB + (size_t)(t + 2) * kstep;
            const char* a3 = a2 + kstep; const char* b3 = b2 + kstep;
            if (last && has_next) S.a_ready(nxt);
            if constexpr (Epi::MIDK) { if (t == 16 || t == 32) E.mid(acc, cur, t, wr, wc, fr, fq); }
            PG8_LDB(B0, 0, 0); PG8_LDB(B1, 0, 1); PG8_SCHED; PG8_LDA(At, 0, 0); PG8_STAGE(PG8_SA(1, 1), a1 + hstepA, voffA);
            PG8_WAIT_V(8); PG8_WAIT_L(0); PG8_BAR; PG8_MMA(0, 0, At, B0); PG8_MMA(0, 1, At, B1); PG8_BAR; PG8_SCHED;
            PG8_LDA(At, 0, 1); PG8_STAGE(PG8_SB(0, 0), b2, voffB); PG8_STAGE(PG8_SB(0, 1), b2 + hstepB, voffB); PG8_STAGE(PG8_SA(0, 0), a2, voffA);
            PG8_WAIT_V(8); PG8_WAIT_L(0); PG8_BAR; PG8_MMA(1, 0, At, B0); PG8_MMA(1, 1, At, B1); PG8_BAR; PG8_SCHED;
            PG8_LDB(B0, 1, 0); PG8_LDB(B1, 1, 1); PG8_SCHED; PG8_LDA(At, 1, 0); PG8_STAGE(PG8_SA(0, 1), a2 + hstepA, voffA);
            PG8_WAIT_V(8); PG8_WAIT_L(0); PG8_BAR; PG8_MMA(0, 0, At, B0); PG8_MMA(0, 1, At, B1); PG8_BAR; PG8_SCHED;
            PG8_LDA(At, 1, 1); PG8_STAGE(PG8_SB(1, 0), b3, voffB); PG8_STAGE(PG8_SB(1, 1), b3 + hstepB, voffB); PG8_STAGE(PG8_SA(1, 0), a3, voffA);
            PG8_WAIT_V(8); PG8_WAIT_L(0); PG8_BAR; PG8_MMA(1, 0, At, B0); PG8_MMA(1, 1, At, B1); PG8_BAR; PG8_SCHED;
        }
        if constexpr (ALIGN_EPI) { if (wr == 0) PG8_BAR; }
        E(acc, cur, wr, wc, fr, fq); S.done(cur);
        if (!has_next) break;
#pragma unroll
        for (int a = 0; a < 2; ++a)
#pragma unroll
            for (int b = 0; b < 2; ++b)
#pragma unroll
                for (int m = 0; m < 4; ++m)
#pragma unroll
                    for (int n = 0; n < 2; ++n) acc[a][b][m][n] = (f32x4){0.f, 0.f, 0.f, 0.f};
        cur = nxt; cA = nA; cB = nB; ++ui;
        if constexpr (ALIGN_EPI) { if (wr == 1) PG8_BAR; }
    }
    PG8_WAIT_V(0);
    if constexpr (!ALIGN_EPI) { if (wr == 0) PG8_BAR; }
    PG8_BAR;
#undef PG8_SA
#undef PG8_SB
#undef PG8_STAGE
#undef PG8_LDA
#undef PG8_LDB
#undef PG8_MMA
#undef PG8_WAIT_V
#undef PG8_WAIT_L
#undef PG8_BAR
#undef PG8_SCHED
}
}
constexpr int BATCH = 2, SEQ = 16384, DM = 2048, DEPTH = 4, M = BATCH * SEQ, FF = 8192;
constexpr int N_IN = 20488, NPROJ = 20480;
constexpr int PQ = 0, PK = 1024, PV = 2048, PO = 3072, PAQ = 4096, PAK = 7168, PAV = 10240, PU = 13312, PG = 14336;
constexpr float NORM_EPS = 1e-6f;
constexpr int NWAVES = 8, NTHR = 512;
constexpr int NPH = 12, NPHASES = DEPTH * NPH + 1;
#ifndef ABL_SA
#define ABL_SA 1.0f
#endif
#ifndef ABL_SB
#define ABL_SB 1.0f
#endif
#ifndef ABL_SC
#define ABL_SC 1.0f
#endif
#ifndef ABL_SM
#define ABL_SM 1.0f
#endif
#ifndef ABL_SF
#define ABL_SF 1.0f
#endif
#if defined(ABL_HOOKFREE_A)
#define ABL_FINAL_GATE 0
#else
#define ABL_FINAL_GATE 2
#endif
#ifndef MK_SPLIT
#define MK_SPLIT 0
#endif

constexpr size_t MiB = 1u << 20;
constexpr size_t WS_CTL = 0, CTL_ZERO_BYTES = 1 * MiB;
constexpr size_t WS_SMALL = 2424 * MiB, SMALL_STRIDE = 8 * MiB;
constexpr size_t WS_IFG = WS_SMALL;
constexpr size_t WS_S5LOC = WS_SMALL + 1 * MiB, WS_S5CAR = WS_SMALL + 2 * MiB;
constexpr size_t WS_WIN = 8 * MiB, WS_WGLU = 88 * MiB, WS_WBR = 92 * MiB, WS_WOUT = 104 * MiB, WS_W1 = 112 * MiB, WS_W2 = 144 * MiB;
constexpr size_t WS_XN = 176 * MiB;
constexpr size_t WS_PROJ = 304 * MiB;
constexpr size_t WS_QKC = 1584 * MiB;
constexpr size_t WS_HM = 1712 * MiB;
constexpr size_t WS_Y = 1712 * MiB;
constexpr size_t WS_Z = 1904 * MiB;
constexpr size_t WS_ATT = 1968 * MiB;
constexpr size_t WS_LSE = WS_SMALL + 4 * MiB;
constexpr size_t WS_CST = 2164 * MiB;
constexpr size_t WS_CIN = 2294 * MiB;
constexpr size_t WS_MF = WS_SMALL + 3 * MiB;
constexpr size_t WS_DISC = WS_SMALL + 3 * MiB + 512 * 1024;
constexpr size_t WS_END = 2456 * MiB;
constexpr int CW_BAR = 4096;

constexpr int RING_BYTES = 131072, MISC_OFF = 148480, LDS_BYTES = 149504;

#define GAS __attribute__((address_space(1)))
#define LAS __attribute__((address_space(3)))
typedef unsigned short bf16;
typedef unsigned v4u __attribute__((ext_vector_type(4)));
typedef unsigned v2u __attribute__((ext_vector_type(2)));
typedef float f32x4 __attribute__((ext_vector_type(4)));
typedef float f32x2 __attribute__((ext_vector_type(2)));
#define LDS_WAIT() asm volatile("s_waitcnt lgkmcnt(0)" ::: "memory")
__device__ __forceinline__ unsigned f2bf(float f) { unsigned u = __builtin_bit_cast(unsigned, f); return (u + 0x7fffu + ((u >> 16) & 1u)) >> 16; }
__device__ __forceinline__ unsigned pk2(float lo, float hi) { return f2bf(lo) | (f2bf(hi) << 16); }
__device__ __forceinline__ float bflo(unsigned u) { return __builtin_bit_cast(float, u << 16); }
__device__ __forceinline__ float bfhi(unsigned u) { return __builtin_bit_cast(float, u & 0xffff0000u); }
__device__ __forceinline__ float bf1(bf16 b) { return __builtin_bit_cast(float, (unsigned)b << 16); }
__device__ __forceinline__ float sigmoid_f(float v) { return __builtin_amdgcn_rcpf(1.0f + __builtin_amdgcn_exp2f(-1.44269504f * v)); }
__device__ __forceinline__ float wave_sum(float v) {
#pragma unroll
    for (int o = 1; o < 64; o <<= 1) v += __shfl_xor(v, o);
    return v;
}

#define XB_TMO      128
#define XB_XCNT(j)  (256  + 64 * (j))
#define XB_XSUB(j)  (1280 + 64 * (j))
#define XB_XGEN(j)  (2304 + 64 * (j))
#define XB_TOP      3328
#define XB_TOPGEN   3392
#define XCD_BAR_WORDS 3456
#define XB_SPIN_CAP (1u << 18)
__device__ __forceinline__ unsigned xb_ld(unsigned* p)              { return __hip_atomic_load(p, __ATOMIC_RELAXED, __HIP_MEMORY_SCOPE_AGENT); }
__device__ __forceinline__ unsigned xb_add(unsigned* p, unsigned v) { return __hip_atomic_fetch_add(p, v, __ATOMIC_RELAXED, __HIP_MEMORY_SCOPE_AGENT); }
__device__ __forceinline__ unsigned xb_xcc_id() { return (unsigned)__builtin_amdgcn_s_getreg((3 << 11) | 20) & 0xFu; }
#define XB_SPIN(cond, bar) do { unsigned _sp = 0; while (cond) { __builtin_amdgcn_s_sleep(1); \
    if ((++_sp & 255u) == 0u) { if (xb_ld(&(bar)[XB_TMO])) break; if (_sp > XB_SPIN_CAP) { atomicAdd(&(bar)[XB_TMO], 1u); break; } } } } while (0)
struct XcdBarrier { unsigned* bar; unsigned x; volatile LAS unsigned* st; };
__device__ __forceinline__ XcdBarrier xcd_barrier_post(unsigned* bar, volatile LAS unsigned* st) {
    XcdBarrier b; b.bar = bar; b.x = xb_xcc_id(); b.st = st;
    if (threadIdx.x == 0) (void)xb_add(&bar[XB_XCNT(b.x)], 1u);
    return b;
}
__device__ __forceinline__ void xcd_barrier_complete(unsigned* bar, unsigned x, unsigned& nloc, unsigned& nx) {
    const unsigned G = gridDim.x * gridDim.y * gridDim.z;
    unsigned sum, cnt, mine, sp = 0u;
    for (;;) {
        sum = 0u; cnt = 0u; mine = 0u;
#pragma unroll
        for (unsigned j = 0; j < 16; ++j) { const unsigned c = xb_ld(&bar[XB_XCNT(j)]); sum += c; cnt += (c > 0u) ? 1u : 0u; mine = (j == x) ? c : mine; }
        if (sum == G) break;
        __builtin_amdgcn_s_sleep(1);
        if ((++sp & 255u) == 0u) { if (xb_ld(&bar[XB_TMO])) break; if (sp > XB_SPIN_CAP) { atomicAdd(&bar[XB_TMO], 1u); break; } }
    }
    nloc = mine > 0u ? mine : 1u; nx = cnt > 0u ? cnt : 1u;
}
__device__ __forceinline__ void xcd_barrier(const XcdBarrier& b) {
    asm volatile("s_waitcnt vmcnt(0)" ::: "memory");
    __syncthreads();
    if (threadIdx.x == 0) {
        unsigned* bar = b.bar;
        __builtin_amdgcn_s_waitcnt(0);
        unsigned nloc = b.st[0], nx = b.st[1];
        if (nloc == 0u) { xcd_barrier_complete(bar, b.x, nloc, nx); b.st[0] = nloc; b.st[1] = nx; }
        const unsigned old = xb_add(&bar[XB_XSUB(b.x)], 1u);
        const unsigned gen = old / nloc;
        if (old + 1u == (gen + 1u) * nloc) {
            __builtin_amdgcn_fence(__ATOMIC_RELEASE, "agent");
            asm volatile("s_waitcnt vmcnt(0)" ::: "memory");
            const unsigned og = xb_add(&bar[XB_TOP], 1u);
            const unsigned tg = og / nx;
            if (og + 1u == (tg + 1u) * nx) xb_add(&bar[XB_TOPGEN], 1u);
            else XB_SPIN(xb_ld(&bar[XB_TOPGEN]) == tg, bar);
            __builtin_amdgcn_fence(__ATOMIC_ACQUIRE, "agent");
            xb_add(&bar[XB_XGEN(b.x)], 1u);
            asm volatile("s_waitcnt vmcnt(0)" ::: "memory");
        } else {
            XB_SPIN(xb_ld(&bar[XB_XGEN(b.x)]) == gen, bar);
            __builtin_amdgcn_fence(__ATOMIC_ACQUIRE, "agent");
            asm volatile("s_waitcnt vmcnt(0)" ::: "memory");
        }
    }
    __syncthreads();
}
using pg8::Unit; using pg8::cvt_pk_bf16;
#define EPI_ROWCOL_PERM() const int row0 = u.pm * 256 + wr * 64 + fr, colt = wc * 32 + 8 * fq
struct EpiProj {
    static constexpr bool PERM = true, MIDK = false;
    bf16* O;
    __device__ __forceinline__ void operator()(const f32x4 (&acc)[2][2][4][2], const Unit& u, int wr, int wc, int fr, int fq) const {
        EPI_ROWCOL_PERM();
        const bool sg = (u.pn >= 12 && u.pn < 16) || (u.pn >= 56);
#pragma unroll
        for (int ai = 0; ai < 2; ++ai)
#pragma unroll
            for (int m = 0; m < 4; ++m) { bf16* rowp = O + (size_t)(row0 + ai * 128 + m * 16) * NPROJ + u.pn * 256 + colt;
#pragma unroll
                for (int bj = 0; bj < 2; ++bj) { f32x4 v0 = acc[ai][bj][m][0], v1 = acc[ai][bj][m][1];
                    if (sg) {
#pragma unroll
                        for (int j = 0; j < 4; ++j) { v0[j] = sigmoid_f(v0[j]); v1[j] = sigmoid_f(v1[j]); } }
                    v4u w; w.x = cvt_pk_bf16(v0[0], v0[1]); w.y = cvt_pk_bf16(v0[2], v0[3]); w.z = cvt_pk_bf16(v1[0], v1[1]); w.w = cvt_pk_bf16(v1[2], v1[3]);
                    __builtin_nontemporal_store(w, (v4u*)(rowp + bj * 128)); } }
    }
};
struct EpiGlu {
    static constexpr bool PERM = true, MIDK = false;
    bf16* O; int ldc;
    __device__ __forceinline__ void operator()(const f32x4 (&acc)[2][2][4][2], const Unit& u, int wr, int wc, int fr, int fq) const {
        EPI_ROWCOL_PERM();
#pragma unroll
        for (int ai = 0; ai < 2; ++ai)
#pragma unroll
            for (int m = 0; m < 4; ++m) { bf16* rowp = O + (size_t)(row0 + ai * 128 + m * 16) * ldc + u.pn * 128 + colt;
                f32x4 v0 = acc[ai][0][m][0], v1 = acc[ai][0][m][1]; const f32x4 g0 = acc[ai][1][m][0], g1 = acc[ai][1][m][1];
#pragma unroll
                for (int j = 0; j < 4; ++j) { v0[j] *= sigmoid_f(g0[j]); v1[j] *= sigmoid_f(g1[j]); }
                v4u w; w.x = cvt_pk_bf16(v0[0], v0[1]); w.y = cvt_pk_bf16(v0[2], v0[3]); w.z = cvt_pk_bf16(v1[0], v1[1]); w.w = cvt_pk_bf16(v1[2], v1[3]);
                *(v4u*)rowp = w; }
    }
};
struct EpiMerge {
    static constexpr bool PERM = true, MIDK = true;
    const bf16* G; bf16* O;
    __device__ __forceinline__ void mid(f32x4 (&acc)[2][2][4][2], const Unit& u, int t, int wr, int wc, int fr, int fq) const {
        unsigned voff = (unsigned)(fr * NPROJ + wc * 32 + 8 * fq) * 2u; asm volatile("" : "+v"(voff));
        int pmz = u.pm; asm volatile("" : "+s"(pmz));
#if defined(ABL_HOOKFREE_A)
        return;
#endif
        const int br = (t >> 4) - 1;
        const char* ub = (const char*)G + ((size_t)(pmz * 256 + wr * 64) * NPROJ + br * 2048 + u.pn * 256) * 2;
#pragma unroll
        for (int ai = 0; ai < 2; ++ai)
#pragma unroll
            for (int m = 0; m < 4; ++m) { const char* rb = ub + (size_t)(ai * 128 + m * 16) * NPROJ * 2;
#pragma unroll
                for (int bj = 0; bj < 2; ++bj) { const v4u sp = *(const v4u*)(rb + bj * 256 + voff), sn = *(const v4u*)(rb + 4096 + bj * 256 + voff);
                    f32x4 r0, r1;
                    r0[0] = bflo(sp.x) * __builtin_amdgcn_rcpf(fmaxf(bflo(sn.x), 1e-30f)); r0[1] = bfhi(sp.x) * __builtin_amdgcn_rcpf(fmaxf(bfhi(sn.x), 1e-30f));
                    r0[2] = bflo(sp.y) * __builtin_amdgcn_rcpf(fmaxf(bflo(sn.y), 1e-30f)); r0[3] = bfhi(sp.y) * __builtin_amdgcn_rcpf(fmaxf(bfhi(sn.y), 1e-30f));
                    r1[0] = bflo(sp.z) * __builtin_amdgcn_rcpf(fmaxf(bflo(sn.z), 1e-30f)); r1[1] = bfhi(sp.z) * __builtin_amdgcn_rcpf(fmaxf(bfhi(sn.z), 1e-30f));
                    r1[2] = bflo(sp.w) * __builtin_amdgcn_rcpf(fmaxf(bflo(sn.w), 1e-30f)); r1[3] = bfhi(sp.w) * __builtin_amdgcn_rcpf(fmaxf(bfhi(sn.w), 1e-30f));
                    acc[ai][bj][m][0] *= r0; acc[ai][bj][m][1] *= r1; }
                if (m & 1) asm volatile("" ::: "memory"); }
    }
    __device__ __forceinline__ void operator()(const f32x4 (&acc)[2][2][4][2], const Unit& u, int wr, int wc, int fr, int fq) const {
        EPI_ROWCOL_PERM();
#pragma unroll
        for (int ai = 0; ai < 2; ++ai)
#pragma unroll
            for (int m = 0; m < 4; ++m) { const size_t row = (size_t)(row0 + ai * 128 + m * 16); const bf16* gp = G + row * NPROJ + ABL_FINAL_GATE * 2048 + u.pn * 256 + colt; bf16* op = O + row * 2048 + u.pn * 256 + colt;
#pragma unroll
                for (int bj = 0; bj < 2; ++bj) { const v4u sc = *(const v4u*)(gp + bj * 128); f32x4 v0 = acc[ai][bj][m][0], v1 = acc[ai][bj][m][1];
                    v0[0] *= bflo(sc.x); v0[1] *= bfhi(sc.x); v0[2] *= bflo(sc.y); v0[3] *= bfhi(sc.y); v1[0] *= bflo(sc.z); v1[1] *= bfhi(sc.z); v1[2] *= bflo(sc.w); v1[3] *= bfhi(sc.w);
                    v4u w; w.x = cvt_pk_bf16(v0[0], v0[1]); w.y = cvt_pk_bf16(v0[2], v0[3]); w.z = cvt_pk_bf16(v1[0], v1[1]); w.w = cvt_pk_bf16(v1[2], v1[3]);
                    *(v4u*)(op + bj * 128) = w; }
                asm volatile("" ::: "memory"); }
    }
};
template <bool WB>
struct EpiResidT {
    static constexpr bool PERM = false, MIDK = false;
    const float* base; float* out; float sc;
    __device__ __forceinline__ void operator()(const f32x4 (&acc)[2][2][4][2], const Unit& u, int wr, int wc, int fr, int fq) const {
        const int row0 = u.pm * 256 + wr * 64 + fr, col0 = u.pn * 256 + wc * 32 + 4 * fq;
        bf16* xbp = nullptr; float* partp = nullptr;
        if constexpr (WB) {
            const __attribute__((address_space(4))) unsigned long long* ka = (const __attribute__((address_space(4))) unsigned long long*)__builtin_amdgcn_kernarg_segment_ptr();
            unsigned char* wsb = (unsigned char*)(GAS unsigned char*)ka[27]; xbp = (bf16*)(wsb + WS_XN); partp = (float*)(wsb + WS_Y); }
#pragma unroll
        for (int ai = 0; ai < 2; ++ai)
#pragma unroll
            for (int m = 0; m < 4; ++m) { const size_t off = (size_t)(row0 + ai * 128 + m * 16) * DM + col0; float ss = 0.f;
#pragma unroll
                for (int bj = 0; bj < 2; ++bj)
#pragma unroll
                    for (int n = 0; n < 2; ++n) { const f32x4 bs = *(const f32x4*)(base + off + bj * 128 + n * 16); const f32x4 r = WB ? (bs + acc[ai][bj][m][n]) : (bs + sc * acc[ai][bj][m][n]); *(f32x4*)(out + off + bj * 128 + n * 16) = r;
                        if constexpr (WB) { v2u w; w.x = pk2(r[0], r[1]); w.y = pk2(r[2], r[3]); *(v2u*)(xbp + off + bj * 128 + n * 16) = w; ss += (r[0] * r[0] + r[1] * r[1]) + (r[2] * r[2] + r[3] * r[3]); } }
                if constexpr (WB) { ss += __shfl_xor(ss, 16); ss += __shfl_xor(ss, 32); if (fq == 0) partp[(size_t)(row0 + ai * 128 + m * 16) * 32 + u.pn * 4 + wc] = ss; }
                asm volatile("" ::: "memory"); }
    }
};
typedef EpiResidT<false> EpiResid;
struct EpiFF1 {
    static constexpr bool PERM = true, MIDK = false;
    bf16* O; const float* rstd;
    __device__ __forceinline__ void operator()(const f32x4 (&acc)[2][2][4][2], const Unit& u, int wr, int wc, int fr, int fq) const {
        EPI_ROWCOL_PERM();
#pragma unroll
        for (int ai = 0; ai < 2; ++ai)
#pragma unroll
            for (int m = 0; m < 4; ++m) { bf16* rowp = O + (size_t)(row0 + ai * 128 + m * 16) * FF + u.pn * 256 + colt; const float rs = rstd[row0 + ai * 128 + m * 16];
#pragma unroll
                for (int bj = 0; bj < 2; ++bj) { f32x4 v0 = acc[ai][bj][m][0], v1 = acc[ai][bj][m][1];
#pragma unroll
                    for (int j = 0; j < 4; ++j) { const float a = fmaxf(v0[j], 0.f) * rs, b = fmaxf(v1[j], 0.f) * rs; v0[j] = a * a; v1[j] = b * b; }
                    v4u w; w.x = cvt_pk_bf16(v0[0], v0[1]); w.y = cvt_pk_bf16(v0[2], v0[3]); w.z = cvt_pk_bf16(v1[0], v1[1]); w.w = cvt_pk_bf16(v1[2], v1[3]);
                    __builtin_nontemporal_store(w, (v4u*)(rowp + bj * 128)); } }
    }
};
__device__ const unsigned char T5B[3][129] = {
 {0,1,2,3,4,5,6,7,8,9,10,11,12,13,14,15,16,16,16,16,16,16,17,17,17,17,17,17,17,17,18,18,18,18,18,18,18,18,18,18,19,19,19,19,19,19,19,19,19,19,19,19,19,19,20,20,20,20,20,20,20,20,20,20,20,20,20,20,20,20,20,20,20,21,21,21,21,21,21,21,21,21,21,21,21,21,21,21,21,21,21,21,21,21,21,21,21,21,21,22,22,22,22,22,22,22,22,22,22,22,22,22,22,22,22,22,22,22,22,22,22,22,22,22,22,22,22,22,22},
 {0,4,8,12,16,16,17,17,18,18,19,19,19,19,20,20,20,20,20,21,21,21,21,21,21,22,22,22,22,22,22,22,22,22,23,23,23,23,23,23,23,23,23,23,23,23,24,24,24,24,24,24,24,24,24,24,24,24,24,24,24,24,25,25,25,25,25,25,25,25,25,25,25,25,25,25,25,25,25,25,25,25,25,26,26,26,26,26,26,26,26,26,26,26,26,26,26,26,26,26,26,26,26,26,26,26,26,26,26,26,26,26,26,27,27,27,27,27,27,27,27,27,27,27,27,27,27,27,27},
 {0,16,18,19,20,21,21,22,22,23,23,23,24,24,24,24,25,25,25,25,25,26,26,26,26,26,26,26,26,27,27,27,27,27,27,27,27,27,27,28,28,28,28,28,28,28,28,28,28,28,28,28,29,29,29,29,29,29,29,29,29,29,29,29,29,29,29,29,29,29,30,30,30,30,30,30,30,30,30,30,30,30,30,30,30,30,30,30,30,30,30,30,30,30,30,31,31,31,31,31,31,31,31,31,31,31,31,31,31,31,31,31,31,31,31,31,31,31,31,31,31,31,31,31,31,31,31,31,31}};

__device__ __forceinline__ void tr_item(const float* W, int ldw, int k0, int c0, bf16* WT, int ldt, int r0, int kd0, LAS float* scr, int lane) {
#pragma unroll 8
    for (int i = 0; i < 32; ++i) { const int kk = 2 * i + (lane >> 5); scr[kk * 33 + (lane & 31)] = W[(size_t)(k0 + kk) * ldw + c0 + (lane & 31)]; }
    LDS_WAIT(); asm volatile("" ::: "memory");
    const int c = lane & 7;
#pragma unroll
    for (int j = 0; j < 4; ++j) { const int n = (lane >> 3) + 8 * j; const LAS float* s = scr + (8 * c) * 33 + n;
        v4u o; o.x = pk2(s[0 * 33], s[1 * 33]); o.y = pk2(s[2 * 33], s[3 * 33]); o.z = pk2(s[4 * 33], s[5 * 33]); o.w = pk2(s[6 * 33], s[7 * 33]);
        *(v4u*)(WT + (size_t)(r0 + n) * ldt + kd0 + k0 + 8 * c) = o; }
    LDS_WAIT(); asm volatile("" ::: "memory");
}
__device__ __forceinline__ void tr_item64(const float* W, int ldw, int k0, int c0, bf16* WT, int ldt, int r0, int kd0, int lane, const float* kg = nullptr) {
    const int kq = lane >> 4, nq = lane & 15;
    const float* src = W + (size_t)(k0 + 16 * kq) * ldw + c0 + 4 * nq;
    f32x4 v[16];
#pragma unroll
    for (int j = 0; j < 16; ++j) v[j] = *(const f32x4*)(src + (size_t)j * ldw);
    if (kg) {
#pragma unroll
        for (int j = 0; j < 16; ++j) v[j] *= kg[k0 + 16 * kq + j]; }
    bf16* dst = WT + (size_t)(r0 + 4 * nq) * ldt + kd0 + k0 + 16 * kq;
#pragma unroll
    for (int e = 0; e < 4; ++e) { v4u o0, o1;
        o0.x = pk2(v[0][e], v[1][e]); o0.y = pk2(v[2][e], v[3][e]); o0.z = pk2(v[4][e], v[5][e]); o0.w = pk2(v[6][e], v[7][e]);
        o1.x = pk2(v[8][e], v[9][e]); o1.y = pk2(v[10][e], v[11][e]); o1.z = pk2(v[12][e], v[13][e]); o1.w = pk2(v[14][e], v[15][e]);
        *(v4u*)(dst + (size_t)e * ldt) = o0; *(v4u*)(dst + (size_t)e * ldt + 8) = o1; }
}
__device__ __forceinline__ void wconv_phase(const float* w_in, const float* w_glu, const float* w_a, const float* w_b, const float* w_c, const float* w_out, const float* w_1, const float* w_2, const float* g2, unsigned char* ws, LAS unsigned char* lds, int gw, int NGW, int wave, int lane) {
    bf16* WIN = (bf16*)(ws + WS_WIN); bf16* WGLU = (bf16*)(ws + WS_WGLU); bf16* WBR = (bf16*)(ws + WS_WBR); bf16* WOUT = (bf16*)(ws + WS_WOUT); bf16* W1 = (bf16*)(ws + WS_W1); bf16* W2 = (bf16*)(ws + WS_W2);
    constexpr int I_IN = 32 * 320, I_GLU = 16 * 32, I_BR = 16 * 32, I_OUT = 32 * 32, I_1 = 32 * 128, I_2 = 128 * 32;
    constexpr int NITEMS = I_IN + I_GLU + 3 * I_BR + I_OUT + I_1 + I_2;
    for (int it = gw; it < NITEMS; it += NGW) {
        int r = it;
        if (r < I_IN) { const int kb = r / 320, nb = r % 320, n0 = 64 * nb; tr_item64(w_in, N_IN, 64 * kb, n0 < 4096 ? n0 : n0 + 8, WIN, DM, n0, 0, lane); continue; } r -= I_IN;
        if (r < I_GLU) { const int kb = r / 32, nb = r % 32, n0 = 64 * nb; const int pn = n0 >> 8, bj = (n0 >> 7) & 1, j = n0 & 127; tr_item64(w_glu, 2048, 64 * kb, bj * 1024 + pn * 128 + j, WGLU, 1024, n0, 0, lane); continue; } r -= I_GLU;
        if (r < 3 * I_BR) { const int br = r / I_BR, q = r % I_BR, kb = q / 32, nb = q % 32; if (br == 0) tr_item64(w_a, DM, 64 * kb, 64 * nb, WBR, 3072, 64 * nb, 0, lane); else if (br == 1) tr_item64(w_b, DM, 64 * kb, 64 * nb, WBR, 3072, 64 * nb, 1024, lane); else tr_item64(w_c, DM, 64 * kb, 64 * nb, WBR, 3072, 64 * nb, 2048, lane); continue; } r -= 3 * I_BR;
        if (r < I_OUT) { const int kb = r / 32, nb = r % 32; tr_item64(w_out, DM, 64 * kb, 64 * nb, WOUT, DM, 64 * nb, 0, lane); continue; } r -= I_OUT;
        if (r < I_1) { const int kb = r / 128, nb = r % 128; tr_item64(w_1, FF, 64 * kb, 64 * nb, W1, DM, 64 * nb, 0, lane, g2); continue; } r -= I_1;
        { const int kb = r / 32, nb = r % 32; tr_item64(w_2, DM, 64 * kb, 64 * nb, W2, FF, 64 * nb, 0, lane); }
    }
}

template <bool DO_IF>
__device__ __forceinline__ void norm_phase(const float* X, const float* gain, bf16* XN, const LAS float* IFW, const float* bi, const float* bfg, float* IFG, int gw, int NGW, int lane) {
    f32x4 gv[8];
#pragma unroll
    for (int j = 0; j < 8; ++j) gv[j] = *(const f32x4*)(gain + 4 * lane + 256 * j);
    for (int m4 = gw; m4 < M / 4; m4 += NGW)
    for (int r4 = 0; r4 < 4; ++r4) { const int m = 4 * m4 + r4;
        const f32x4* xr = (const f32x4*)(X + (size_t)m * DM) + lane;
        f32x4 v[8]; float ss = 0.f;
#pragma unroll
        for (int j = 0; j < 8; ++j) { v[j] = xr[64 * j]; ss += (v[j].x * v[j].x + v[j].y * v[j].y) + (v[j].z * v[j].z + v[j].w * v[j].w); }
        const float rstd = 1.0f / sqrtf(wave_sum(ss) * (1.0f / DM) + NORM_EPS);
        v2u* o8 = (v2u*)(XN + (size_t)m * DM) + lane;
#pragma unroll
        for (int j = 0; j < 8; ++j) { v[j] = (v[j] * rstd) * gv[j]; v2u w; w.x = pk2(v[j].x, v[j].y); w.y = pk2(v[j].z, v[j].w); o8[64 * j] = w; }
        if constexpr (DO_IF) {
            float p[8];
#pragma unroll
            for (int c = 0; c < 8; ++c) p[c] = 0.f;
#pragma unroll
            for (int j = 0; j < 8; ++j)
#pragma unroll
                for (int e = 0; e < 4; ++e) { const int d = 4 * lane + 256 * j + e; const f32x4 w0 = *(const LAS f32x4*)(IFW + d * 8), w1 = *(const LAS f32x4*)(IFW + d * 8 + 4); const float xv = v[j][e];
                    p[0] += xv * w0.x; p[1] += xv * w0.y; p[2] += xv * w0.z; p[3] += xv * w0.w; p[4] += xv * w1.x; p[5] += xv * w1.y; p[6] += xv * w1.z; p[7] += xv * w1.w;
                    if (e == 3) asm volatile("" ::: "memory"); }
#pragma unroll
            for (int c = 0; c < 8; ++c) p[c] = wave_sum(p[c]);
            if (lane < 8) {
                float val = p[0];
#pragma unroll
                for (int c = 1; c < 8; ++c) val = (lane == c) ? p[c] : val;
                if (lane < 4) val += bi[lane];
                else { const float xg = val + bfg[lane - 4]; val = fminf(xg, 0.f) - log1pf(expf(-fabsf(xg))); }
                IFG[(size_t)m * 8 + lane] = val;
            }
        }
    }
}

__device__ __forceinline__ void mconv_phase(const bf16* PROJ, const float* cw, const float* cb, bf16* QKC, int gtid, int NGT) {
    for (int job = gtid; job < 256 * (M / 64); job += NGT) {
        const int cg = job & 255, run = job >> 8, c0 = cg * 8, m0 = run * 64;
        float w[4][8], bb[8];
#pragma unroll
        for (int j = 0; j < 4; ++j) { const f32x4 a = *(const f32x4*)(cw + j * 2048 + c0), b = *(const f32x4*)(cw + j * 2048 + c0 + 4); w[j][0] = a.x; w[j][1] = a.y; w[j][2] = a.z; w[j][3] = a.w; w[j][4] = b.x; w[j][5] = b.y; w[j][6] = b.z; w[j][7] = b.w; }
        { const f32x4 a = *(const f32x4*)(cb + c0), b = *(const f32x4*)(cb + c0 + 4); bb[0] = a.x; bb[1] = a.y; bb[2] = a.z; bb[3] = a.w; bb[4] = b.x; bb[5] = b.y; bb[6] = b.z; bb[7] = b.w; }
        const float osc = (c0 >= 1024) ? 0.0625f : 1.0f;
        float h0[8], h1[8], h2[8];
        const bool first = (m0 % SEQ) == 0;
#pragma unroll
        for (int e = 0; e < 8; ++e) { h0[e] = 0.f; h1[e] = 0.f; h2[e] = 0.f; }
        if (!first) {
            const v4u a = *(const v4u*)(PROJ + (size_t)(m0 - 3) * NPROJ + c0), b = *(const v4u*)(PROJ + (size_t)(m0 - 2) * NPROJ + c0), c = *(const v4u*)(PROJ + (size_t)(m0 - 1) * NPROJ + c0);
            h0[0] = bflo(a.x); h0[1] = bfhi(a.x); h0[2] = bflo(a.y); h0[3] = bfhi(a.y); h0[4] = bflo(a.z); h0[5] = bfhi(a.z); h0[6] = bflo(a.w); h0[7] = bfhi(a.w);
            h1[0] = bflo(b.x); h1[1] = bfhi(b.x); h1[2] = bflo(b.y); h1[3] = bfhi(b.y); h1[4] = bflo(b.z); h1[5] = bfhi(b.z); h1[6] = bflo(b.w); h1[7] = bfhi(b.w);
            h2[0] = bflo(c.x); h2[1] = bfhi(c.x); h2[2] = bflo(c.y); h2[3] = bfhi(c.y); h2[4] = bflo(c.z); h2[5] = bfhi(c.z); h2[6] = bflo(c.w); h2[7] = bfhi(c.w);
        }
#pragma unroll 4
        for (int r = 0; r < 64; ++r) {
            const v4u a = *(const v4u*)(PROJ + (size_t)(m0 + r) * NPROJ + c0);
            float x[8]; x[0] = bflo(a.x); x[1] = bfhi(a.x); x[2] = bflo(a.y); x[3] = bfhi(a.y); x[4] = bflo(a.z); x[5] = bfhi(a.z); x[6] = bflo(a.w); x[7] = bfhi(a.w);
            float y[8];
#pragma unroll
            for (int e = 0; e < 8; ++e) { const float s = bb[e] + w[0][e] * h0[e] + w[1][e] * h1[e] + w[2][e] * h2[e] + w[3][e] * x[e]; y[e] = s * sigmoid_f(s) * osc; h0[e] = h1[e]; h1[e] = h2[e]; h2[e] = x[e]; }
            v4u o; o.x = pk2(y[0], y[1]); o.y = pk2(y[2], y[3]); o.z = pk2(y[4], y[5]); o.w = pk2(y[6], y[7]);
            *(v4u*)(QKC + (size_t)(m0 + r) * 2048 + c0) = o;
        }
    }
}

__device__ __forceinline__ void mlstm_rec_phase(const bf16* QKC, const bf16* PROJ, const float* IFG, float* HM, int unit0, int ustride, int wave, int lane) {
    for (int unit = unit0; unit < 256; unit += ustride) {
        const int b = unit >> 7, h = (unit >> 5) & 3, e = (unit & 31) * 8 + wave;
        float C[4] = {0.f, 0.f, 0.f, 0.f}, nn[4] = {0.f, 0.f, 0.f, 0.f};
        const size_t mb = (size_t)b * SEQ;
        const bf16* qp = QKC + mb * 2048 + h * 256 + 4 * lane;
        const bf16* kp = qp + 1024;
        const bf16* vp = PROJ + mb * NPROJ + PV + h * 256 + e;
        const float* gp = IFG + mb * 8 + h;
        float* hp = HM + mb * 1024 + h * 256 + e;
        v2u qv[4], kv[4]; bf16 vv[4]; float ig[4], lf[4];
#pragma unroll
        for (int j = 0; j < 4; ++j) { qv[j] = *(const v2u*)(qp + (size_t)j * 2048); kv[j] = *(const v2u*)(kp + (size_t)j * 2048); vv[j] = vp[(size_t)j * NPROJ]; ig[j] = gp[j * 8]; lf[j] = gp[j * 8 + 4]; }
        for (int t0 = 0; t0 < SEQ; t0 += 4) {
            v2u qn[4], kn[4]; bf16 vn[4]; float ign[4], lfn[4];
            const int t1 = (t0 + 4 < SEQ) ? t0 + 4 : t0;
#pragma unroll
            for (int j = 0; j < 4; ++j) { qn[j] = *(const v2u*)(qp + (size_t)(t1 + j) * 2048); kn[j] = *(const v2u*)(kp + (size_t)(t1 + j) * 2048); vn[j] = vp[(size_t)(t1 + j) * NPROJ]; ign[j] = gp[(t1 + j) * 8]; lfn[j] = gp[(t1 + j) * 8 + 4]; }
            float pn[4], pd[4];
#pragma unroll
            for (int j = 0; j < 4; ++j) {
                const float fi = __expf(lf[j]), ii = __expf(ig[j]), iv = ii * bf1(vv[j]);
                const float q0 = bflo(qv[j].x), q1 = bfhi(qv[j].x), q2 = bflo(qv[j].y), q3 = bfhi(qv[j].y);
                const float k0 = bflo(kv[j].x), k1 = bfhi(kv[j].x), k2 = bflo(kv[j].y), k3 = bfhi(kv[j].y);
                C[0] = fi * C[0] + iv * k0; C[1] = fi * C[1] + iv * k1; C[2] = fi * C[2] + iv * k2; C[3] = fi * C[3] + iv * k3;
                nn[0] = fi * nn[0] + ii * k0; nn[1] = fi * nn[1] + ii * k1; nn[2] = fi * nn[2] + ii * k2; nn[3] = fi * nn[3] + ii * k3;
                pn[j] = (C[0] * q0 + C[1] * q1) + (C[2] * q2 + C[3] * q3);
                pd[j] = (nn[0] * q0 + nn[1] * q1) + (nn[2] * q2 + nn[3] * q3);
            }
#pragma unroll
            for (int j = 0; j < 4; ++j) { pn[j] = wave_sum(pn[j]); pd[j] = wave_sum(pd[j]); }
            if (lane == 0) {
#pragma unroll
                for (int j = 0; j < 4; ++j) hp[(size_t)(t0 + j) * 1024] = pn[j] / fmaxf(fabsf(pd[j]), 1.0f);
            }
#pragma unroll
            for (int j = 0; j < 4; ++j) { qv[j] = qn[j]; kv[j] = kn[j]; vv[j] = vn[j]; ig[j] = ign[j]; lf[j] = lfn[j]; }
        }
    }
}

__device__ __forceinline__ void mnorm_phase(const float* HM, const bf16* PROJ, const float* mg, bf16* Y, int gw, int NGW, int lane) {
    f32x4 gv[4];
#pragma unroll
    for (int j = 0; j < 4; ++j) gv[j] = *(const f32x4*)(mg + 16 * lane + 4 * j);
    for (int m = gw; m < M; m += NGW) {
        f32x4 v[4]; float ss = 0.f;
#pragma unroll
        for (int j = 0; j < 4; ++j) { v[j] = *(const f32x4*)(HM + (size_t)m * 1024 + 16 * lane + 4 * j); ss += (v[j].x * v[j].x + v[j].y * v[j].y) + (v[j].z * v[j].z + v[j].w * v[j].w); }
        ss += __shfl_xor(ss, 1); ss += __shfl_xor(ss, 2); ss += __shfl_xor(ss, 4); ss += __shfl_xor(ss, 8);
        const float r = 1.0f / sqrtf(ss * (1.0f / 256.0f) + NORM_EPS);
        const v4u o0 = *(const v4u*)(PROJ + (size_t)m * NPROJ + PO + 16 * lane), o1 = *(const v4u*)(PROJ + (size_t)m * NPROJ + PO + 16 * lane + 8);
        const float og[16] = {bflo(o0.x), bfhi(o0.x), bflo(o0.y), bfhi(o0.y), bflo(o0.z), bfhi(o0.z), bflo(o0.w), bfhi(o0.w), bflo(o1.x), bfhi(o1.x), bflo(o1.y), bfhi(o1.y), bflo(o1.z), bfhi(o1.z), bflo(o1.w), bfhi(o1.w)};
        float y[16];
#pragma unroll
        for (int j = 0; j < 4; ++j)
#pragma unroll
            for (int e = 0; e < 4; ++e) y[4 * j + e] = ABL_SA * og[4 * j + e] * ((v[j][e] * r) * gv[j][e]);
        v4u w0, w1; w0.x = pk2(y[0], y[1]); w0.y = pk2(y[2], y[3]); w0.z = pk2(y[4], y[5]); w0.w = pk2(y[6], y[7]); w1.x = pk2(y[8], y[9]); w1.y = pk2(y[10], y[11]); w1.z = pk2(y[12], y[13]); w1.w = pk2(y[14], y[15]);
        *(v4u*)(Y + (size_t)m * 3072 + 16 * lane) = w0; *(v4u*)(Y + (size_t)m * 3072 + 16 * lane + 8) = w1;
    }
}

__device__ __forceinline__ void attn_fill_bias(const float* rel_bias, LAS float* BT, int tid) {
    for (int i = tid; i < 3 * 129 * 8; i += NTHR) { const int hs = i & 7, n = (i >> 3) % 129, g = (i >> 3) / 129; BT[i] = rel_bias[T5B[g][n] * 24 + g * 8 + hs]; }
}
__device__ __forceinline__ void attn_simple_phase(const bf16* PROJ, const LAS float* BT, bf16* Y, int gw, int NGW, int lane) {
    const int quad = lane >> 2, sub = lane & 3;
    for (int job = gw; job < (M / 16) * 8; job += NGW) {
        const int hs = job & 7, m = (job >> 3) * 16 + quad, b = m / SEQ, t = m % SEQ;
        float mx = -1e30f, l = 0.f, acc[32];
#pragma unroll
        for (int i = 0; i < 32; ++i) acc[i] = 0.f;
        for (int g = 0; g < 3; ++g) {
            const int r = (g == 0) ? 1 : (g == 1 ? 4 : 16), hh = g * 8 + hs;
            float q[32];
            { const v4u* qr = (const v4u*)(PROJ + (size_t)m * NPROJ + PAQ + hh * 128 + sub * 32);
#pragma unroll
              for (int i = 0; i < 4; ++i) { const v4u a = qr[i]; q[8 * i + 0] = bflo(a.x); q[8 * i + 1] = bfhi(a.x); q[8 * i + 2] = bflo(a.y); q[8 * i + 3] = bfhi(a.y); q[8 * i + 4] = bflo(a.z); q[8 * i + 5] = bfhi(a.z); q[8 * i + 6] = bflo(a.w); q[8 * i + 7] = bfhi(a.w); }
#pragma unroll
              for (int i = 0; i < 32; ++i) q[i] *= 0.08838834764831845f; }
            const bf16* kb = PROJ + (size_t)b * SEQ * NPROJ + PAK + hh * 128 + sub * 32;
            const bf16* vb = PROJ + (size_t)b * SEQ * NPROJ + PAV + hh * 128 + sub * 32;
            const LAS float* bt = BT + g * 129 * 8 + hs;
            for (int n = 0; n <= 128; ++n) {
                const int tk = t - n * r;
                if (tk >= 0) {
                    const v4u* kr = (const v4u*)(kb + (size_t)tk * NPROJ);
                    float dot = 0.f;
#pragma unroll
                    for (int i = 0; i < 4; ++i) { const v4u a = kr[i];
                        dot += q[8 * i + 0] * bflo(a.x) + q[8 * i + 1] * bfhi(a.x) + q[8 * i + 2] * bflo(a.y) + q[8 * i + 3] * bfhi(a.y) + q[8 * i + 4] * bflo(a.z) + q[8 * i + 5] * bfhi(a.z) + q[8 * i + 6] * bflo(a.w) + q[8 * i + 7] * bfhi(a.w); }
                    dot += __shfl_xor(dot, 1); dot += __shfl_xor(dot, 2);
                    const float s = dot + bt[n * 8];
                    const float mn = fmaxf(mx, s), corr = __expf(mx - mn), p = __expf(s - mn);
                    l = l * corr + p; mx = mn;
                    const v4u* vr = (const v4u*)(vb + (size_t)tk * NPROJ);
#pragma unroll
                    for (int i = 0; i < 4; ++i) { const v4u a = vr[i];
                        acc[8 * i + 0] = acc[8 * i + 0] * corr + p * bflo(a.x); acc[8 * i + 1] = acc[8 * i + 1] * corr + p * bfhi(a.x); acc[8 * i + 2] = acc[8 * i + 2] * corr + p * bflo(a.y); acc[8 * i + 3] = acc[8 * i + 3] * corr + p * bfhi(a.y);
                        acc[8 * i + 4] = acc[8 * i + 4] * corr + p * bflo(a.z); acc[8 * i + 5] = acc[8 * i + 5] * corr + p * bfhi(a.z); acc[8 * i + 6] = acc[8 * i + 6] * corr + p * bflo(a.w); acc[8 * i + 7] = acc[8 * i + 7] * corr + p * bfhi(a.w); }
                }
            }
        }
        const float inv = ABL_SB / l;
        v4u* op = (v4u*)(Y + (size_t)m * 3072 + 1024 + hs * 128 + sub * 32);
#pragma unroll
        for (int i = 0; i < 4; ++i) { v4u w; w.x = pk2(acc[8 * i + 0] * inv, acc[8 * i + 1] * inv); w.y = pk2(acc[8 * i + 2] * inv, acc[8 * i + 3] * inv); w.z = pk2(acc[8 * i + 4] * inv, acc[8 * i + 5] * inv); w.w = pk2(acc[8 * i + 6] * inv, acc[8 * i + 7] * inv); op[i] = w; }
    }
}

struct S5P { const float *lam_re, *lam_im, *log_dt, *b_re, *b_im, *c_re, *c_im, *d_skip; };
#define S5P_MAKE(sp, l) S5P sp; sp.lam_re = ARG(9) + (size_t)(l) * 4096; sp.lam_im = ARG(10) + (size_t)(l) * 4096; sp.log_dt = ARG(11) + (size_t)(l) * 64; \
    sp.b_re = ARG(12) + (size_t)(l) * 65536; sp.b_im = ARG(13) + (size_t)(l) * 65536; sp.c_re = ARG(14) + (size_t)(l) * 65536; sp.c_im = ARG(15) + (size_t)(l) * 65536; sp.d_skip = ARG(16) + (size_t)(l) * 1024
__device__ __forceinline__ void s5_disc(const S5P& P, int g, int p, float& are, float& aim, float& fre, float& fim) {
    const float dt = expf(P.log_dt[g]), lr = P.lam_re[g * 64 + p], li = P.lam_im[g * 64 + p];
    const float mag = expf(lr * dt), ang = li * dt;
    are = mag * cosf(ang); aim = mag * sinf(ang);
    const float nr = are - 1.0f, ni = aim, den = lr * lr + li * li;
    fre = (nr * lr + ni * li) / den; fim = (ni * lr - nr * li) / den;
}
template <bool OUT>
__device__ __forceinline__ void s5_scan_phase(const S5P& P, const bf16* PROJ, float* LOC, const float* CAR, bf16* Z, LAS float* xs  , int gw, int NGW, int lane) {
    for (int job = gw; job < 2 * 64 * 16; job += NGW) {
        const int c = job & 15, g = (job >> 4) & 63, b = job >> 10, p = lane;
        float are, aim, fre, fim; s5_disc(P, g, p, are, aim, fre, fim);
        float Br[16], Bi[16];
#pragma unroll
        for (int i = 0; i < 16; ++i) { const float br = P.b_re[(g * 64 + p) * 16 + i], bi = P.b_im[(g * 64 + p) * 16 + i]; Br[i] = fre * br - fim * bi; Bi[i] = fre * bi + fim * br; }
        float xr = 0.f, xi = 0.f;
        const size_t sidx = ((size_t)((b * 64 + g) * 16 + c) * 64 + p) * 2;
        float Cr[16], Ci[16], dsk = 0.f; const int o = lane & 15, qd = lane >> 4;
        if (OUT) { xr = CAR[sidx]; xi = CAR[sidx + 1];
#pragma unroll
            for (int j = 0; j < 16; ++j) { Cr[j] = P.c_re[(g * 16 + o) * 64 + qd * 16 + j]; Ci[j] = P.c_im[(g * 16 + o) * 64 + qd * 16 + j]; }
            dsk = P.d_skip[g * 16 + o]; }
        const bf16* up = PROJ + ((size_t)b * SEQ + c * 1024) * NPROJ + PU + g * 16;
        for (int t = 0; t < 1024; ++t) {
            const v4u u0 = *(const v4u*)(up + (size_t)t * NPROJ), u1 = *(const v4u*)(up + (size_t)t * NPROJ + 8);
            const float u[16] = {bflo(u0.x), bfhi(u0.x), bflo(u0.y), bfhi(u0.y), bflo(u0.z), bfhi(u0.z), bflo(u0.w), bfhi(u0.w), bflo(u1.x), bfhi(u1.x), bflo(u1.y), bfhi(u1.y), bflo(u1.z), bfhi(u1.z), bflo(u1.w), bfhi(u1.w)};
            float br = 0.f, bi = 0.f;
#pragma unroll
            for (int i = 0; i < 16; ++i) { br += Br[i] * u[i]; bi += Bi[i] * u[i]; }
            const float nr = are * xr - aim * xi + br, ni = are * xi + aim * xr + bi; xr = nr; xi = ni;
            if (OUT) {
                xs[p] = xr; xs[64 + p] = xi; LDS_WAIT();
                float s = 0.f;
#pragma unroll
                for (int j = 0; j < 16; ++j) s += Cr[j] * xs[qd * 16 + j] - Ci[j] * xs[64 + qd * 16 + j];
                LDS_WAIT();
                s += __shfl_xor(s, 16); s += __shfl_xor(s, 32);
                float uo = u[0];
#pragma unroll
                for (int j = 1; j < 16; ++j) uo = (o == j) ? u[j] : uo;
                const float y = s + dsk * uo;
                const float z = ABL_SC * 0.5f * y * (1.0f + tanhf(0.7978845608028654f * (y + 0.044715f * y * y * y)));
                if (qd == 0) Z[((size_t)b * SEQ + c * 1024 + t) * 1024 + g * 16 + o] = (bf16)f2bf(z);
            }
        }
        if (!OUT) { LOC[sidx] = xr; LOC[sidx + 1] = xi; }
    }
}
__device__ __forceinline__ void s5_carry_phase(const f32x4* DISC, const float* LOC, float* CAR, int gtid, int NGT) {
    for (int i = gtid; i < 2 * 64 * 64; i += NGT) {
        const int p = i & 63, g = (i >> 6) & 63, b = i >> 12;
        const f32x4 dq = DISC[g * 64 + p];
        float pr = dq[0], pi = dq[1];
#pragma unroll 1
        for (int k = 0; k < 10; ++k) { const float nr = pr * pr - pi * pi, ni = 2.0f * pr * pi; pr = nr; pi = ni; }
        float cr = 0.f, ci = 0.f; asm volatile("" : "+v"(cr), "+v"(ci));
        for (int c = 0; c < 16; ++c) {
            const size_t sidx = ((size_t)((b * 64 + g) * 16 + c) * 64 + p) * 2;
            CAR[sidx] = cr; CAR[sidx + 1] = ci;
            const float lr = LOC[sidx], li = LOC[sidx + 1];
            const float nr = pr * cr - pi * ci + lr, ni = pr * ci + pi * cr + li; cr = nr; ci = ni;
        }
    }
}
constexpr int AT_PITCH = 288, AT_KOFF = 0, AT_VOFF = 256 * AT_PITCH, AT_BTOFF = 2 * 256 * AT_PITCH;
typedef short s16x4 __attribute__((ext_vector_type(4)));
typedef short s16x8 __attribute__((ext_vector_type(8)));
__device__ __forceinline__ s16x4 tr_read4(LAS unsigned char* p) { return __builtin_bit_cast(s16x4, __builtin_amdgcn_ds_read_tr16_b64_v4i16((LAS s16x4*)p)); }
struct AtUnit { int b, hh, grp, r, c, qb; };
__device__ __forceinline__ AtUnit at_unit(int u) { AtUnit a; const int blk = u & 127; a.hh = (u >> 7) % 24; a.b = u / (128 * 24); a.grp = a.hh >> 3; a.r = a.grp == 0 ? 1 : (a.grp == 1 ? 4 : 16);
    const int nbq = 128 / a.r; a.c = blk / nbq; a.qb = blk % nbq; return a; }
__device__ __forceinline__ void at_issue_loads(const bf16* PROJ, const AtUnit& a, int tid, v4u (&kreg)[8], v4u (&vreg)[8]) {
#pragma unroll
    for (int it = 0; it < 8; ++it) { const int chunk = it * NTHR + tid, row = chunk >> 4, c16 = chunk & 15; int jk = a.qb * 128 - 128 + row; jk = jk < 0 ? 0 : jk;
        const bf16* src = PROJ + ((size_t)a.b * SEQ + a.c + (size_t)a.r * jk) * NPROJ + PAK + a.hh * 128 + c16 * 8;
        kreg[it] = *(const v4u*)src; vreg[it] = *(const v4u*)(src + (PAV - PAK)); }
}
__device__ __forceinline__ void attn_mfma_phase(const bf16* PROJ, const float* rel_bias, bf16* ATT, float* LSE, LAS unsigned char* lds, int bx, int G, int tid) {
    const int lane = tid & 63, w = __builtin_amdgcn_readfirstlane(tid >> 6), ql = lane & 15, g4 = lane >> 4;
    constexpr int NU = 2 * 24 * 128;
    constexpr float SC = 0.08838834764831845f * 1.4426950408889634f;
    v4u kreg[8], vreg[8];
    float btv = -1e30f;
    if (bx < NU) { const AtUnit a0 = at_unit(bx); at_issue_loads(PROJ, a0, tid, kreg, vreg);
        if (tid < 159) { const int n = 143 - tid; btv = (n >= 0 && n <= 128) ? rel_bias[T5B[a0.grp][n] * 24 + a0.hh] * 1.4426950408889634f : -1e30f; } }
    for (int u = bx; u < NU; u += G) {
        const AtUnit a = at_unit(u);
#pragma unroll
        for (int it = 0; it < 8; ++it) { const int chunk = it * NTHR + tid, row = chunk >> 4, c16 = chunk & 15;
            *(LAS v4u*)(lds + AT_KOFF + row * AT_PITCH + c16 * 16) = kreg[it]; *(LAS v4u*)(lds + AT_VOFF + row * AT_PITCH + c16 * 16) = vreg[it]; }
        if (tid < 159) ((LAS float*)(lds + AT_BTOFF))[tid] = btv;
        __syncthreads();
        if (u + G < NU) { const AtUnit an = at_unit(u + G); at_issue_loads(PROJ, an, tid, kreg, vreg);
            if (tid < 159) { const int n = 143 - tid; btv = (n >= 0 && n <= 128) ? rel_bias[T5B[an.grp][n] * 24 + an.hh] * 1.4426950408889634f : -1e30f; } }
        const int jq = a.qb * 128 + 16 * w + ql; const size_t mq = (size_t)a.b * SEQ + a.c + (size_t)a.r * jq;
        s16x8 qf[4];
#pragma unroll
        for (int ks = 0; ks < 4; ++ks) qf[ks] = *(const s16x8*)(PROJ + mq * NPROJ + PAQ + a.hh * 128 + 32 * ks + 8 * g4);
        f32x4 s[9];
#pragma unroll
        for (int kt = 0; kt < 9; ++kt) { f32x4 acc = {0.f, 0.f, 0.f, 0.f};
#pragma unroll
            for (int ks = 0; ks < 4; ++ks) { const s16x8 kf = *(const LAS s16x8*)(lds + AT_KOFF + (16 * (w + kt) + ql) * AT_PITCH + (32 * ks + 8 * g4) * 2);
                acc = __builtin_amdgcn_mfma_f32_16x16x32_bf16(kf, qf[ks], acc, 0, 0, 0); }
            s[kt] = acc; }
        const LAS float* bt = (const LAS float*)(lds + AT_BTOFF) + (15 - ql + 4 * g4);
        float mx = -1e30f;
#pragma unroll
        for (int kt = 0; kt < 9; ++kt)
#pragma unroll
            for (int i = 0; i < 4; ++i) { float v = s[kt][i] * SC + bt[16 * kt + i];
                if (a.qb == 0) { if (16 * (w + kt) + 4 * g4 + i < 128) v = -1e30f; }
                s[kt][i] = v; mx = fmaxf(mx, v); }
        mx = fmaxf(mx, __shfl_xor(mx, 16)); mx = fmaxf(mx, __shfl_xor(mx, 32));
        float sum = 0.f;
#pragma unroll
        for (int kt = 0; kt < 9; ++kt)
#pragma unroll
            for (int i = 0; i < 4; ++i) { const float p = __builtin_amdgcn_exp2f(s[kt][i] - mx); s[kt][i] = p; sum += p; }
        sum += __shfl_xor(sum, 16); sum += __shfl_xor(sum, 32);
        f32x4 o[8];
#pragma unroll
        for (int dt = 0; dt < 8; ++dt) o[dt] = (f32x4){0.f, 0.f, 0.f, 0.f};
        LAS unsigned char* vb = lds + AT_VOFF + (16 * w + 4 * g4 + (ql >> 2)) * AT_PITCH + (ql & 3) * 8;
#pragma unroll
        for (int p = 0; p < 5; ++p) {
            v4u pk; pk.x = cvt_pk_bf16(s[2 * p][0], s[2 * p][1]); pk.y = cvt_pk_bf16(s[2 * p][2], s[2 * p][3]);
            if (p < 4) { pk.z = cvt_pk_bf16(s[2 * p + 1][0], s[2 * p + 1][1]); pk.w = cvt_pk_bf16(s[2 * p + 1][2], s[2 * p + 1][3]); } else { pk.z = 0u; pk.w = 0u; }
            const s16x8 pf = __builtin_bit_cast(s16x8, pk);
#pragma unroll
            for (int dt = 0; dt < 8; ++dt) {
                const s16x4 lo = tr_read4(vb + p * 32 * AT_PITCH + dt * 32);
                s16x4 hi = {0, 0, 0, 0}; if (p < 4) hi = tr_read4(vb + p * 32 * AT_PITCH + 16 * AT_PITCH + dt * 32);
                const s16x8 vf = {lo[0], lo[1], lo[2], lo[3], hi[0], hi[1], hi[2], hi[3]};
                o[dt] = __builtin_amdgcn_mfma_f32_16x16x32_bf16(vf, pf, o[dt], 0, 0, 0); }
        }
        const float inv = 1.0f / sum;
        bf16* op = ATT + ((size_t)a.grp * M + mq) * 1024 + (a.hh & 7) * 128 + 4 * g4;
#pragma unroll
        for (int dt = 0; dt < 8; ++dt) { v2u wv; wv.x = cvt_pk_bf16(o[dt][0] * inv, o[dt][1] * inv); wv.y = cvt_pk_bf16(o[dt][2] * inv, o[dt][3] * inv); *(v2u*)(op + dt * 16) = wv; }
        if (g4 == 0) LSE[(size_t)a.grp * (2 * 8 * SEQ) + ((size_t)(a.b * 8 + (a.hh & 7)) * a.r + a.c) * (SEQ / a.r) + jq] = mx + __builtin_amdgcn_logf(sum);
        __syncthreads();
    }
}
__device__ __forceinline__ void attn_merge_phase(const bf16* ATT, const float* LSE, bf16* Yb  , int gw, int NGW, int lane) {
    for (int m = gw; m < M; m += NGW) {
        const int hs = lane >> 3, b = m / SEQ, t = m % SEQ;
        const float* lb = LSE + (size_t)(b * 8 + hs) * SEQ;
        const float l0 = lb[t], l1 = lb[(size_t)(2 * 8 * SEQ) + (t & 3) * (SEQ / 4) + (t >> 2)], l2 = lb[(size_t)2 * (2 * 8 * SEQ) + (t & 15) * (SEQ / 16) + (t >> 4)];
        const float mx = fmaxf(l0, fmaxf(l1, l2));
        float w0 = __builtin_amdgcn_exp2f(l0 - mx), w1 = __builtin_amdgcn_exp2f(l1 - mx), w2 = __builtin_amdgcn_exp2f(l2 - mx);
        const float inv = 1.0f / (w0 + w1 + w2); w0 *= inv; w1 *= inv; w2 *= inv;
        float y[16];
#pragma unroll
        for (int hlf = 0; hlf < 2; ++hlf) {
            const v4u a = *(const v4u*)(ATT + (size_t)m * 1024 + 16 * lane + 8 * hlf), b = *(const v4u*)(ATT + ((size_t)M + m) * 1024 + 16 * lane + 8 * hlf), c = *(const v4u*)(ATT + ((size_t)2 * M + m) * 1024 + 16 * lane + 8 * hlf);
            y[8 * hlf + 0] = w0 * bflo(a.x) + w1 * bflo(b.x) + w2 * bflo(c.x); y[8 * hlf + 1] = w0 * bfhi(a.x) + w1 * bfhi(b.x) + w2 * bfhi(c.x);
            y[8 * hlf + 2] = w0 * bflo(a.y) + w1 * bflo(b.y) + w2 * bflo(c.y); y[8 * hlf + 3] = w0 * bfhi(a.y) + w1 * bfhi(b.y) + w2 * bfhi(c.y);
            y[8 * hlf + 4] = w0 * bflo(a.z) + w1 * bflo(b.z) + w2 * bflo(c.z); y[8 * hlf + 5] = w0 * bfhi(a.z) + w1 * bfhi(b.z) + w2 * bfhi(c.z);
            y[8 * hlf + 6] = w0 * bflo(a.w) + w1 * bflo(b.w) + w2 * bflo(c.w); y[8 * hlf + 7] = w0 * bfhi(a.w) + w1 * bfhi(b.w) + w2 * bfhi(c.w);
        }
        v4u o0, o1; o0.x = pk2(y[0], y[1]); o0.y = pk2(y[2], y[3]); o0.z = pk2(y[4], y[5]); o0.w = pk2(y[6], y[7]); o1.x = pk2(y[8], y[9]); o1.y = pk2(y[10], y[11]); o1.z = pk2(y[12], y[13]); o1.w = pk2(y[14], y[15]);
        *(v4u*)(Yb + (size_t)m * 3072 + 16 * lane) = o0; *(v4u*)(Yb + (size_t)m * 3072 + 16 * lane + 8) = o1;
    }
}
constexpr int ML_PITCH = 544, ML_KOFF = 0, ML_VOFF = 128 * ML_PITCH, ML_GOFF = 2 * 128 * ML_PITCH;
constexpr int ML_ROWS = 257, ML_USZ = ML_ROWS * 256;
__device__ __forceinline__ void ml_gates(const float* IFG, size_t m0, int h, LAS float* gv, int tid) {
    if (tid < 64) {
        const int l = tid; const float x0 = IFG[(m0 + 2 * l) * 8 + 4 + h], x1 = IFG[(m0 + 2 * l + 1) * 8 + 4 + h], i0 = IFG[(m0 + 2 * l) * 8 + h], i1 = IFG[(m0 + 2 * l + 1) * 8 + h];
        float inc = x0 + x1;
#pragma unroll
        for (int d = 1; d < 64; d <<= 1) { const float t = __shfl_up(inc, d); if (l >= d) inc += t; }
        const float b1 = inc, b0 = inc - x1, bL = __shfl(inc, 63);
        gv[2 * l] = b0; gv[2 * l + 1] = b1; gv[128 + 2 * l] = i0 - b0; gv[128 + 2 * l + 1] = i1 - b1;
        gv[256 + 2 * l] = __expf(bL - b0 + i0); gv[256 + 2 * l + 1] = __expf(bL - b1 + i1);
    }
}
template <bool SCALE>
__device__ __forceinline__ void ml_stage(const bf16* QKC, const bf16* PROJ, size_t m0, int h, LAS unsigned char* lds, int tid) {
    const LAS float* Wv = (const LAS float*)(lds + ML_GOFF) + 256;
#pragma unroll
    for (int it = 0; it < 8; ++it) { const int chunk = it * NTHR + tid, row = chunk >> 5, c16 = chunk & 31;
        const v4u kv = *(const v4u*)(QKC + (m0 + row) * 2048 + 1024 + h * 256 + c16 * 8); v4u vv = *(const v4u*)(PROJ + (m0 + row) * NPROJ + PV + h * 256 + c16 * 8);
        if (SCALE) { const float w = Wv[row]; vv.x = pk2(bflo(vv.x) * w, bfhi(vv.x) * w); vv.y = pk2(bflo(vv.y) * w, bfhi(vv.y) * w); vv.z = pk2(bflo(vv.z) * w, bfhi(vv.z) * w); vv.w = pk2(bflo(vv.w) * w, bfhi(vv.w) * w); }
        *(LAS v4u*)(lds + ML_KOFF + row * ML_PITCH + c16 * 16) = kv; *(LAS v4u*)(lds + ML_VOFF + row * ML_PITCH + c16 * 16) = vv; }
    if (tid < 256) { const int row = tid >> 1, hf = tid & 1; v4u z = {0u, 0u, 0u, 0u}; if (hf == 0) z.x = SCALE ? f2bf(Wv[row]) : 0x3f80u; *(LAS v4u*)(lds + ML_VOFF + row * ML_PITCH + 512 + hf * 16) = z; }
}
__device__ __forceinline__ void mlstm_a1_phase(const bf16* QKC, const bf16* PROJ, const float* IFG, bf16* CST, float* MF, LAS unsigned char* lds, int bx, int G, int tid) {
    const int lane = tid & 63, w = __builtin_amdgcn_readfirstlane(tid >> 6), li = lane & 15, g4 = lane >> 4;
    for (int u = bx; u < 1024; u += G) {
        const int c = u & 127, h = (u >> 7) & 3, b = u >> 9; const size_t m0 = (size_t)b * SEQ + c * 128;
        LAS float* gv = (LAS float*)(lds + ML_GOFF);
        ml_gates(IFG, m0, h, gv, tid);
        __syncthreads();
        if (tid == 0) MF[u * 32] = __expf(gv[127]);
        ml_stage<true>(QKC, PROJ, m0, h, lds, tid);
        __syncthreads();
        s16x8 kf[2][4];
        LAS unsigned char* kb = lds + ML_KOFF + (8 * g4 + (li >> 2)) * ML_PITCH + (li & 3) * 8;
        LAS unsigned char* vb = lds + ML_VOFF + (8 * g4 + (li >> 2)) * ML_PITCH + (li & 3) * 8;
#pragma unroll
        for (int dt = 0; dt < 2; ++dt)
#pragma unroll
            for (int ks = 0; ks < 4; ++ks) { const s16x4 lo = tr_read4(kb + ks * 32 * ML_PITCH + (2 * w + dt) * 32), hi = tr_read4(kb + ks * 32 * ML_PITCH + 4 * ML_PITCH + (2 * w + dt) * 32);
                kf[dt][ks] = (s16x8){lo[0], lo[1], lo[2], lo[3], hi[0], hi[1], hi[2], hi[3]}; }
        bf16* cu = CST + (size_t)u * ML_USZ;
#pragma unroll 1
        for (int et = 0; et < 17; ++et) {
            f32x4 a0 = {0.f, 0.f, 0.f, 0.f}, a1 = {0.f, 0.f, 0.f, 0.f};
#pragma unroll
            for (int ks = 0; ks < 4; ++ks) { const s16x4 lo = tr_read4(vb + ks * 32 * ML_PITCH + et * 32), hi = tr_read4(vb + ks * 32 * ML_PITCH + 4 * ML_PITCH + et * 32);
                const s16x8 vf = {lo[0], lo[1], lo[2], lo[3], hi[0], hi[1], hi[2], hi[3]};
                a0 = __builtin_amdgcn_mfma_f32_16x16x32_bf16(kf[0][ks], vf, a0, 0, 0, 0); a1 = __builtin_amdgcn_mfma_f32_16x16x32_bf16(kf[1][ks], vf, a1, 0, 0, 0); }
            const int e = et * 16 + li;
            if (e < ML_ROWS) { v2u o0, o1; o0.x = cvt_pk_bf16(a0[0], a0[1]); o0.y = cvt_pk_bf16(a0[2], a0[3]); o1.x = cvt_pk_bf16(a1[0], a1[1]); o1.y = cvt_pk_bf16(a1[2], a1[3]);
                *(v2u*)(cu + (size_t)e * 256 + 32 * w + 4 * g4) = o0; *(v2u*)(cu + (size_t)e * 256 + 32 * w + 16 + 4 * g4) = o1; }
        }
        __syncthreads();
    }
}
__device__ __forceinline__ void mlstm_a2_phase(const bf16* DC, bf16* CIN, const float* MF, int gtid, int NGT) {
    constexpr int NQ = ML_USZ / 8;
    for (int job = gtid; job < 8 * NQ; job += NGT) {
        const int bh = job / NQ, q = job % NQ;
        float cr[8];
#pragma unroll
        for (int j = 0; j < 8; ++j) cr[j] = 0.f;
        const bf16* p = DC + (size_t)bh * 128 * ML_USZ + (size_t)q * 8; bf16* po = CIN + (size_t)bh * 128 * ML_USZ + (size_t)q * 8;
        for (int c0 = 0; c0 < 128; c0 += 8) {
            v4u d[8]; float f[8];
#pragma unroll
            for (int k = 0; k < 8; ++k) { d[k] = *(const v4u*)(p + (size_t)(c0 + k) * ML_USZ); f[k] = MF[(bh * 128 + c0 + k) * 32]; }
#pragma unroll
            for (int k = 0; k < 8; ++k) {
                v4u o; o.x = pk2(cr[0], cr[1]); o.y = pk2(cr[2], cr[3]); o.z = pk2(cr[4], cr[5]); o.w = pk2(cr[6], cr[7]);
                *(v4u*)(po + (size_t)(c0 + k) * ML_USZ) = o;
                cr[0] = f[k] * cr[0] + bflo(d[k].x); cr[1] = f[k] * cr[1] + bfhi(d[k].x); cr[2] = f[k] * cr[2] + bflo(d[k].y); cr[3] = f[k] * cr[3] + bfhi(d[k].y);
                cr[4] = f[k] * cr[4] + bflo(d[k].z); cr[5] = f[k] * cr[5] + bfhi(d[k].z); cr[6] = f[k] * cr[6] + bflo(d[k].w); cr[7] = f[k] * cr[7] + bfhi(d[k].w);
            }
        }
    }
}
constexpr int ML3_GOFF = 139840;
__device__ __forceinline__ void mlstm_a3_phase(const bf16* QKC, const bf16* PROJ, const float* IFG, const bf16* CST, const float* mg, bf16* Yo, LAS unsigned char* lds, int bx, int G, int tid) {
    const int lane = tid & 63, w = __builtin_amdgcn_readfirstlane(tid >> 6), li = lane & 15, g4 = lane >> 4;
    for (int u = bx; u < 1024; u += G) {
        const int c = u & 127, h = (u >> 7) & 3, b = u >> 9; const size_t m0 = (size_t)b * SEQ + c * 128;
        LAS float* gv = (LAS float*)(lds + ML3_GOFF);
        ml_gates(IFG, m0, h, gv, tid);
        const bf16* cu = CST + (size_t)u * ML_USZ;
#pragma unroll 1
        for (int hf = 0; hf < 2; ++hf) { v4u r[8];
#pragma unroll
            for (int it = 0; it < 8; ++it) { const int chunk = (hf * 8 + it) * NTHR + tid; r[it] = *(const v4u*)(cu + (size_t)(chunk >> 5) * 256 + (chunk & 31) * 8); }
#pragma unroll
            for (int it = 0; it < 8; ++it) { const int chunk = (hf * 8 + it) * NTHR + tid; *(LAS v4u*)(lds + (chunk >> 5) * ML_PITCH + (chunk & 31) * 16) = r[it]; } }
        if (tid < 32) *(LAS v4u*)(lds + 256 * ML_PITCH + tid * 16) = *(const v4u*)(cu + (size_t)256 * 256 + tid * 8);
        const size_t mq = m0 + 16 * w + li;
        __syncthreads();
        s16x8 qf[8];
#pragma unroll
        for (int ks = 0; ks < 8; ++ks) qf[ks] = *(const s16x8*)(QKC + mq * 2048 + h * 256 + 32 * ks + 8 * g4);
        f32x4 o[17];
#pragma unroll
        for (int et = 0; et < 17; ++et) { f32x4 acc = {0.f, 0.f, 0.f, 0.f}; const int row = (et * 16 + li) < ML_ROWS ? (et * 16 + li) : (ML_ROWS - 1);
#pragma unroll
            for (int ks = 0; ks < 8; ++ks) { const s16x8 cf = *(const LAS s16x8*)(lds + row * ML_PITCH + (32 * ks + 8 * g4) * 2); acc = __builtin_amdgcn_mfma_f32_16x16x32_bf16(cf, qf[ks], acc, 0, 0, 0); }
            o[et] = acc; if (et & 1) __builtin_amdgcn_sched_barrier(0); }
        const float bt = gv[16 * w + li], ebt = __expf(bt);
#pragma unroll
        for (int et = 0; et < 17; ++et) o[et] *= ebt;
        v4u kr[8], vr[8];
#pragma unroll
        for (int it = 0; it < 8; ++it) { const int chunk = it * NTHR + tid, row = chunk >> 5, c16 = chunk & 31;
            kr[it] = *(const v4u*)(QKC + (m0 + row) * 2048 + 1024 + h * 256 + c16 * 8); vr[it] = *(const v4u*)(PROJ + (m0 + row) * NPROJ + PV + h * 256 + c16 * 8); }
        __syncthreads();
#pragma unroll
        for (int it = 0; it < 8; ++it) { const int chunk = it * NTHR + tid, row = chunk >> 5, c16 = chunk & 31;
            *(LAS v4u*)(lds + ML_KOFF + row * ML_PITCH + c16 * 16) = kr[it]; *(LAS v4u*)(lds + ML_VOFF + row * ML_PITCH + c16 * 16) = vr[it]; }
        if (tid < 256) { const int row = tid >> 1, hf = tid & 1; v4u z = {0u, 0u, 0u, 0u}; if (hf == 0) z.x = 0x3f80u; *(LAS v4u*)(lds + ML_VOFF + row * ML_PITCH + 512 + hf * 16) = z; }
        __syncthreads();
        v4u pk[4];
#pragma unroll
        for (int p = 0; p < 4; ++p) pk[p] = (v4u){0u, 0u, 0u, 0u};
#pragma unroll
        for (int kt = 0; kt < 8; ++kt) {
            if (kt <= w) {
                f32x4 acc = {0.f, 0.f, 0.f, 0.f};
#pragma unroll
                for (int ks = 0; ks < 8; ++ks) { const s16x8 kf = *(const LAS s16x8*)(lds + ML_KOFF + (16 * kt + li) * ML_PITCH + (32 * ks + 8 * g4) * 2); acc = __builtin_amdgcn_mfma_f32_16x16x32_bf16(kf, qf[ks], acc, 0, 0, 0); }
                const f32x4 av = *(const LAS f32x4*)(gv + 128 + 16 * kt + 4 * g4);
                float pv[4];
#pragma unroll
                for (int i = 0; i < 4; ++i) { const bool ok = (16 * kt + 4 * g4 + i) <= (16 * w + li); pv[i] = ok ? acc[i] * __expf(bt + av[i]) : 0.f; }
                if (kt & 1) { pk[kt >> 1].z = cvt_pk_bf16(pv[0], pv[1]); pk[kt >> 1].w = cvt_pk_bf16(pv[2], pv[3]); } else { pk[kt >> 1].x = cvt_pk_bf16(pv[0], pv[1]); pk[kt >> 1].y = cvt_pk_bf16(pv[2], pv[3]); }
            }
        }
        LAS unsigned char* vb = lds + ML_VOFF + (4 * g4 + (li >> 2)) * ML_PITCH + (li & 3) * 8;
#pragma unroll
        for (int p = 0; p < 4; ++p) {
            if (2 * p <= w) {
                const s16x8 pf = __builtin_bit_cast(s16x8, pk[p]);
#pragma unroll
                for (int et = 0; et < 17; ++et) { const s16x4 lo = tr_read4(vb + p * 32 * ML_PITCH + et * 32), hi = tr_read4(vb + p * 32 * ML_PITCH + 16 * ML_PITCH + et * 32);
                    const s16x8 vf = {lo[0], lo[1], lo[2], lo[3], hi[0], hi[1], hi[2], hi[3]};
                    o[et] = __builtin_amdgcn_mfma_f32_16x16x32_bf16(vf, pf, o[et], 0, 0, 0); }
            }
        }
        const float den = __shfl(o[16][0], li), rden = 1.0f / fmaxf(fabsf(den), 1.0f);
        float ss = 0.f;
#pragma unroll
        for (int et = 0; et < 16; ++et) { o[et] *= rden; ss += (o[et][0] * o[et][0] + o[et][1] * o[et][1]) + (o[et][2] * o[et][2] + o[et][3] * o[et][3]); }
        ss += __shfl_xor(ss, 16); ss += __shfl_xor(ss, 32);
        const float rn = 1.0f / sqrtf(ss * (1.0f / 256.0f) + NORM_EPS);
#pragma unroll
        for (int et = 0; et < 16; ++et) { const int ch = h * 256 + 16 * et + 4 * g4;
            const v2u og = *(const v2u*)(PROJ + mq * NPROJ + PO + ch); const f32x4 gn = *(const f32x4*)(mg + ch);
            v2u wv; wv.x = cvt_pk_bf16(bflo(og.x) * (o[et][0] * rn) * gn[0], bfhi(og.x) * (o[et][1] * rn) * gn[1]); wv.y = cvt_pk_bf16(bflo(og.y) * (o[et][2] * rn) * gn[2], bfhi(og.y) * (o[et][3] * rn) * gn[3]);
            *(v2u*)(Yo + mq * 3072 + ch) = wv; }
        __syncthreads();
    }
}
__device__ __forceinline__ float dpp_row_shr1(float v) { return __builtin_bit_cast(float, __builtin_amdgcn_update_dpp(0, __builtin_bit_cast(int, v), 0x111, 0xF, 0xF, true)); }
__device__ __forceinline__ float dpp_row_shr2(float v) { return __builtin_bit_cast(float, __builtin_amdgcn_update_dpp(0, __builtin_bit_cast(int, v), 0x112, 0xF, 0xF, true)); }
__device__ __forceinline__ float dpp_row_shr4(float v) { return __builtin_bit_cast(float, __builtin_amdgcn_update_dpp(0, __builtin_bit_cast(int, v), 0x114, 0xF, 0xF, true)); }
__device__ __forceinline__ float dpp_row_shr8(float v) { return __builtin_bit_cast(float, __builtin_amdgcn_update_dpp(0, __builtin_bit_cast(int, v), 0x118, 0xF, 0xF, true)); }
__device__ __forceinline__ float dpp_row_ror1(float v) { return __builtin_bit_cast(float, __builtin_amdgcn_update_dpp(0, __builtin_bit_cast(int, v), 0x121, 0xF, 0xF, true)); }
__device__ __forceinline__ float gelu_tanh_f(float y) { const float x = 0.7978845608028654f * (y + 0.044715f * y * y * y); const float th = 1.0f - 2.0f * __builtin_amdgcn_rcpf(1.0f + __builtin_amdgcn_exp2f(2.8853900817779268f * x)); return 0.5f * y * (1.0f + th); }
__device__ __forceinline__ void s5_disc_phase(const S5P& P, f32x4* DISC, int gtid) { if (gtid < 4096) { float a_r, a_i, f_r, f_i; s5_disc(P, gtid >> 6, gtid & 63, a_r, a_i, f_r, f_i); DISC[gtid] = (f32x4){a_r, a_i, f_r, f_i};
    const float t2 = a_r * a_i, a2r = a_r * a_r - a_i * a_i, a2i = t2 + t2, t4 = a2r * a2i, a4r = a2r * a2r - a2i * a2i, a4i = t4 + t4, t8 = a4r * a4i, a8r = a4r * a4r - a4i * a4i, a8i = t8 + t8;
    const float t16 = a8r * a8i, a12r = a8r * a4r - a8i * a4i, a12i = a8r * a4i + a8i * a4r, a16r = a8r * a8r - a8i * a8i, a16i = t16 + t16;
    float one = 1.f, zero = 0.f; asm volatile("" : "+v"(one), "+v"(zero));
    f32x4* E = DISC + 4096 + (size_t)gtid * 4; E[0] = (f32x4){one, zero, a4r, a4i}; E[1] = (f32x4){a8r, a8i, a12r, a12i}; E[2] = (f32x4){a16r, a16i, a_r, a_i}; E[3] = (f32x4){f_r, f_i, zero, zero}; } }
constexpr int S5_WLDS = 16384, S5_BOFF = 0, S5_COFF = 8192, S5_AOFF = 12288, S5_XOFF = 12800;
template <bool OUT>
__device__ __forceinline__ void s5_mfma_phase(const S5P& P, const f32x4* DISC, const bf16* PROJ, float* LOC, const float* CAR, bf16* Zb, LAS unsigned char* wl, int gw, int NGW, int lane) {
    const int li = lane & 15, g4 = lane >> 4;
    LAS v4u* bl = (LAS v4u*)(wl + S5_BOFF); LAS v4u* cl = (LAS v4u*)(wl + S5_COFF);
    LAS f32x4* at = (LAS f32x4*)(wl + S5_AOFF) + g4 * 8;
    LAS f32x4* xt = (LAS f32x4*)(wl + S5_XOFF) + g4 * 8;
    for (int wj = gw >> 3; wj < 256; wj += NGW >> 3) {
        const int wv = gw & 7, c = (wj & 7) * 2 + (wv >> 2), grp = ((wj >> 3) & 15) * 4 + (wv & 3), b = wj >> 7;
#pragma unroll
        for (int T = 0; T < 4; ++T) { const int p = 16 * T + li; const f32x4 dq = DISC[grp * 64 + p]; const float f_r = dq[2], f_i = dq[3];
            v4u re = {0u, 0u, 0u, 0u}, im = {0u, 0u, 0u, 0u};
            if (g4 < 2) { const float* br = P.b_re + (grp * 64 + p) * 16 + 8 * g4; const float* bi = P.b_im + (grp * 64 + p) * 16 + 8 * g4; float vr[8], vi[8];
#pragma unroll
                for (int j = 0; j < 8; ++j) { vr[j] = f_r * br[j] - f_i * bi[j]; vi[j] = f_r * bi[j] + f_i * br[j]; }
                re.x = pk2(vr[0], vr[1]); re.y = pk2(vr[2], vr[3]); re.z = pk2(vr[4], vr[5]); re.w = pk2(vr[6], vr[7]); im.x = pk2(vi[0], vi[1]); im.y = pk2(vi[2], vi[3]); im.z = pk2(vi[4], vi[5]); im.w = pk2(vi[6], vi[7]); }
            bl[T * 64 + lane] = re; bl[(4 + T) * 64 + lane] = im; }
        if (OUT) {
#pragma unroll
            for (int ks = 0; ks < 4; ++ks) { float cv[8];
#pragma unroll
                for (int j = 0; j < 8; ++j) { const int pp = 16 * (2 * ks + (j >> 2)) + 4 * g4 + (j & 3);
                    cv[j] = (pp < 64) ? P.c_re[(grp * 16 + li) * 64 + pp] : -P.c_im[(grp * 16 + li) * 64 + pp - 64]; }
                v4u w; w.x = pk2(cv[0], cv[1]); w.y = pk2(cv[2], cv[3]); w.z = pk2(cv[4], cv[5]); w.w = pk2(cv[6], cv[7]); cl[ks * 64 + lane] = w; }
        }
        if (li < 8) {
            const int q0 = 2 * li, p0 = 16 * (q0 >> 2) + 4 * g4 + (q0 & 3), p1 = p0 + 1; const f32x4 d0 = DISC[grp * 64 + p0], d1 = DISC[grp * 64 + p1];
            at[li] = (f32x4){d0[0], d0[1], d1[0], d1[1]};
            float zf = 0.f; asm volatile("" : "+v"(zf));
            f32x4 c0 = {zf, zf, zf, zf};
            if (OUT) { const size_t s0 = ((size_t)((b * 64 + grp) * 16 + c) * 64 + p0) * 2; c0 = (f32x4){CAR[s0], CAR[s0 + 1], CAR[s0 + 2], CAR[s0 + 3]}; }
            xt[li] = c0; }
        float dsk[4] = {0.f, 0.f, 0.f, 0.f};
        if (OUT) {
#pragma unroll
            for (int i = 0; i < 4; ++i) dsk[i] = P.d_skip[grp * 16 + 4 * g4 + i]; }
        LDS_WAIT();
        const bf16* ub = PROJ + ((size_t)b * SEQ + c * 1024 + li) * NPROJ + PU + grp * 16;
        v4u un0 = {0u, 0u, 0u, 0u}, un1 = {0u, 0u, 0u, 0u};
        if (g4 < 2) { un0 = *(const v4u*)(ub + 8 * g4); un1 = *(const v4u*)(ub + (size_t)16 * NPROJ + 8 * g4); }
        v2u us0 = {0u, 0u}, us1 = {0u, 0u};
        if (OUT) { us0 = *(const v2u*)(ub + 4 * g4); us1 = *(const v2u*)(ub + (size_t)16 * NPROJ + 4 * g4); }
#pragma unroll 1
        for (int tt = 0; tt < 64; ++tt) {
            const v4u uv = un0; const v2u us = us0; un0 = un1; us0 = us1;
            { const int t2 = tt + 2 < 64 ? tt + 2 : 63; const bf16* u2 = ub + (size_t)t2 * 16 * NPROJ;
              if (g4 < 2) un1 = *(const v4u*)(u2 + 8 * g4);
              if (OUT) us1 = *(const v2u*)(u2 + 4 * g4); }
            const s16x8 uf = __builtin_bit_cast(s16x8, uv);
            f32x4 y = {0.f, 0.f, 0.f, 0.f};
#pragma unroll 1
            for (int h2 = 0; h2 < 2; ++h2) {
                float xr[8], xi[8], ar[8], ai[8];
#pragma unroll
                for (int Tl = 0; Tl < 2; ++Tl) { const int T = 2 * h2 + Tl; const f32x4 z4 = {0.f, 0.f, 0.f, 0.f};
                    const s16x8 bre = __builtin_bit_cast(s16x8, bl[T * 64 + lane]), bim = __builtin_bit_cast(s16x8, bl[(4 + T) * 64 + lane]);
                    const f32x4 dre = __builtin_amdgcn_mfma_f32_16x16x32_bf16(bre, uf, z4, 0, 0, 0), dim = __builtin_amdgcn_mfma_f32_16x16x32_bf16(bim, uf, z4, 0, 0, 0);
#pragma unroll
                    for (int i = 0; i < 4; ++i) { xr[4 * Tl + i] = dre[i]; xi[4 * Tl + i] = dim[i]; } }
#pragma unroll
                for (int k = 0; k < 4; ++k) { const f32x4 av = at[4 * h2 + k], cv = xt[4 * h2 + k];
                    ar[2 * k] = av[0]; ai[2 * k] = av[1]; ar[2 * k + 1] = av[2]; ai[2 * k + 1] = av[3];
                    if (li == 0) { xr[2 * k] += av[0] * cv[0] - av[1] * cv[1]; xi[2 * k] += av[0] * cv[1] + av[1] * cv[0]; xr[2 * k + 1] += av[2] * cv[2] - av[3] * cv[3]; xi[2 * k + 1] += av[2] * cv[3] + av[3] * cv[2]; } }
#pragma unroll
                for (int q = 0; q < 8; ++q) {
                    float vr = xr[q], vi = xi[q], wr = ar[q], wi = ai[q];
                    { const float tr = dpp_row_shr1(vr), ti = dpp_row_shr1(vi); vr += wr * tr - wi * ti; vi += wr * ti + wi * tr; }
                    { const float nr = wr * wr - wi * wi, ni = 2.f * wr * wi; wr = nr; wi = ni; }
                    { const float tr = dpp_row_shr2(vr), ti = dpp_row_shr2(vi); vr += wr * tr - wi * ti; vi += wr * ti + wi * tr; }
                    { const float nr = wr * wr - wi * wi, ni = 2.f * wr * wi; wr = nr; wi = ni; }
                    { const float tr = dpp_row_shr4(vr), ti = dpp_row_shr4(vi); vr += wr * tr - wi * ti; vi += wr * ti + wi * tr; }
                    { const float nr = wr * wr - wi * wi, ni = 2.f * wr * wi; wr = nr; wi = ni; }
                    { const float tr = dpp_row_shr8(vr), ti = dpp_row_shr8(vi); vr += wr * tr - wi * ti; vi += wr * ti + wi * tr; }
                    xr[q] = vr; xi[q] = vi; }
                if (li == 15) {
#pragma unroll
                    for (int k = 0; k < 4; ++k) xt[4 * h2 + k] = (f32x4){xr[2 * k], xi[2 * k], xr[2 * k + 1], xi[2 * k + 1]}; }
                if (OUT) { v4u wre, wim;
                    wre.x = cvt_pk_bf16(xr[0], xr[1]); wre.y = cvt_pk_bf16(xr[2], xr[3]); wre.z = cvt_pk_bf16(xr[4], xr[5]); wre.w = cvt_pk_bf16(xr[6], xr[7]);
                    wim.x = cvt_pk_bf16(xi[0], xi[1]); wim.y = cvt_pk_bf16(xi[2], xi[3]); wim.z = cvt_pk_bf16(xi[4], xi[5]); wim.w = cvt_pk_bf16(xi[6], xi[7]);
                    y = __builtin_amdgcn_mfma_f32_16x16x32_bf16(__builtin_bit_cast(s16x8, cl[h2 * 64 + lane]), __builtin_bit_cast(s16x8, wre), y, 0, 0, 0);
                    y = __builtin_amdgcn_mfma_f32_16x16x32_bf16(__builtin_bit_cast(s16x8, cl[(2 + h2) * 64 + lane]), __builtin_bit_cast(s16x8, wim), y, 0, 0, 0); }
            }
            if (OUT) {
                const float u4[4] = {bflo(us.x), bfhi(us.x), bflo(us.y), bfhi(us.y)};
                float z[4];
#pragma unroll
                for (int i = 0; i < 4; ++i) z[i] = gelu_tanh_f(y[i] + dsk[i] * u4[i]);
                v2u zo; zo.x = cvt_pk_bf16(z[0], z[1]); zo.y = cvt_pk_bf16(z[2], z[3]);
                *(v2u*)(Zb + ((size_t)b * SEQ + c * 1024 + tt * 16 + li) * 1024 + grp * 16 + 4 * g4) = zo;
            }
        }
        if (!OUT) { if (li < 8) { const f32x4 fv = xt[li];
#pragma unroll
            for (int e = 0; e < 2; ++e) { const int q = 2 * li + e, p = 16 * (q >> 2) + 4 * g4 + (q & 3); const size_t sidx = ((size_t)((b * 64 + grp) * 16 + c) * 64 + p) * 2; LOC[sidx] = fv[2 * e]; LOC[sidx + 1] = fv[2 * e + 1]; } } }
        LDS_WAIT();
    }
}
__device__ __forceinline__ void s5a_reduce_phase(const S5P& P, const f32x4* DISC, const bf16* PROJ, float* LOC, LAS unsigned char* wl, int gw, int NGW, int lane) {
    const int li = lane & 15, g4 = lane >> 4;
    LAS v4u* bl = (LAS v4u*)(wl + S5_BOFF);
    for (int wj = gw >> 3; wj < 256; wj += NGW >> 3) {
        const int wv = gw & 7, c = (wj & 7) * 2 + (wv >> 2), grp = ((wj >> 3) & 15) * 4 + (wv & 3), b = wj >> 7;
#pragma unroll
        for (int T = 0; T < 4; ++T) { const int p = 16 * T + li; const f32x4 dq = DISC[grp * 64 + p]; const float f_r = dq[2], f_i = dq[3];
            v4u re = {0u, 0u, 0u, 0u}, im = {0u, 0u, 0u, 0u};
            if (g4 < 2) { const float* br = P.b_re + (grp * 64 + p) * 16 + 8 * g4; const float* bi = P.b_im + (grp * 64 + p) * 16 + 8 * g4; float vr[8], vi[8];
#pragma unroll
                for (int j = 0; j < 8; ++j) { vr[j] = f_r * br[j] - f_i * bi[j]; vi[j] = f_r * bi[j] + f_i * br[j]; }
                re.x = pk2(vr[0], vr[1]); re.y = pk2(vr[2], vr[3]); re.z = pk2(vr[4], vr[5]); re.w = pk2(vr[6], vr[7]); im.x = pk2(vi[0], vi[1]); im.y = pk2(vi[2], vi[3]); im.z = pk2(vi[4], vi[5]); im.w = pk2(vi[6], vi[7]); }
            bl[T * 64 + lane] = re; bl[(4 + T) * 64 + lane] = im; }
        float wr[16], wi[16], sr[16], si[16], cr[16], ci[16];
        const int ex = 15 - li;
#pragma unroll
        for (int q = 0; q < 16; ++q) { const f32x4 da = DISC[grp * 64 + 16 * (q >> 2) + 4 * g4 + (q & 3)];
            float pr = da[0], pi = da[1], ar_ = 1.f, ai_ = 0.f;
#pragma unroll
            for (int bit = 0; bit < 4; ++bit) { if ((ex >> bit) & 1) { const float nr = ar_ * pr - ai_ * pi, ni = ar_ * pi + ai_ * pr; ar_ = nr; ai_ = ni; }
                const float qr = pr * pr - pi * pi, qi = 2.f * pr * pi; pr = qr; pi = qi; }
            wr[q] = ar_; wi[q] = ai_; sr[q] = pr; si[q] = pi; cr[q] = 0.f; ci[q] = 0.f; }
        LDS_WAIT();
        const bf16* ub = PROJ + ((size_t)b * SEQ + c * 1024 + li) * NPROJ + PU + grp * 16;
        v4u un0 = {0u, 0u, 0u, 0u}, un1 = {0u, 0u, 0u, 0u};
        if (g4 < 2) { un0 = *(const v4u*)(ub + 8 * g4); un1 = *(const v4u*)(ub + (size_t)16 * NPROJ + 8 * g4); }
#pragma unroll 1
        for (int tt = 0; tt < 64; ++tt) {
            const v4u uv = un0; un0 = un1;
            { const int t2 = tt + 2 < 64 ? tt + 2 : 63; if (g4 < 2) un1 = *(const v4u*)(ub + (size_t)t2 * 16 * NPROJ + 8 * g4); }
            const s16x8 uf = __builtin_bit_cast(s16x8, uv);
#pragma unroll
            for (int T = 0; T < 4; ++T) { const f32x4 z4 = {0.f, 0.f, 0.f, 0.f};
                const s16x8 bre = __builtin_bit_cast(s16x8, bl[T * 64 + lane]), bim = __builtin_bit_cast(s16x8, bl[(4 + T) * 64 + lane]);
                const f32x4 dre = __builtin_amdgcn_mfma_f32_16x16x32_bf16(bre, uf, z4, 0, 0, 0), dim = __builtin_amdgcn_mfma_f32_16x16x32_bf16(bim, uf, z4, 0, 0, 0);
#pragma unroll
                for (int i = 0; i < 4; ++i) { const int q = 4 * T + i;
                    float vr = dre[i] * wr[q] - dim[i] * wi[q], vi = dre[i] * wi[q] + dim[i] * wr[q];
                    vr += dpp_row_shr1(vr); vi += dpp_row_shr1(vi); vr += dpp_row_shr2(vr); vi += dpp_row_shr2(vi);
                    vr += dpp_row_shr4(vr); vi += dpp_row_shr4(vi); vr += dpp_row_shr8(vr); vi += dpp_row_shr8(vi);
                    const float nr = sr[q] * cr[q] - si[q] * ci[q] + vr, ni = sr[q] * ci[q] + si[q] * cr[q] + vi; cr[q] = nr; ci[q] = ni; }
                __builtin_amdgcn_sched_barrier(0); }
        }
        if (li == 15) {
#pragma unroll
            for (int q = 0; q < 16; ++q) { const int p = 16 * (q >> 2) + 4 * g4 + (q & 3); const size_t sidx = ((size_t)((b * 64 + grp) * 16 + c) * 64 + p) * 2; LOC[sidx] = cr[q]; LOC[sidx + 1] = ci[q]; } }
        LDS_WAIT();
    }
}
__device__ __forceinline__ float bperm_f(int addr, float v) { return __builtin_bit_cast(float, __builtin_amdgcn_ds_bpermute(addr, __builtin_bit_cast(int, v))); }
struct S5Pw { float ar, ai, a4r, a4i, a8r, a8i, a16r, a16i; };
__device__ __forceinline__ S5Pw s5_powers(const f32x4 dq) { S5Pw w; w.ar = dq[0]; w.ai = dq[1];
    const float a2r = w.ar * w.ar - w.ai * w.ai, a2i = 2.f * w.ar * w.ai; w.a4r = a2r * a2r - a2i * a2i; w.a4i = 2.f * a2r * a2i;
    w.a8r = w.a4r * w.a4r - w.a4i * w.a4i; w.a8i = 2.f * w.a4r * w.a4i; w.a16r = w.a8r * w.a8r - w.a8i * w.a8i; w.a16i = 2.f * w.a8r * w.a8i; return w; }
__device__ __forceinline__ void s5_fill_bfrags(const S5P& P, const f32x4* DISC, int grp, LAS v4u* bl, int lane) {
    const int li = lane & 15, g4 = lane >> 4;
#pragma unroll
    for (int T = 0; T < 4; ++T) { const int p = 16 * T + li; const f32x4 dq = DISC[grp * 64 + p]; const float f_r = dq[2], f_i = dq[3];
        v4u re = {0u, 0u, 0u, 0u}, im = {0u, 0u, 0u, 0u};
        if (g4 < 2) { const float* br = P.b_re + (grp * 64 + p) * 16 + 8 * g4; const float* bi = P.b_im + (grp * 64 + p) * 16 + 8 * g4; float vr[8], vi[8];
#pragma unroll
            for (int j = 0; j < 8; ++j) { vr[j] = f_r * br[j] - f_i * bi[j]; vi[j] = f_r * bi[j] + f_i * br[j]; }
            re.x = pk2(vr[0], vr[1]); re.y = pk2(vr[2], vr[3]); re.z = pk2(vr[4], vr[5]); re.w = pk2(vr[6], vr[7]); im.x = pk2(vi[0], vi[1]); im.y = pk2(vi[2], vi[3]); im.z = pk2(vi[4], vi[5]); im.w = pk2(vi[6], vi[7]); }
        bl[T * 64 + lane] = re; bl[(4 + T) * 64 + lane] = im; }
}
__device__ __forceinline__ float afma(float a, float b, float c) { float d; asm("v_fma_f32 %0, %1, %2, %3" : "=v"(d) : "v"(a), "v"(b), "v"(c)); return d; }
__device__ __forceinline__ float anfma(float a, float b, float c) { float d; asm("v_fma_f32 %0, -%1, %2, %3" : "=v"(d) : "v"(a), "v"(b), "v"(c)); return d; }
__device__ __forceinline__ float aadd(float a, float b) { float d; asm("v_add_f32 %0, %1, %2" : "=v"(d) : "v"(a), "v"(b)); return d; }
#define CFMA(rr, ri, ar, ai, xr_, xi_, cr_, ci_) do { const float t0_ = anfma(ai, xi_, cr_), t1_ = afma(ai, xr_, ci_); rr = afma(ar, xr_, t0_); ri = afma(ar, xi_, t1_); } while (0)
__device__ __forceinline__ void s5a_ls_phase(const S5P& P, const f32x4* DISC, const bf16* PROJ, float* LOC, LAS unsigned char* wl, int gw, int NGW, int lane) {
    float zf = 0.f; asm volatile("" : "+v"(zf));
    const int li = lane & 15, g4 = lane >> 4;
    LAS v4u* bl = (LAS v4u*)(wl + S5_BOFF);
    const int ax16 = (lane ^ 16) << 2, ax32 = (lane ^ 32) << 2;
    for (int wj = gw >> 3; wj < 256; wj += NGW >> 3) {
        const int wv = gw & 7, c = (wj & 7) * 2 + (wv >> 2), grp = ((wj >> 3) & 15) * 4 + (wv & 3), b = wj >> 7;
        s5_fill_bfrags(P, DISC, grp, bl, lane);
        S5Pw pw[4]; float qr[4], qi[4], cr[4], ci[4];
        const f32x2* E = (const f32x2*)(DISC + 4096);
#pragma unroll
        for (int T = 0; T < 4; ++T) { const f32x2* e = E + (size_t)(grp * 64 + 16 * T + li) * 8; const f32x2 a = e[5], q = e[3 - g4], s16 = e[4];
            pw[T].ar = a[0]; pw[T].ai = a[1]; pw[T].a16r = s16[0]; pw[T].a16i = s16[1]; qr[T] = q[0]; qi[T] = q[1]; cr[T] = 0.f; ci[T] = 0.f; }
        LDS_WAIT();
        const bf16* ub = PROJ + ((size_t)b * SEQ + c * 1024 + li) * NPROJ + PU + grp * 16;
        v4u un0 = {0u, 0u, 0u, 0u}, un1 = {0u, 0u, 0u, 0u};
        if (g4 < 2) { un0 = *(const v4u*)(ub + 8 * g4); un1 = *(const v4u*)(ub + (size_t)16 * NPROJ + 8 * g4); }
#pragma unroll 1
        for (int tt = 0; tt < 64; ++tt) {
            const v4u uv = un0; un0 = un1;
            { const int t2 = tt + 2 < 64 ? tt + 2 : 63; if (g4 < 2) un1 = *(const v4u*)(ub + (size_t)t2 * 16 * NPROJ + 8 * g4); }
            const s16x8 uf = __builtin_bit_cast(s16x8, uv);
            f32x4 dre4[4], dim4[4];
#pragma unroll
            for (int T = 0; T < 4; ++T) { const f32x4 z4 = {0.f, 0.f, 0.f, 0.f};
                dre4[T] = __builtin_amdgcn_mfma_f32_16x16x32_bf16(uf, __builtin_bit_cast(s16x8, bl[T * 64 + lane]), z4, 0, 0, 0); dim4[T] = __builtin_amdgcn_mfma_f32_16x16x32_bf16(uf, __builtin_bit_cast(s16x8, bl[(4 + T) * 64 + lane]), z4, 0, 0, 0); }
            asm volatile("s_nop 7\n\ts_nop 3" : "+v"(dre4[0]), "+v"(dim4[0]), "+v"(dre4[1]), "+v"(dim4[1]), "+v"(dre4[2]), "+v"(dim4[2]), "+v"(dre4[3]), "+v"(dim4[3]));
#pragma unroll
            for (int T = 0; T < 4; ++T) { const f32x4 dre = dre4[T], dim = dim4[T];
                const float a_r = pw[T].ar, a_i = pw[T].ai;
                float hr = dre[0], hi = dim[0];
#pragma unroll
                for (int i = 1; i < 4; ++i) { float nr, ni; CFMA(nr, ni, a_r, a_i, hr, hi, dre[i], dim[i]); hr = nr; hi = ni; }
                float wr, wi; CFMA(wr, wi, qr[T], qi[T], hr, hi, zf, zf);
                wr = aadd(wr, bperm_f(ax16, wr)); wi = aadd(wi, bperm_f(ax16, wi)); wr = aadd(wr, bperm_f(ax32, wr)); wi = aadd(wi, bperm_f(ax32, wi));
                { float nr, ni; CFMA(nr, ni, pw[T].a16r, pw[T].a16i, cr[T], ci[T], wr, wi); cr[T] = nr; ci[T] = ni; } }
        }
        if (g4 == 0) {
#pragma unroll
            for (int T = 0; T < 4; ++T) { const int p = 16 * T + li; const size_t sidx = ((size_t)((b * 64 + grp) * 16 + c) * 64 + p) * 2; LOC[sidx] = cr[T]; LOC[sidx + 1] = ci[T]; } }
        LDS_WAIT();
    }
}
constexpr int S5_XTOFF = 12288;
__device__ __forceinline__ void s5c_ls_phase(const S5P& P, const f32x4* DISC, const bf16* PROJ, const float* CAR, bf16* Zb, LAS unsigned char* wl, int gw, int NGW, int lane) {
    float zf = 0.f; asm volatile("" : "+v"(zf));
    const int li = lane & 15, g4 = lane >> 4;
    LAS v4u* bl = (LAS v4u*)(wl + S5_BOFF); LAS v4u* cl = (LAS v4u*)(wl + S5_COFF); LAS unsigned char* xt = wl + S5_XTOFF;
    const int au16 = ((lane - 16) & 63) << 2, au32 = ((lane - 32) & 63) << 2, ab3 = (48 + li) << 2;
    for (int wj = gw >> 3; wj < 256; wj += NGW >> 3) {
        const int wv = gw & 7, c = (wj & 7) * 2 + (wv >> 2), grp = ((wj >> 3) & 15) * 4 + (wv & 3), b = wj >> 7;
        s5_fill_bfrags(P, DISC, grp, bl, lane);
#pragma unroll
        for (int ks = 0; ks < 4; ++ks) { float cv[8];
#pragma unroll
            for (int j = 0; j < 8; ++j) { const int pp = 32 * ks + 8 * g4 + j; cv[j] = (pp < 64) ? P.c_re[(grp * 16 + li) * 64 + pp] : -P.c_im[(grp * 16 + li) * 64 + pp - 64]; }
            v4u w; w.x = pk2(cv[0], cv[1]); w.y = pk2(cv[2], cv[3]); w.z = pk2(cv[4], cv[5]); w.w = pk2(cv[6], cv[7]); cl[ks * 64 + lane] = w; }
        S5Pw pw[4]; float gr[4], gi[4], cr[4], ci[4];
        const f32x2* E = (const f32x2*)(DISC + 4096);
#pragma unroll
        for (int T = 0; T < 4; ++T) { const int p = 16 * T + li; const f32x2* e = E + (size_t)(grp * 64 + p) * 8; const f32x2 a = e[5], p4 = e[1], p8 = e[2], gq = e[g4];
            pw[T].ar = a[0]; pw[T].ai = a[1]; pw[T].a4r = p4[0]; pw[T].a4i = p4[1]; pw[T].a8r = p8[0]; pw[T].a8i = p8[1]; gr[T] = gq[0]; gi[T] = gq[1];
            const size_t sidx = ((size_t)((b * 64 + grp) * 16 + c) * 64 + p) * 2; cr[T] = CAR[sidx]; ci[T] = CAR[sidx + 1]; }
        float dsk[4];
#pragma unroll
        for (int i = 0; i < 4; ++i) dsk[i] = P.d_skip[grp * 16 + 4 * g4 + i];
        LDS_WAIT();
        const bf16* ub = PROJ + ((size_t)b * SEQ + c * 1024 + li) * NPROJ + PU + grp * 16;
        v4u un0 = {0u, 0u, 0u, 0u}, un1 = {0u, 0u, 0u, 0u};
        if (g4 < 2) { un0 = *(const v4u*)(ub + 8 * g4); un1 = *(const v4u*)(ub + (size_t)16 * NPROJ + 8 * g4); }
        v2u us0 = *(const v2u*)(ub + 4 * g4), us1 = *(const v2u*)(ub + (size_t)16 * NPROJ + 4 * g4);
#pragma unroll 1
        for (int tt = 0; tt < 64; ++tt) {
            const v4u uv = un0; const v2u us = us0; un0 = un1; us0 = us1;
            { const int t2 = tt + 2 < 64 ? tt + 2 : 63; const bf16* u2 = ub + (size_t)t2 * 16 * NPROJ; if (g4 < 2) un1 = *(const v4u*)(u2 + 8 * g4); us1 = *(const v2u*)(u2 + 4 * g4); }
            const s16x8 uf = __builtin_bit_cast(s16x8, uv);
            f32x4 dre4[4], dim4[4];
#pragma unroll
            for (int T = 0; T < 4; ++T) { const f32x4 z4 = {0.f, 0.f, 0.f, 0.f};
                dre4[T] = __builtin_amdgcn_mfma_f32_16x16x32_bf16(uf, __builtin_bit_cast(s16x8, bl[T * 64 + lane]), z4, 0, 0, 0); dim4[T] = __builtin_amdgcn_mfma_f32_16x16x32_bf16(uf, __builtin_bit_cast(s16x8, bl[(4 + T) * 64 + lane]), z4, 0, 0, 0); }
            asm volatile("s_nop 7\n\ts_nop 3" : "+v"(dre4[0]), "+v"(dim4[0]), "+v"(dre4[1]), "+v"(dim4[1]), "+v"(dre4[2]), "+v"(dim4[2]), "+v"(dre4[3]), "+v"(dim4[3]));
#pragma unroll
            for (int T = 0; T < 4; ++T) { const f32x4 dre = dre4[T], dim = dim4[T];
                const float a_r = pw[T].ar, a_i = pw[T].ai;
                float xr[4], xi[4]; xr[0] = dre[0]; xi[0] = dim[0];
#pragma unroll
                for (int i = 1; i < 4; ++i) { CFMA(xr[i], xi[i], a_r, a_i, xr[i - 1], xi[i - 1], dre[i], dim[i]); }
                float er = xr[3], ei = xi[3];
                { float sr = bperm_f(au16, er), si = bperm_f(au16, ei); if (g4 < 1) { sr = 0.f; si = 0.f; } float nr, ni; CFMA(nr, ni, pw[T].a4r, pw[T].a4i, sr, si, er, ei); er = nr; ei = ni; }
                { float sr = bperm_f(au32, er), si = bperm_f(au32, ei); if (g4 < 2) { sr = 0.f; si = 0.f; } float nr, ni; CFMA(nr, ni, pw[T].a8r, pw[T].a8i, sr, si, er, ei); er = nr; ei = ni; }
                float mr = bperm_f(au16, er), mi = bperm_f(au16, ei); if (g4 < 1) { mr = 0.f; mi = 0.f; }
                float tr, ti; CFMA(tr, ti, gr[T], gi[T], cr[T], ci[T], mr, mi);
#pragma unroll
                for (int i = 0; i < 4; ++i) { float nr, ni; CFMA(nr, ni, a_r, a_i, tr, ti, zf, zf); tr = nr; ti = ni; xr[i] = aadd(xr[i], tr); xi[i] = aadd(xi[i], ti); }
                cr[T] = bperm_f(ab3, xr[3]); ci[T] = bperm_f(ab3, xi[3]);
                v2u wre, wim; wre.x = cvt_pk_bf16(xr[0], xr[1]); wre.y = cvt_pk_bf16(xr[2], xr[3]); wim.x = cvt_pk_bf16(xi[0], xi[1]); wim.y = cvt_pk_bf16(xi[2], xi[3]);
                *(LAS v2u*)(xt + (16 * T + li) * 32 + g4 * 8) = wre; *(LAS v2u*)(xt + (64 + 16 * T + li) * 32 + g4 * 8) = wim; }
            f32x4 y = {0.f, 0.f, 0.f, 0.f};
#pragma unroll
            for (int ks = 0; ks < 4; ++ks) { const s16x4 lo = tr_read4(xt + (32 * ks + 8 * g4 + (li >> 2)) * 32 + (li & 3) * 8), hi = tr_read4(xt + (32 * ks + 8 * g4 + 4 + (li >> 2)) * 32 + (li & 3) * 8);
                const s16x8 xf = {lo[0], lo[1], lo[2], lo[3], hi[0], hi[1], hi[2], hi[3]};
                y = __builtin_amdgcn_mfma_f32_16x16x32_bf16(__builtin_bit_cast(s16x8, cl[ks * 64 + lane]), xf, y, 0, 0, 0); }
            const float u4[4] = {bflo(us.x), bfhi(us.x), bflo(us.y), bfhi(us.y)};
            float z[4];
#pragma unroll
            for (int i = 0; i < 4; ++i) z[i] = gelu_tanh_f(y[i] + dsk[i] * u4[i]);
            v2u zo; zo.x = cvt_pk_bf16(z[0], z[1]); zo.y = cvt_pk_bf16(z[2], z[3]);
            *(v2u*)(Zb + ((size_t)b * SEQ + c * 1024 + tt * 16 + li) * 1024 + grp * 16 + 4 * g4) = zo;
        }
        LDS_WAIT();
    }
}
#ifndef PH_MASK
#define PH_MASK 0x1FFF
#endif
#define PHEN(k) (((PH_MASK) >> (k)) & 1)
#ifndef DUP_MASK
#define DUP_MASK 0
#endif
#define NREP(k) ((((DUP_MASK) >> (k)) & 1) ? 2 : 1)
#ifndef SUB_MASK
#define SUB_MASK 0
#endif
#define SUBREP(k) for (int srep = 0; srep < ((((SUB_MASK) >> (k)) & 1) ? 2 : 1); ++srep)
__device__ unsigned g_ctl[2 * (XCD_BAR_WORDS + 64) + 64];
struct Args { const float* in[26]; float* out; unsigned char* ws; int ph_lo, ph_hi; };
__global__ void __launch_bounds__(NTHR, 2) fwd_kernel(Args args) {
    extern __shared__ __attribute__((aligned(16))) unsigned char lds_raw[];
    LAS unsigned char* lds = (LAS unsigned char*)lds_raw;
    volatile LAS unsigned* MISC = (volatile LAS unsigned*)(lds + MISC_OFF);
#define PHASE_IDS() PHASE_PTRS(); int tid = threadIdx.x; asm volatile("" : "+v"(tid)); const int lane = tid & 63, wave = __builtin_amdgcn_readfirstlane(tid >> 6); \
    const int gw = bx * NWAVES + wave, NGW = G * NWAVES, gtid = bx * NTHR + tid, NGT = G * NTHR; (void)lane; (void)gw; (void)NGW; (void)gtid; (void)NGT
#define PHASE_PTRS() int zq = 0, G = gridDim.x, bx = blockIdx.x; asm volatile("" : "+s"(zq), "+s"(G), "+s"(bx)); const __attribute__((address_space(4))) unsigned long long* kargs = (const __attribute__((address_space(4))) unsigned long long*)__builtin_amdgcn_kernarg_segment_ptr(); \
    unsigned char* ws = (unsigned char*)(GAS unsigned char*)kargs[27 + zq]; float* X = (float*)(GAS float*)kargs[26 + zq]; (void)ws; (void)X
#define ARG(k) ((const float*)(const GAS float*)kargs[(k) + zq])
    for (int u = threadIdx.x; u < LDS_BYTES / 16; u += NTHR) ((LAS v4u*)lds)[u] = (v4u){0u, 0u, 0u, 0u};
    __syncthreads();
    { unsigned* gctl = (unsigned*)(GAS unsigned*)g_ctl;
      if (threadIdx.x == 0) MISC[16] = (xb_add(gctl + 2 * (XCD_BAR_WORDS + 64), 1u) / gridDim.x) & 1u;
      __syncthreads();
      const unsigned bsel = (unsigned)__builtin_amdgcn_readfirstlane((int)MISC[16]);
      (void)xcd_barrier_post(gctl + bsel * (XCD_BAR_WORDS + 64), MISC + 8); }
#define GRID_BARRIER() do { XcdBarrier b_; unsigned* gp_ = (unsigned*)(GAS unsigned*)g_ctl; asm volatile("" : "+s"(gp_)); b_.bar = gp_ + (unsigned)__builtin_amdgcn_readfirstlane((int)MISC[16]) * (XCD_BAR_WORDS + 64); b_.x = xb_xcc_id(); b_.st = MISC + 8; xcd_barrier(b_); } while (0)
    const int lo = args.ph_lo, hi = args.ph_hi;
#ifndef START_HOLD
#define START_HOLD 0
#endif
    if (hi - lo > 1) { for (int dl = 0; dl < START_HOLD; ++dl) __builtin_amdgcn_s_sleep(127); }
#define IN(k) (lo <= (k) && (k) < hi)
#define SEAM(k) do { if (IN(k) && IN((k) + 1)) GRID_BARRIER(); } while (0)

#define XN ((bf16*)(ws + WS_XN))
#define PROJ ((bf16*)(ws + WS_PROJ))
#define HID ((bf16*)(ws + WS_PROJ))
#define QKC ((bf16*)(ws + WS_QKC))
#define MIX ((bf16*)(ws + WS_QKC))
#define HM ((float*)(ws + WS_HM))
#define Y ((bf16*)(ws + WS_Y))
#define Z ((bf16*)(ws + WS_Z))
#define LOFF ((size_t)l * SMALL_STRIDE)
#define IFG ((float*)(ws + WS_IFG + LOFF))
#define S5LOC ((float*)(ws + WS_S5LOC + LOFF))
#define S5CAR ((float*)(ws + WS_S5CAR + LOFF))

    for (int l = 0; l < DEPTH; ++l) {
        const int pb = l * NPH;

        if (PHEN(0) && IN(pb + 0)) for (int rep = 0; rep < NREP(0); ++rep) {
            PHASE_IDS();
            { S5P_MAKE(sp, l); s5_disc_phase(sp, (f32x4*)(ws + WS_DISC + LOFF), gtid); }
            wconv_phase(ARG(2) + (size_t)l * DM * N_IN, ARG(17) + (size_t)l * 1024 * 2048, ARG(18) + (size_t)l * 1024 * DM, ARG(19) + (size_t)l * 1024 * DM,
                        ARG(20) + (size_t)l * 1024 * DM, ARG(21) + (size_t)l * DM * DM, ARG(23) + (size_t)l * DM * FF, ARG(24) + (size_t)l * FF * DM, ARG(22) + (size_t)l * DM, ws, lds, gw, NGW, wave, lane);
            __syncthreads();
            { LAS float* IFW = (LAS float*)lds; const float* src = ARG(2) + (size_t)l * DM * N_IN + 4096;
              for (int i = tid; i < DM * 8; i += NTHR) IFW[i] = src[(size_t)(i >> 3) * N_IN + (i & 7)];
              __syncthreads();
              norm_phase<true>((l == 0) ? ARG(0) : (const float*)X, ARG(1) + (size_t)l * DM, XN, IFW, ARG(5) + l * 4, ARG(6) + l * 4, IFG, gw, NGW, lane);
              __syncthreads(); }
        }
        SEAM(pb + 0);
        if (l == 0 && IN(0) && IN(1) && blockIdx.x == 0) { const unsigned bsel = (unsigned)__builtin_amdgcn_readfirstlane((int)MISC[16]); unsigned* gp_ = (unsigned*)(GAS unsigned*)g_ctl; asm volatile("" : "+s"(gp_)); unsigned* other = gp_ + (bsel ^ 1u) * (XCD_BAR_WORDS + 64);
            int tz = threadIdx.x; asm volatile("" : "+v"(tz));
            for (int u = tz; u < XCD_BAR_WORDS + 64; u += NTHR) __hip_atomic_store(other + u, 0u, __ATOMIC_RELAXED, __HIP_MEMORY_SCOPE_AGENT); }
        if (PHEN(1) && IN(pb + 1)) for (int rep = 0; rep < NREP(1); ++rep) {
            PHASE_PTRS();
            pg8::Gemm g{XN, (const bf16*)(ws + WS_WIN), M, NPROJ, DM, DM, DM}; pg8::StaticOrder S; S.init(M, NPROJ, G, bx);
            EpiProj E{PROJ};
            pg8::gemm_phase<EpiProj, pg8::StaticOrder>(lds, g, S, E);
        }
        SEAM(pb + 1);
        if (PHEN(2) && IN(pb + 2)) for (int rep = 0; rep < NREP(2); ++rep) {
            PHASE_IDS();
            S5P_MAKE(sp, l);
            SUBREP(0) mconv_phase(PROJ, ARG(3) + (size_t)l * 4 * 2048, ARG(4) + (size_t)l * 2048, QKC, gtid, NGT);
            SUBREP(1) s5a_ls_phase(sp, (const f32x4*)(ws + WS_DISC + LOFF), PROJ, S5LOC, lds + wave * S5_WLDS, gw, NGW, lane);
        }
        SEAM(pb + 2);
        if (PHEN(3) && IN(pb + 3)) for (int rep = 0; rep < NREP(3); ++rep) {
            PHASE_IDS();
            S5P_MAKE(sp, l);
            SUBREP(2) mlstm_a1_phase(QKC, PROJ, IFG, (bf16*)(ws + WS_CST), (float*)(ws + WS_MF + LOFF), lds, bx, G, tid);
            SUBREP(3) s5_carry_phase((const f32x4*)(ws + WS_DISC + LOFF), S5LOC, S5CAR, gtid, NGT);
        }
        SEAM(pb + 3);
        if (PHEN(4) && IN(pb + 4)) for (int rep = 0; rep < NREP(4); ++rep) { PHASE_IDS(); mlstm_a2_phase((const bf16*)(ws + WS_CST), (bf16*)(ws + WS_CIN), (const float*)(ws + WS_MF + LOFF), gtid, NGT); }
        SEAM(pb + 4);
        if (PHEN(5) && IN(pb + 5)) for (int rep = 0; rep < NREP(5); ++rep) {
            PHASE_IDS();
            S5P_MAKE(sp, l);
            SUBREP(4) { mlstm_a3_phase(QKC, PROJ, IFG, (const bf16*)(ws + WS_CIN), ARG(7) + (size_t)l * 1024, Y, lds, bx, G, tid);
            __syncthreads(); }
            SUBREP(5) { attn_mfma_phase(PROJ, ARG(8), (bf16*)(ws + WS_ATT), (float*)(ws + WS_LSE + LOFF), lds, bx, G, tid);
            __syncthreads(); }
            SUBREP(6) { s5c_ls_phase(sp, (const f32x4*)(ws + WS_DISC + LOFF), PROJ, S5CAR, Z, lds + wave * S5_WLDS, gw, NGW, lane);
            __syncthreads(); }
        }
        SEAM(pb + 5);
        if (PHEN(6) && IN(pb + 6)) for (int rep = 0; rep < NREP(6); ++rep) {
            SUBREP(7) { PHASE_IDS(); attn_merge_phase((const bf16*)(ws + WS_ATT), (const float*)(ws + WS_LSE + LOFF), Y + 1024, gw, NGW, lane); }
            PHASE_PTRS();
            pg8::Gemm g{Z, (const bf16*)(ws + WS_WGLU), M, 2048, 1024, 1024, 1024}; pg8::StaticOrder S; S.init(M, 2048, G, bx);
            EpiGlu E{Y + 2048, 3072};
            pg8::gemm_phase<EpiGlu, pg8::StaticOrder>(lds, g, S, E);
        }
        SEAM(pb + 6);
        if (PHEN(7) && IN(pb + 7)) for (int rep = 0; rep < NREP(7); ++rep) {
            PHASE_PTRS();
            pg8::Gemm g{Y, (const bf16*)(ws + WS_WBR), M, DM, 3072, 3072, 3072}; pg8::StaticOrder S; S.init(M, DM, G, bx);
            EpiMerge E{PROJ + PG, MIX};
            pg8::gemm_phase<EpiMerge, pg8::StaticOrder>(lds, g, S, E);
        }
        SEAM(pb + 7);
        if (PHEN(8) && IN(pb + 8)) {
            PHASE_PTRS();
            pg8::Gemm g{MIX, (const bf16*)(ws + WS_WOUT), M, DM, DM, DM, DM}; pg8::StaticOrder S; S.init(M, DM, G, bx);
            EpiResidT<true> E{(l == 0) ? ARG(0) : (const float*)X, X, 1.0f};
            pg8::gemm_phase<EpiResidT<true>, pg8::StaticOrder>(lds, g, S, E);
        }
        SEAM(pb + 8);
        if (PHEN(9) && IN(pb + 9)) { PHASE_IDS();
            const f32x4* pp = (const f32x4*)(GAS const f32x4*)(ws + WS_Y); float* rsd = (float*)(GAS float*)(ws + WS_Y + 8 * MiB);
            for (int m = gtid; m < M; m += NGT) { f32x4 a = pp[(size_t)m * 8];
#pragma unroll
                for (int j = 1; j < 8; ++j) a += pp[(size_t)m * 8 + j];
                rsd[m] = 1.0f / sqrtf(((a[0] + a[1]) + (a[2] + a[3])) * (1.0f / DM) + NORM_EPS); } }
        SEAM(pb + 9);
        if (PHEN(10) && IN(pb + 10)) for (int rep = 0; rep < NREP(10); ++rep) {
            PHASE_PTRS();
            pg8::Gemm g{XN, (const bf16*)(ws + WS_W1), M, FF, DM, DM, DM}; pg8::StaticOrder S; S.init(M, FF, G, bx);
            EpiFF1 E{HID, (const float*)(GAS const float*)(ws + WS_Y + 8 * MiB)};
            pg8::gemm_phase<EpiFF1, pg8::StaticOrder>(lds, g, S, E);
        }
        SEAM(pb + 10);
        if (PHEN(11) && IN(pb + 11)) {
            PHASE_PTRS();
            pg8::Gemm g{HID, (const bf16*)(ws + WS_W2), M, DM, FF, FF, FF}; pg8::StaticOrder S; S.init(M, DM, G, bx);
            EpiResid E{X, X, ABL_SF};
            pg8::gemm_phase<EpiResid, pg8::StaticOrder>(lds, g, S, E);
        }
        SEAM(pb + 11);
    }
    if (PHEN(12) && IN(DEPTH * NPH)) {
        PHASE_IDS();
        const float* gain = ARG(25);
        f32x4 gv[8];
#pragma unroll
        for (int j = 0; j < 8; ++j) gv[j] = *(const f32x4*)(gain + 4 * lane + 256 * j);
        for (int m = gw; m < M; m += NGW) {
            f32x4* xr = (f32x4*)(X + (size_t)m * DM) + lane;
            f32x4 v[8]; float ss = 0.f;
#pragma unroll
            for (int j = 0; j < 8; ++j) { v[j] = xr[64 * j]; ss += (v[j].x * v[j].x + v[j].y * v[j].y) + (v[j].z * v[j].z + v[j].w * v[j].w); }
            const float rstd = 1.0f / sqrtf(wave_sum(ss) * (1.0f / DM) + NORM_EPS);
#pragma unroll
            for (int j = 0; j < 8; ++j) xr[64 * j] = (v[j] * rstd) * gv[j];
        }
    }
#undef IN
#undef SEAM
}

extern "C" void kernel_launch(void* const* d_in, const int* in_sizes, int n_in, void* d_out, int out_size, void* d_ws, size_t ws_size, hipStream_t stream) {
    static int grid = 0;
    if (grid == 0) {
        if (n_in != 26 || in_sizes[0] != M * DM || out_size != M * DM || ws_size < WS_END) { fprintf(stderr, "kernel_launch: unexpected shapes (n_in %d, in0 %d, out %d, ws %zu); nothing launched\n", n_in, n_in > 0 ? in_sizes[0] : -1, out_size, ws_size); grid = -1; return; }
        int dev = 0, cus = 0, per_cu = 0;
        if (hipGetDevice(&dev) != hipSuccess || hipDeviceGetAttribute(&cus, hipDeviceAttributeMultiprocessorCount, dev) != hipSuccess) { grid = -1; return; }
        if (hipFuncSetAttribute((const void*)fwd_kernel, hipFuncAttributeMaxDynamicSharedMemorySize, LDS_BYTES) != hipSuccess) { fprintf(stderr, "kernel_launch: hipFuncSetAttribute failed\n"); grid = -1; return; }
        if (hipOccupancyMaxActiveBlocksPerMultiprocessor(&per_cu, (const void*)fwd_kernel, NTHR, LDS_BYTES) != hipSuccess || per_cu < 1) fprintf(stderr, "kernel_launch: occupancy query reports %d\n", per_cu);
        (void)hipGetLastError();
        grid = cus;
    }
    if (grid < 0) return;
    Args a{};
    for (int i = 0; i < 26; ++i) a.in[i] = (const float*)d_in[i];
    a.out = (float*)d_out; a.ws = (unsigned char*)d_ws;
#if MK_SPLIT
    for (int p = 0; p < NPHASES; ++p) { a.ph_lo = p; a.ph_hi = p + 1; hipLaunchKernelGGL(fwd_kernel, dim3(grid), dim3(NTHR), LDS_BYTES, stream, a); }
#else
    a.ph_lo = 0; a.ph_hi = NPHASES;
    hipLaunchKernelGGL(fwd_kernel, dim3(grid), dim3(NTHR), LDS_BYTES, stream, a);
#endif
    const hipError_t le = hipPeekAtLastError();
    if (le != hipSuccess) fprintf(stderr, "kernel_launch: launch failed: %s\n", hipGetErrorName(le));
}
```
